# Optimizing an MI355X kernel written in HIP

```python
import jax, jax.numpy as jnp
from jax import lax
import numpy as np

D_MODEL = 1024
BATCH = 4
SEQ = 4096
DEPTH = 1
DEC_BATCH = 16
DEC_SEQ = 16
PAST_LEN = 4096

CHUNK = 64
D_MIX = D_MODEL
D_POOL = D_MIX // 2
D_CONV = D_MIX - D_POOL
POOL_WINDOWS = (2, 4, 8, 16)
N_POOL_GROUPS = len(POOL_WINDOWS)
POOL_GROUP = D_POOL // N_POOL_GROUPS
POOL_HIST = max(POOL_WINDOWS) - 1
CONV_WIDTH = 31
CONV_HIST = CONV_WIDTH - 1
D_IN = 2 * D_POOL + 3 * D_CONV
RMS_EPS = 1e-6
LN_EPS = 1e-5

kernel_name = "hymba_pool_conformer_stream"


def rms_norm(x, g):
    x32 = x.astype(jnp.float32)
    y = x32 * lax.rsqrt(jnp.mean(x32 * x32, axis=-1, keepdims=True) + RMS_EPS)
    return (y * g.astype(jnp.float32)).astype(x.dtype)


def layer_norm(x, g, b):
    x32 = x.astype(jnp.float32)
    mu = jnp.mean(x32, axis=-1, keepdims=True)
    xc = x32 - mu
    var = jnp.mean(xc * xc, axis=-1, keepdims=True)
    y = xc * lax.rsqrt(var + LN_EPS) * g.astype(jnp.float32) + b.astype(jnp.float32)
    return y.astype(x.dtype)


def multiscale_pool(u_ext, p0, t_new):
    u32 = u_ext.astype(jnp.float32)
    cs = jnp.cumsum(u32, axis=1)
    cs = jnp.concatenate([jnp.zeros_like(cs[:, :1]), cs], axis=1)
    end = cs[:, POOL_HIST + 1:POOL_HIST + 1 + t_new]
    cur = u32[:, POOL_HIST:]
    pos = p0 + jnp.arange(t_new, dtype=jnp.int32)
    outs = []
    for gi, w in enumerate(POOL_WINDOWS):
        sl = slice(gi * POOL_GROUP, (gi + 1) * POOL_GROUP)
        start = cs[:, POOL_HIST + 1 - w:POOL_HIST + 1 - w + t_new, sl]
        cnt = jnp.minimum(pos + 1, w).astype(jnp.float32)[None, :, None]
        outs.append((end[..., sl] - start) / cnt - cur[..., sl])
    return jnp.concatenate(outs, axis=-1).astype(u_ext.dtype)


def causal_dwconv(v_ext, w, b):
    y = lax.conv_general_dilated(
        v_ext, w[:, None, :].astype(v_ext.dtype), window_strides=(1,), padding='VALID',
        dimension_numbers=('NWC', 'WIO', 'NWC'), feature_group_count=v_ext.shape[-1])
    return y + b


def mixer_layer(x, pool_hist, conv_hist, p0, norm_g, w_in, pool_mix, pool_scale,
                dw_w, dw_b, ln_g, ln_b, pw_w, pw_b, w_out):
    B, T, _ = x.shape
    h = rms_norm(x, norm_g)
    proj = jnp.einsum('btd,de->bte', h, w_in)
    u, g_pool, v_a, v_b, g_conv = jnp.split(
        proj, [D_POOL, 2 * D_POOL, 2 * D_POOL + D_CONV, 2 * D_POOL + 2 * D_CONV], axis=-1)
    u_ext = jnp.concatenate([pool_hist.astype(u.dtype), u], axis=1)
    pooled = multiscale_pool(u_ext, p0, T)
    pooled = jnp.einsum('btgc,gcd->btgd', pooled.reshape(B, T, N_POOL_GROUPS, POOL_GROUP),
                        pool_mix).reshape(B, T, D_POOL) * pool_scale
    pool_out = jax.nn.silu(g_pool) * pooled
    v = v_a * jax.nn.sigmoid(v_b)
    v_ext = jnp.concatenate([conv_hist.astype(v.dtype), v], axis=1)
    c = causal_dwconv(v_ext, dw_w, dw_b)
    c = jax.nn.silu(layer_norm(c, ln_g, ln_b))
    c = jnp.einsum('btc,ce->bte', c, pw_w) + pw_b
    conv_out = jax.nn.silu(g_conv) * c
    y = x + jnp.einsum('bte,ed->btd', jnp.concatenate([pool_out, conv_out], axis=-1), w_out)
    return y, u_ext[:, -POOL_HIST:], v_ext[:, -CONV_HIST:]


def setup_inputs(seed: int = 0) -> dict:
    key = jax.random.key(seed)
    ks = jax.random.split(key, 16)
    f32 = jnp.float32
    nrm = lambda k, s: jax.random.normal(k, s, f32)
    return {
        'x_prompt': nrm(ks[0], (BATCH, SEQ, D_MODEL)),
        'x_sample': nrm(ks[1], (DEC_BATCH, DEC_SEQ, D_MODEL)),
        'cache_pool': nrm(ks[2], (DEPTH, DEC_BATCH, POOL_HIST, D_POOL)),
        'cache_conv': 0.5 * nrm(ks[3], (DEPTH, DEC_BATCH, CONV_HIST, D_CONV)),
        'norm_g': 1.0 + 0.05 * nrm(ks[4], (DEPTH, D_MODEL)),
        'w_in': nrm(ks[5], (DEPTH, D_MODEL, D_IN)) * D_MODEL ** -0.5,
        'pool_mix': nrm(ks[6], (DEPTH, N_POOL_GROUPS, POOL_GROUP, POOL_GROUP)) * POOL_GROUP ** -0.5,
        'pool_scale': 1.0 + 0.1 * nrm(ks[7], (DEPTH, D_POOL)),
        'dw_w': nrm(ks[8], (DEPTH, CONV_WIDTH, D_CONV)) * CONV_WIDTH ** -0.5,
        'dw_b': 0.02 * nrm(ks[9], (DEPTH, D_CONV)),
        'ln_g': 1.0 + 0.05 * nrm(ks[10], (DEPTH, D_CONV)),
        'ln_b': 0.02 * nrm(ks[11], (DEPTH, D_CONV)),
        'pw_w': nrm(ks[12], (DEPTH, D_CONV, D_CONV)) * D_CONV ** -0.5,
        'pw_b': 0.02 * nrm(ks[13], (DEPTH, D_CONV)),
        'w_out': nrm(ks[14], (DEPTH, D_MIX, D_MODEL)) * D_MIX ** -0.5,
        'final_g': 1.0 + 0.05 * nrm(ks[15], (D_MODEL,)),
    }


def reference(x_prompt, x_sample, cache_pool, cache_conv, norm_g, w_in, pool_mix, pool_scale,
              dw_w, dw_b, ln_g, ln_b, pw_w, pw_b, w_out, final_g):
    yp = x_prompt
    ys = x_sample
    bp = x_prompt.shape[0]
    sp_pool, sp_conv, ss_pool, ss_conv = [], [], [], []
    for l in range(DEPTH):
        lw = (norm_g[l], w_in[l], pool_mix[l], pool_scale[l], dw_w[l], dw_b[l],
              ln_g[l], ln_b[l], pw_w[l], pw_b[l], w_out[l])
        zero_pool = jnp.zeros((bp, POOL_HIST, D_POOL), x_prompt.dtype)
        zero_conv = jnp.zeros((bp, CONV_HIST, D_CONV), x_prompt.dtype)
        yp, hp_pool, hp_conv = mixer_layer(yp, zero_pool, zero_conv, 0, *lw)
        ys, hs_pool, hs_conv = mixer_layer(ys, cache_pool[l], cache_conv[l], PAST_LEN, *lw)
        sp_pool.append(hp_pool)
        sp_conv.append(hp_conv)
        ss_pool.append(hs_pool)
        ss_conv.append(hs_conv)
    y_prompt = rms_norm(yp, final_g)
    y_sample = rms_norm(ys, final_g)
    return (y_prompt, y_sample, jnp.stack(sp_pool), jnp.stack(sp_conv),
            jnp.stack(ss_pool), jnp.stack(ss_conv))
```

```cpp
#include <hip/hip_runtime.h>
#include <cstdio>

#define LAS __attribute__((address_space(3)))
typedef unsigned short bf16_t;
typedef short bf16x8 __attribute__((ext_vector_type(8)));
typedef float f32x4 __attribute__((ext_vector_type(4)));
typedef float f32x2 __attribute__((ext_vector_type(2)));
typedef unsigned u32x4 __attribute__((ext_vector_type(4)));
typedef unsigned u32x2 __attribute__((ext_vector_type(2)));

constexpr int DM = 1024, NPROMPT = 16384, NSAMP = 256, MT = NPROMPT + NSAMP, DIN = 2560, DH = 512;
constexpr int SEQ = 4096, DSEQ = 16;
constexpr size_t O_Y = 0;
constexpr size_t O_SPP = (size_t)MT * DM;
constexpr size_t O_SCP = O_SPP + 4 * 15 * 512;
constexpr size_t O_SPS = O_SCP + 4 * 30 * 512;
constexpr size_t O_SCS = O_SPS + 16 * 15 * 512;
constexpr size_t WS_XB = 0;
constexpr size_t WS_WIN = WS_XB + (size_t)MT * DM * 2;
constexpr size_t WS_MIX = WS_WIN + (size_t)DIN * DM * 2;
constexpr size_t WS_PW = WS_MIX + (size_t)512 * 512 * 2;
constexpr size_t WS_WOUT = WS_PW + (size_t)512 * 512 * 2;
constexpr size_t WS_U = WS_WOUT + (size_t)1024 * 1024 * 2;
constexpr size_t WS_SGP = WS_U + (size_t)MT * DH * 2;
constexpr size_t WS_V = WS_SGP + (size_t)MT * DH * 2;
constexpr size_t WS_SGC = WS_V + (size_t)MT * DH * 2;
constexpr size_t WS_PC = WS_SGC + (size_t)MT * DH * 2;
constexpr size_t WS_Z = WS_PC + (size_t)MT * DM * 2;
constexpr size_t WS_SS = WS_Z + (size_t)MT * DM * 2;
constexpr size_t WS_BAR = (WS_SS + (size_t)MT * 4 + 255) / 256 * 256;
constexpr size_t WS_CNT = WS_BAR + 4608 * 4;
constexpr size_t WS_CTL_BYTES = 4608 * 4 + 65 * 256;
constexpr size_t WS_XS = WS_CNT + 65 * 256;
constexpr size_t WS_END = WS_XS + (size_t)64 * 4 * 256 * 4;

struct Params {
    const float* x_prompt; const float* x_sample; const float* cache_pool; const float* cache_conv; const float* norm_g; const float* w_in;
    const float* pool_mix; const float* pool_scale; const float* dw_w; const float* dw_b; const float* ln_g; const float* ln_b;
    const float* pw_w; const float* pw_b; const float* w_out; const float* final_g;
    float* out; unsigned char* ws;
};

__device__ __forceinline__ unsigned cvt_pk_bf16(float lo, float hi) { unsigned r; asm volatile("v_cvt_pk_bf16_f32 %0, %1, %2" : "=v"(r) : "v"(lo), "v"(hi)); return r; }
__device__ __forceinline__ float bf_lo(unsigned u) { return __uint_as_float(u << 16); }
__device__ __forceinline__ float bf_hi(unsigned u) { return __uint_as_float(u & 0xffff0000u); }
__device__ __forceinline__ f32x2 bf_unpack(unsigned u) { return (f32x2){bf_lo(u), bf_hi(u)}; }
__device__ __forceinline__ float sigmoid_f(float x) { return __builtin_amdgcn_rcpf(1.0f + __expf(-x)); }
__device__ __forceinline__ float silu_f(float x) { return x * sigmoid_f(x); }
__device__ __forceinline__ u32x4 pack8(f32x4 a, f32x4 b) { return (u32x4){cvt_pk_bf16(a[0], a[1]), cvt_pk_bf16(a[2], a[3]), cvt_pk_bf16(b[0], b[1]), cvt_pk_bf16(b[2], b[3])}; }
__device__ __forceinline__ float wave_sum(float v) {
#pragma unroll
    for (int o = 32; o > 0; o >>= 1) v += __shfl_xor(v, o);
    return v;
}


#define XB_TMO      128
#define XB_XCNT(j)  (256  + 64 * (j))
#define XB_XSUB(j)  (1280 + 64 * (j))
#define XB_XGEN(j)  (2304 + 64 * (j))
#define XB_TOP      3328
#define XB_TOPGEN   3392
#define XB_XLOC(j)  (3520 + 64 * (j))
#define XCD_BAR_WORDS 4608
#define XB_SPIN_CAP (1u << 18)
__device__ __forceinline__ unsigned xb_ld(unsigned* p)              { return __hip_atomic_load(p, __ATOMIC_RELAXED, __HIP_MEMORY_SCOPE_AGENT); }
__device__ __forceinline__ unsigned xb_add(unsigned* p, unsigned v) { return __hip_atomic_fetch_add(p, v, __ATOMIC_RELAXED, __HIP_MEMORY_SCOPE_AGENT); }
__device__ __forceinline__ unsigned xb_xcc_id() { return (unsigned)__builtin_amdgcn_s_getreg((3 << 11) | 20) & 0xFu; }
#define XB_SPIN(cond, bar) do { unsigned _sp = 0; while (cond) { __builtin_amdgcn_s_sleep(1); \
    if ((++_sp & 255u) == 0u) { if (xb_ld(&(bar)[XB_TMO])) break; if (_sp > XB_SPIN_CAP) { atomicAdd(&(bar)[XB_TMO], 1u); break; } } } } while (0)
struct XcdBarrier { unsigned* bar; unsigned x; volatile LAS unsigned* st; };
__device__ __forceinline__ XcdBarrier xcd_barrier_post(unsigned* bar, volatile LAS unsigned* st) {
    XcdBarrier b; b.bar = bar; b.x = xb_xcc_id(); b.st = st;
    if (threadIdx.x == 0) st[2] = xb_add(&bar[XB_XCNT(b.x)], 1u);
    return b;
}
__device__ __forceinline__ void xcd_barrier_complete(unsigned* bar, unsigned x, unsigned& nloc, unsigned& nx, unsigned& uni) {
    const unsigned G = gridDim.x * gridDim.y * gridDim.z;
    unsigned sum, cnt, mine, sp = 0u;
    for (;;) {
        sum = 0u; cnt = 0u; mine = 0u; uni = 1u;
#pragma unroll
        for (unsigned j = 0; j < 16; ++j) { const unsigned c = xb_ld(&bar[XB_XCNT(j)]); sum += c; cnt += (c > 0u) ? 1u : 0u; mine = (j == x) ? c : mine; uni = (c == (j < 8 ? 32u : 0u)) ? uni : 0u; }
        if (sum == G) break;
        __builtin_amdgcn_s_sleep(1);
        if ((++sp & 255u) == 0u) { if (xb_ld(&bar[XB_TMO])) break; if (sp > XB_SPIN_CAP) { atomicAdd(&bar[XB_TMO], 1u); break; } }
    }
    nloc = mine > 0u ? mine : 1u; nx = cnt > 0u ? cnt : 1u; uni = (sum == G) ? uni : 0u;
}
template <class Hook>
__device__ __forceinline__ void xcd_barrier(const XcdBarrier& b, const Hook& hook) {
    asm volatile("s_waitcnt vmcnt(0)" ::: "memory");
    __syncthreads();
    if (threadIdx.x >= 64) hook();
    if (threadIdx.x == 0) {
        unsigned* bar = b.bar;
        __builtin_amdgcn_s_waitcnt(0);
        unsigned nloc = b.st[0], nx = b.st[1];
        if (nloc == 0u) { unsigned uni; xcd_barrier_complete(bar, b.x, nloc, nx, uni); b.st[0] = nloc; b.st[1] = nx; b.st[3] = uni; }
        const unsigned old = xb_add(&bar[XB_XSUB(b.x)], 1u);
        const unsigned gen = old / nloc;
        if (old + 1u == (gen + 1u) * nloc) {
            __builtin_amdgcn_fence(__ATOMIC_RELEASE, "agent");
            asm volatile("s_waitcnt vmcnt(0)" ::: "memory");
            const unsigned og = xb_add(&bar[XB_TOP], 1u);
            const unsigned tg = og / nx;
            if (og + 1u == (tg + 1u) * nx) xb_add(&bar[XB_TOPGEN], 1u);
            else XB_SPIN(xb_ld(&bar[XB_TOPGEN]) == tg, bar);
            __builtin_amdgcn_fence(__ATOMIC_ACQUIRE, "agent");
            xb_add(&bar[XB_XGEN(b.x)], 1u);
            asm volatile("s_waitcnt vmcnt(0)" ::: "memory");
        } else {
            XB_SPIN(xb_ld(&bar[XB_XGEN(b.x)]) == gen, bar);
            __builtin_amdgcn_fence(__ATOMIC_ACQUIRE, "agent");
            asm volatile("s_waitcnt vmcnt(0)" ::: "memory");
        }
    }
    if (threadIdx.x < 64) hook();
    __syncthreads();
}
__device__ __forceinline__ void xcd_barrier(const XcdBarrier& b) { xcd_barrier(b, [] {}); }
template <class Hook>
__device__ __forceinline__ void xcc_barrier(const XcdBarrier& b, const Hook& hook) {
    asm volatile("s_waitcnt vmcnt(0)" ::: "memory");
    __syncthreads();
    if (threadIdx.x >= 64) hook();
    if (threadIdx.x == 0) {
        unsigned* w = &b.bar[XB_XLOC(b.x)];
        __builtin_amdgcn_s_waitcnt(0);
        const unsigned old = xb_add(w, 1u), target = (old / 32u + 1u) * 32u;
        XB_SPIN(xb_ld(w) < target, b.bar);
        __builtin_amdgcn_fence(__ATOMIC_ACQUIRE, "agent");
        asm volatile("s_waitcnt vmcnt(0)" ::: "memory");
    }
    if (threadIdx.x < 64) hook();
    __syncthreads();
}

namespace pg8 {
constexpr int BM = 256, BK = 64, HALF = 128, HTB = HALF * BK * 2, STAGE_BYTES = 8 * HTB, NXCD = 8, WGM = 8;
__device__ __forceinline__ int lds_byte(int r, int c) { const int st = (r >> 4) * 2 + (c >> 5), rr = r & 15, cc = c & 31, ob = rr * 64 + cc * 2; return st * 1024 + (ob ^ (((ob >> 9) & 1) << 5)); }
__device__ __forceinline__ void stage_rc(int b, int& R, int& C) { const int st = b / 1024, sb = b % 1024, swz = sb ^ (((sb >> 9) & 1) << 5); R = (st >> 1) * 16 + swz / 64; C = (st & 1) * 32 + (swz % 64) / 2; }
__device__ __forceinline__ int perm32(int rho) { const int n = rho >> 4, i = rho & 15; return 8 * (i >> 2) + 4 * n + (i & 3); }

struct Unit { const char* A; const char* B; int pm, pn, nt; };

__device__ __forceinline__ bool tile_order(int i, int G, int c, int nM, int nN, int& pm, int& pn) {
    const int nwg = nM * nN; const long L = (long)i * G + c; if (L >= nwg) return false;
    int wgid = (int)L; { const int q = nwg / NXCD, r = nwg % NXCD, xcd = wgid % NXCD, off = wgid / NXCD; wgid = (xcd < r ? xcd * (q + 1) : r * (q + 1) + (xcd - r) * q) + off; }
    const int nig = WGM * nN, gid = wgid / nig, fm = gid * WGM, gsz = (nM - fm) < WGM ? (nM - fm) : WGM;
    pm = fm + ((wgid % nig) % gsz); pn = (wgid % nig) / gsz; return true;
}

template <class Epi, class Sched>
__device__ __forceinline__ void gemm_phase(LAS unsigned char* lds, const int lda, const int ldb, const Sched& S, const Epi& E, f32x4 (&acc)[2][2][4][2]) {
    int tid_ = threadIdx.x; asm volatile("" : "+v"(tid_));
    const int tid = tid_, wid = __builtin_amdgcn_readfirstlane(tid >> 6), lane = tid & 63, wr = wid >> 2, wc = wid & 3, fr = lane & 15, fq = lane >> 4;
    unsigned voffA[2], voffB[2];
#pragma unroll
    for (int i = 0; i < 2; ++i) { int R, C; stage_rc(tid * 16 + i * 8192, R, C); const int Rb = Epi::PERM ? ((R & ~31) + perm32(R & 31)) : R;
        voffA[i] = (unsigned)(R * lda + C) * 2u; voffB[i] = (unsigned)(Rb * ldb + C) * 2u; }
    const size_t kstep = (size_t)(BK * 2);
    const size_t hstepA = (size_t)HALF * lda * 2, hstepB = (size_t)HALF * ldb * 2;
    const unsigned ldsw = (unsigned)wid * 1024u;
    const int aoff = lds_byte(wr * 64 + fr, fq * 8), boff = lds_byte(wc * 32 + fr, fq * 8);
#define PG8_SA(b, h) (((b) * 2 + (h)) * HTB)
#define PG8_SB(b, h) ((4 + (b) * 2 + (h)) * HTB)
#define PG8_STAGE(bufoff, gbase, voff) do { _Pragma("unroll") for (int _i = 0; _i < 2; ++_i) \
        __builtin_amdgcn_global_load_lds((const unsigned*)((const char*)(gbase) + (voff)[_i]), (LAS unsigned*)(lds + (bufoff) + ldsw + _i * 8192), 16, 0, 0); } while (0)
#define PG8_LDA(dst, b, h) do { _Pragma("unroll") for (int m = 0; m < 4; ++m) _Pragma("unroll") for (int k = 0; k < 2; ++k) dst[m][k] = *(const LAS bf16x8*)(lds + PG8_SA(b, h) + aoff + m * 2048 + k * 1024); } while (0)
#define PG8_LDB(dst, b, h) do { _Pragma("unroll") for (int n = 0; n < 2; ++n) _Pragma("unroll") for (int k = 0; k < 2; ++k) dst[n][k] = *(const LAS bf16x8*)(lds + PG8_SB(b, h) + boff + n * 2048 + k * 1024); } while (0)
#define PG8_MMA(ai, bj, At, Bt) do { __builtin_amdgcn_s_setprio(1); _Pragma("unroll") for (int m = 0; m < 4; ++m) _Pragma("unroll") for (int n = 0; n < 2; ++n) _Pragma("unroll") for (int k = 0; k < 2; ++k) \
        acc[ai][bj][m][n] = __builtin_amdgcn_mfma_f32_16x16x32_bf16(Bt[n][k], At[m][k], acc[ai][bj][m][n], 0, 0, 0); __builtin_amdgcn_s_setprio(0); } while (0)
#define PG8_WAIT_V(n) asm volatile("s_waitcnt vmcnt(" #n ")" ::: "memory")
#define PG8_WAIT_L(n) asm volatile("s_waitcnt lgkmcnt(" #n ")" ::: "memory")
#define PG8_BAR __builtin_amdgcn_s_barrier()
#define PG8_SCHED __builtin_amdgcn_sched_barrier(0)
    Unit cur, nxt; int ui = 0;
    if (!S.next(0, cur)) return;
    if constexpr (!Epi::EXT_INIT) E.init(acc, cur, wr, wc, fr, fq);
    bf16x8 At[4][2], B0[2][2], B1[2][2];
    const char* cA = cur.A; const char* cB = cur.B;
    PG8_STAGE(PG8_SB(0, 0), cB, voffB); PG8_STAGE(PG8_SA(0, 0), cA, voffA); PG8_STAGE(PG8_SB(0, 1), cB + hstepB, voffB); PG8_STAGE(PG8_SA(0, 1), cA + hstepA, voffA);
    if (wr == 1) PG8_BAR;
    PG8_WAIT_V(4); PG8_BAR;
    PG8_STAGE(PG8_SB(1, 0), cB + kstep, voffB); PG8_STAGE(PG8_SA(1, 0), cA + kstep, voffA); PG8_STAGE(PG8_SB(1, 1), cB + hstepB + kstep, voffB);
    PG8_WAIT_V(6); PG8_BAR;
    for (;;) {
        const bool has_next = S.next(ui + 1, nxt);
        const char* nA = has_next ? nxt.A : cA; const char* nB = has_next ? nxt.B : cB;
        const int nt = cur.nt;
        for (int t = 0; t < nt; t += 2) {
            const bool last = (t == nt - 2);
            const char* a1 = cA + (size_t)(t + 1) * kstep;
            const char* a2 = last ? nA : cA + (size_t)(t + 2) * kstep; const char* b2 = last ? nB : cB + (size_t)(t + 2) * kstep;
            const char* a3 = a2 + kstep; const char* b3 = b2 + kstep;
            PG8_LDB(B0, 0, 0); PG8_SCHED; PG8_LDA(At, 0, 0); PG8_STAGE(PG8_SA(1, 1), a1 + hstepA, voffA);
            PG8_WAIT_L(8); PG8_BAR; PG8_WAIT_L(0); PG8_MMA(0, 0, At, B0); PG8_BAR; PG8_SCHED;
            PG8_LDB(B1, 0, 1); PG8_STAGE(PG8_SB(0, 0), b2, voffB);
            PG8_BAR; PG8_WAIT_L(0); PG8_MMA(0, 1, At, B1); PG8_BAR;
            PG8_LDA(At, 0, 1); PG8_STAGE(PG8_SA(0, 0), a2, voffA);
            PG8_BAR; PG8_WAIT_L(0); PG8_MMA(1, 0, At, B0); PG8_BAR; PG8_SCHED;
            PG8_STAGE(PG8_SB(0, 1), b2 + hstepB, voffB);
            PG8_WAIT_V(6); PG8_BAR; PG8_MMA(1, 1, At, B1); PG8_BAR;
            PG8_LDB(B0, 1, 0); PG8_SCHED; PG8_LDA(At, 1, 0); PG8_STAGE(PG8_SA(0, 1), a2 + hstepA, voffA);
            PG8_WAIT_L(8); PG8_BAR; PG8_WAIT_L(0); PG8_MMA(0, 0, At, B0); PG8_BAR; PG8_SCHED;
            PG8_LDB(B1, 1, 1); PG8_STAGE(PG8_SB(1, 0), b3, voffB);
            PG8_BAR; PG8_WAIT_L(0); PG8_MMA(0, 1, At, B1); PG8_BAR;
            PG8_LDA(At, 1, 1); PG8_STAGE(PG8_SA(1, 0), a3, voffA);
            PG8_BAR; PG8_WAIT_L(0); PG8_MMA(1, 0, At, B0); PG8_BAR; PG8_SCHED;
            PG8_STAGE(PG8_SB(1, 1), b3 + hstepB, voffB);
            PG8_WAIT_V(6); PG8_BAR; PG8_MMA(1, 1, At, B1); PG8_BAR;
        }
        if constexpr (!Epi::AFTER_DRAIN) E(acc, cur, wr, wc, fr, fq);
        if (!has_next) break;
        cur = nxt; cA = nA; cB = nB; ++ui;
        E.init(acc, cur, wr, wc, fr, fq);
    }
    PG8_WAIT_V(0);
    if (wr == 0) PG8_BAR;
    PG8_BAR;
    if constexpr (Epi::AFTER_DRAIN) E.fused(acc, cur, wr, wc, fr, fq, lds, tid);
#undef PG8_SA
#undef PG8_SB
#undef PG8_STAGE
#undef PG8_LDA
#undef PG8_LDB
#undef PG8_MMA
#undef PG8_WAIT_V
#undef PG8_WAIT_L
#undef PG8_BAR
#undef PG8_SCHED
}
}

struct SchedP1 {
    const char* xb; const char* win; int G, c;
    __device__ __forceinline__ bool next(int i, pg8::Unit& u) const {
        int pm, pn; if (!pg8::tile_order(i, G, c, MT / 256, DIN / 256, pm, pn)) return false;
        u.pm = pm; u.pn = pn; u.nt = 16; u.A = xb + (size_t)pm * 256 * DM * 2; u.B = win + (size_t)pn * 256 * DM * 2; return true;
    }
};
struct EpiP1 {
    static constexpr bool PERM = true, AFTER_DRAIN = false, EXT_INIT = false;
    bf16_t* U; bf16_t* SGP; bf16_t* V; bf16_t* SGC; float* out;
    __device__ __forceinline__ void init(f32x4 (&acc)[2][2][4][2], const pg8::Unit&, int, int, int, int) const {
#pragma unroll
        for (int a = 0; a < 2; ++a)
#pragma unroll
            for (int b = 0; b < 2; ++b)
#pragma unroll
                for (int m = 0; m < 4; ++m)
#pragma unroll
                    for (int n = 0; n < 2; ++n) acc[a][b][m][n] = (f32x4){0.f, 0.f, 0.f, 0.f};
    }
    __device__ __forceinline__ void operator()(const f32x4 (&acc)[2][2][4][2], const pg8::Unit& u, int wr, int wc, int fr, int fq) const {
        const int pn = u.pn, row0 = u.pm * 256 + wr * 64 + fr, cl = wc * 32 + 8 * fq;
        if (pn < 2) {
#pragma unroll
            for (int ai = 0; ai < 2; ++ai)
#pragma unroll
                for (int m = 0; m < 4; ++m) {
                    const int r = row0 + ai * 128 + m * 16; bool st; size_t so;
                    if (r < NPROMPT) { const int t = r & (SEQ - 1); st = t >= SEQ - 15; so = O_SPP + ((size_t)(r >> 12) * 15 + (t - (SEQ - 15))) * 512; }
                    else { const int s = r - NPROMPT, t = s & 15; st = t >= 1; so = O_SPS + ((size_t)(s >> 4) * 15 + (t - 1)) * 512; }
#pragma unroll
                    for (int bj = 0; bj < 2; ++bj) { const int c = pn * 256 + bj * 128 + cl; const f32x4 v0 = acc[ai][bj][m][0], v1 = acc[ai][bj][m][1];
                        *(u32x4*)(U + (size_t)r * DH + c) = pack8(v0, v1);
                        if (st) { *(f32x4*)(out + so + c) = v0; *(f32x4*)(out + so + c + 4) = v1; } }
                }
        } else if (pn < 4 || pn >= 8) {
            bf16_t* dst = pn < 4 ? SGP : SGC; const int cb = (pn < 4 ? pn - 2 : pn - 8) * 256 + cl;
#pragma unroll
            for (int ai = 0; ai < 2; ++ai)
#pragma unroll
                for (int m = 0; m < 4; ++m) { const int r = row0 + ai * 128 + m * 16;
#pragma unroll
                    for (int bj = 0; bj < 2; ++bj) { f32x4 v0 = acc[ai][bj][m][0], v1 = acc[ai][bj][m][1];
#pragma unroll
                        for (int j = 0; j < 4; ++j) { v0[j] = silu_f(v0[j]); v1[j] = silu_f(v1[j]); }
                        *(u32x4*)(dst + (size_t)r * DH + cb + bj * 128) = pack8(v0, v1); }
                }
        } else {
            const int c = (pn - 4) * 128 + cl;
#pragma unroll
            for (int ai = 0; ai < 2; ++ai)
#pragma unroll
                for (int m = 0; m < 4; ++m) {
                    const int r = row0 + ai * 128 + m * 16; bool st; size_t so;
                    if (r < NPROMPT) { const int t = r & (SEQ - 1); st = t >= SEQ - 30; so = O_SCP + ((size_t)(r >> 12) * 30 + (t - (SEQ - 30))) * 512; }
                    else { const int s = r - NPROMPT, t = s & 15; st = true; so = O_SCS + ((size_t)(s >> 4) * 30 + 14 + t) * 512; }
                    f32x4 v0 = acc[ai][0][m][0], v1 = acc[ai][0][m][1]; const f32x4 g0 = acc[ai][1][m][0], g1 = acc[ai][1][m][1];
#pragma unroll
                    for (int j = 0; j < 4; ++j) { v0[j] *= sigmoid_f(g0[j]); v1[j] *= sigmoid_f(g1[j]); }
                    *(u32x4*)(V + (size_t)r * DH + c) = pack8(v0, v1);
                    if (st) { *(f32x4*)(out + so + c) = v0; *(f32x4*)(out + so + c + 4) = v1; }
                }
        }
    }
};

struct SchedP3 {
    const char* pc; const char* mix; const char* pw; int pm0, pn0;
    __device__ __forceinline__ bool next(int i, pg8::Unit& u) const {
        if (i != 0) return false; const int pm = pm0, pn = pn0;
        u.pm = pm; u.pn = pn;
        if (pn < 2) { u.nt = 4; u.A = pc + ((size_t)pm * 256 * DM + 256 * pn) * 2; u.B = mix + ((size_t)pn * 256 * 512 + 256 * pn) * 2; }
        else { u.nt = 8; u.A = pc + ((size_t)pm * 256 * DM + 512) * 2; u.B = pw + (size_t)(pn - 2) * 256 * 512 * 2; }
        return true;
    }
};
struct EpiP3 {
    static constexpr bool PERM = true, AFTER_DRAIN = false, EXT_INIT = false;
    const bf16_t* SGP; const bf16_t* SGC; const float* pw_b; bf16_t* Z;
    __device__ __forceinline__ void init(f32x4 (&acc)[2][2][4][2], const pg8::Unit&, int, int, int, int) const {
#pragma unroll
        for (int a = 0; a < 2; ++a)
#pragma unroll
            for (int b = 0; b < 2; ++b)
#pragma unroll
                for (int m = 0; m < 4; ++m)
#pragma unroll
                    for (int n = 0; n < 2; ++n) acc[a][b][m][n] = (f32x4){0.f, 0.f, 0.f, 0.f};
    }
    __device__ __forceinline__ void operator()(const f32x4 (&acc)[2][2][4][2], const pg8::Unit& u, int wr, int wc, int fr, int fq) const {
        const int pn = u.pn, row0 = u.pm * 256 + wr * 64 + fr, cl = wc * 32 + 8 * fq;
        const bool conv = pn >= 2; const bf16_t* gate = conv ? SGC : SGP; const int cb = (conv ? pn - 2 : pn) * 256 + cl;
        f32x4 bv[2][2];
#pragma unroll
        for (int bj = 0; bj < 2; ++bj)
#pragma unroll
            for (int n = 0; n < 2; ++n) bv[bj][n] = conv ? *(const f32x4*)(pw_b + cb + bj * 128 + 4 * n) : (f32x4){0.f, 0.f, 0.f, 0.f};
#pragma unroll
        for (int ai = 0; ai < 2; ++ai) {
            u32x4 gt[4][2];
#pragma unroll
            for (int m = 0; m < 4; ++m)
#pragma unroll
                for (int bj = 0; bj < 2; ++bj) gt[m][bj] = *(const u32x4*)(gate + (size_t)(row0 + ai * 128 + m * 16) * DH + cb + bj * 128);
#pragma unroll
            for (int m = 0; m < 4; ++m) { const int r = row0 + ai * 128 + m * 16;
#pragma unroll
                for (int bj = 0; bj < 2; ++bj) { const int c = cb + bj * 128; const u32x4 g = gt[m][bj];
                    f32x4 v0 = acc[ai][bj][m][0] + bv[bj][0], v1 = acc[ai][bj][m][1] + bv[bj][1];
                    v0[0] *= bf_lo(g[0]); v0[1] *= bf_hi(g[0]); v0[2] *= bf_lo(g[1]); v0[3] *= bf_hi(g[1]);
                    v1[0] *= bf_lo(g[2]); v1[1] *= bf_hi(g[2]); v1[2] *= bf_lo(g[3]); v1[3] *= bf_hi(g[3]);
                    *(u32x4*)(Z + (size_t)r * DM + (conv ? 512 : 0) + c) = pack8(v0, v1); }
            }
        }
    }
};

struct SchedP4 {
    const char* z; const char* wout; int pm0, pn0;
    __device__ __forceinline__ bool next(int i, pg8::Unit& u) const {
        if (i != 0) return false; const int pm = pm0, pn = pn0;
        u.pm = pm; u.pn = pn; u.nt = 16; u.A = z + (size_t)pm * 256 * DM * 2; u.B = wout + (size_t)pn * 256 * DM * 2; return true;
    }
};
struct EpiP4 {
    static constexpr bool PERM = false, AFTER_DRAIN = true, EXT_INIT = true;
    const float* x_prompt; const float* final_g; float* out; float* xs; unsigned* cnt; const float* ss; int srow; bool uni;
    __device__ __forceinline__ void init(f32x4 (&acc)[2][2][4][2], const pg8::Unit& u, int wr, int wc, int fr, int fq) const {
        const int row0 = u.pm * 256 + wr * 64 + fr, col0 = u.pn * 256 + wc * 32 + 4 * fq;
#pragma unroll
        for (int ai = 0; ai < 2; ++ai)
#pragma unroll
            for (int m = 0; m < 4; ++m) { const float* xr = x_prompt + (size_t)(row0 + ai * 128 + m * 16) * DM + col0;
#pragma unroll
                for (int bj = 0; bj < 2; ++bj)
#pragma unroll
                    for (int n = 0; n < 2; ++n) acc[ai][bj][m][n] = *(const f32x4*)(xr + bj * 128 + n * 16); }
    }
    __device__ __forceinline__ void fused(const f32x4 (&acc)[2][2][4][2], const pg8::Unit& u, int wr, int wc, int fr, int fq, LAS unsigned char* lds, int tid) const {
        LAS float* lss = (LAS float*)lds;
#pragma unroll
        for (int ai = 0; ai < 2; ++ai)
#pragma unroll
            for (int m = 0; m < 4; ++m) { float s = 0.f;
#pragma unroll
                for (int bj = 0; bj < 2; ++bj)
#pragma unroll
                    for (int n = 0; n < 2; ++n) { const f32x4 y = acc[ai][bj][m][n]; s += y[0] * y[0] + y[1] * y[1] + y[2] * y[2] + y[3] * y[3]; }
                s += __shfl_xor(s, 16); s += __shfl_xor(s, 32);
                if (fq == 0) lss[(ai * 128 + wr * 64 + m * 16 + fr) * 4 + wc] = s; }
        __syncthreads();
        if (tid < 256) { const f32x4 v = *(const LAS f32x4*)(lss + tid * 4); xs[((size_t)u.pm * 4 + u.pn) * 256 + tid] = v[0] + v[1] + v[2] + v[3]; }
        asm volatile("s_waitcnt vmcnt(0)" ::: "memory");
        __syncthreads();
        if (tid == 0) {
            unsigned* cw = cnt + 64 * u.pm; unsigned* cs = cnt + 64 * 64;
            if (!uni) __builtin_amdgcn_fence(__ATOMIC_RELEASE, "agent");
            asm volatile("s_waitcnt vmcnt(0)" ::: "memory");
            (void)xb_add(cw, 1u);
            unsigned sp = 0u;
            while (xb_ld(cw) < 4u || xb_ld(cs) < 256u) { __builtin_amdgcn_s_sleep(1); if (++sp > (1u << 22)) break; }
            __builtin_amdgcn_fence(__ATOMIC_ACQUIRE, "agent");
            asm volatile("s_waitcnt vmcnt(0)" ::: "memory");
        }
        __syncthreads();
        if (tid >= 256) { const int t4 = (tid - 256) * 4; const float rs = rsqrtf(ss[srow] * (1.0f / DM) + 1e-6f); float* yr = out + (size_t)srow * DM + t4;
            *(f32x4*)yr = *(const f32x4*)yr * rs * *(const f32x4*)(final_g + t4); }
        if (tid < 256) { const float* xp = xs + (size_t)u.pm * 4 * 256 + tid; const float tot = xp[0] + xp[256] + xp[512] + xp[768];
            lss[1024 + tid] = rsqrtf(tot * (1.0f / DM) + 1e-6f); }
        __syncthreads();
        const int row0 = u.pm * 256 + wr * 64 + fr, col0 = u.pn * 256 + wc * 32 + 4 * fq;
        f32x4 g4[2][2];
#pragma unroll
        for (int bj = 0; bj < 2; ++bj)
#pragma unroll
            for (int n = 0; n < 2; ++n) g4[bj][n] = *(const f32x4*)(final_g + col0 + bj * 128 + n * 16);
#pragma unroll
        for (int ai = 0; ai < 2; ++ai)
#pragma unroll
            for (int m = 0; m < 4; ++m) { const float rs = lss[1024 + ai * 128 + wr * 64 + m * 16 + fr]; float* yr = out + (size_t)(row0 + ai * 128 + m * 16) * DM + col0;
#pragma unroll
                for (int bj = 0; bj < 2; ++bj)
#pragma unroll
                    for (int n = 0; n < 2; ++n) *(f32x4*)(yr + bj * 128 + n * 16) = acc[ai][bj][m][n] * rs * g4[bj][n]; }
    }
    __device__ __forceinline__ void operator()(const f32x4 (&)[2][2][4][2], const pg8::Unit&, int, int, int, int) const {}
};

template <int NF>
__device__ __forceinline__ f32x4 small_gemm(const bf16_t* __restrict__ A, int lda, const bf16_t* __restrict__ Bt, int ldb, int K, int nw, f32x4* red) {
    const int tid = threadIdx.x, wid = tid >> 6, lane = tid & 63, fr = lane & 15, fq = lane >> 4;
    f32x4 acc[NF];
#pragma unroll
    for (int f = 0; f < NF; ++f) acc[f] = (f32x4){0.f, 0.f, 0.f, 0.f};
    if (wid < nw) { const int ks = K / nw; const bf16_t* ap = A + (size_t)fr * lda + wid * ks + fq * 8; const bf16_t* bp = Bt + (size_t)fr * ldb + wid * ks + fq * 8;
        for (int k = 0; k < ks; k += 32) { const bf16x8 a = *(const bf16x8*)(ap + k);
#pragma unroll
            for (int f = 0; f < NF; ++f) { const bf16x8 b = *(const bf16x8*)(bp + (size_t)f * 16 * ldb + k); acc[f] = __builtin_amdgcn_mfma_f32_16x16x32_bf16(b, a, acc[f], 0, 0, 0); } } }
#pragma unroll
    for (int f = 0; f < NF; ++f) red[(wid * NF + f) * 64 + lane] = acc[f];
    __syncthreads();
    f32x4 r = (f32x4){0.f, 0.f, 0.f, 0.f};
    if (tid < 64 * NF) {
#pragma unroll
        for (int w = 0; w < 8; ++w) r += red[(w * NF + wid) * 64 + lane]; }
    return r;
}
__device__ __forceinline__ void sample_p3(const Params& p, unsigned char* shm, const int i) {
    const int tid = threadIdx.x, wid = tid >> 6, lane = tid & 63, fr = lane & 15, fq = lane >> 4; f32x4* red = (f32x4*)shm;
    const bf16_t* PC = (const bf16_t*)(p.ws + WS_PC); bf16_t* Z = (bf16_t*)(p.ws + WS_Z);
    { const int rb = i >> 4, cb = i & 15, row0 = NPROMPT + rb * 16, row = row0 + fr, c = 32 * cb + 16 * wid + 4 * fq;
        {
            const f32x4 r = small_gemm<2>(PC + (size_t)row0 * DM + 512, DM, (const bf16_t*)(p.ws + WS_PW) + (size_t)32 * cb * 512, 512, 512, 8, red);
            if (tid < 128) { const f32x4 bv = *(const f32x4*)(p.pw_b + c); const u32x2 g = *(const u32x2*)((const bf16_t*)(p.ws + WS_SGC) + (size_t)row * DH + c);
                const f32x4 z = (r + bv) * (f32x4){bf_lo(g[0]), bf_hi(g[0]), bf_lo(g[1]), bf_hi(g[1])};
                *(u32x2*)(Z + (size_t)row * DM + 512 + c) = (u32x2){cvt_pk_bf16(z[0], z[1]), cvt_pk_bf16(z[2], z[3])}; }
            __syncthreads();
        }
        {
            const int g128 = (cb >> 2) * 128;
            const f32x4 r = small_gemm<2>(PC + (size_t)row0 * DM + g128, DM, (const bf16_t*)(p.ws + WS_MIX) + (size_t)32 * cb * 512 + g128, 512, 128, 4, red);
            if (tid < 128) { const u32x2 g = *(const u32x2*)((const bf16_t*)(p.ws + WS_SGP) + (size_t)row * DH + c);
                const f32x4 z = r * (f32x4){bf_lo(g[0]), bf_hi(g[0]), bf_lo(g[1]), bf_hi(g[1])};
                *(u32x2*)(Z + (size_t)row * DM + c) = (u32x2){cvt_pk_bf16(z[0], z[1]), cvt_pk_bf16(z[2], z[3])}; }
            __syncthreads();
        }
    }
}
__device__ __forceinline__ void sample_p4(const Params& p, unsigned char* shm, const int i) {
    const int tid = threadIdx.x, wid = tid >> 6, lane = tid & 63, fr = lane & 15, fq = lane >> 4; f32x4* red = (f32x4*)shm;
    float* ss = (float*)(p.ws + WS_SS);
    { const int rb = i >> 4, cb = i & 15, row0 = NPROMPT + rb * 16, row = row0 + fr, c = 64 * cb + 16 * wid + 4 * fq;
        const f32x4 r = small_gemm<4>((const bf16_t*)(p.ws + WS_Z) + (size_t)row0 * DM, DM, (const bf16_t*)(p.ws + WS_WOUT) + (size_t)64 * cb * DM, DM, DM, 8, red);
        if (tid < 256) { const f32x4 y = r + *(const f32x4*)(p.x_sample + (size_t)(row - NPROMPT) * DM + c);
            *(f32x4*)(p.out + (size_t)row * DM + c) = y;
            float s = y[0] * y[0] + y[1] * y[1] + y[2] * y[2] + y[3] * y[3]; s += __shfl_xor(s, 16); s += __shfl_xor(s, 32);
            if (fq == 0) atomicAdd(ss + row, s); }
        asm volatile("s_waitcnt vmcnt(0)" ::: "memory");
        __syncthreads();
        if (tid == 0) { __builtin_amdgcn_fence(__ATOMIC_RELEASE, "agent"); asm volatile("s_waitcnt vmcnt(0)" ::: "memory"); (void)xb_add((unsigned*)(p.ws + WS_CNT) + 64 * 64, 1u); }
    }
}
__device__ __forceinline__ void transpose_load(const float* __restrict__ src, int ldsrc, int k0, int n0s, f32x4 (&v)[2]) {
    const int tid = threadIdx.x, kk = tid >> 4, n4 = (tid & 15) * 4;
#pragma unroll
    for (int i = 0; i < 2; ++i) v[i] = *(const f32x4*)(src + (size_t)(k0 + kk + 32 * i) * ldsrc + n0s + n4);
}
__device__ __forceinline__ void transpose_store(const f32x4 (&v)[2], int k0, bf16_t* __restrict__ dst, int ldd, int n0d, float* tile) {
    const int tid = threadIdx.x;
    {
        const int kk = tid >> 4, n4 = (tid & 15) * 4;
#pragma unroll
        for (int i = 0; i < 2; ++i) { const int k = kk + 32 * i;
            tile[k * 65 + n4 + 0] = v[i][0]; tile[k * 65 + n4 + 1] = v[i][1]; tile[k * 65 + n4 + 2] = v[i][2]; tile[k * 65 + n4 + 3] = v[i][3]; }
    }
    __syncthreads();
    {
        const int n = tid >> 3, k8 = (tid & 7) * 8; float w[8];
#pragma unroll
        for (int j = 0; j < 8; ++j) w[j] = tile[(k8 + j) * 65 + n];
        *(u32x4*)(dst + (size_t)(n0d + n) * ldd + k0 + k8) = (u32x4){cvt_pk_bf16(w[0], w[1]), cvt_pk_bf16(w[2], w[3]), cvt_pk_bf16(w[4], w[5]), cvt_pk_bf16(w[6], w[7])};
    }
    __syncthreads();
}
__device__ __forceinline__ void transpose_tile(const float* __restrict__ src, int ldsrc, int k0, int n0s, bf16_t* __restrict__ dst, int ldd, int n0d, float* tile) {
    f32x4 v[2]; transpose_load(src, ldsrc, k0, n0s, v); transpose_store(v, k0, dst, ldd, n0d, tile);
}
__device__ __forceinline__ int win_src_col(int n0) {
    if (n0 >= 1024 && n0 < 2048) { const int q = n0 - 1024, j = q >> 8, i = q & 255; return i < 128 ? 1024 + 128 * j + i : 1536 + 128 * j + (i - 128); }
    return n0;
}

__device__ __forceinline__ void phase_prep(const Params& p, unsigned char* shm) {
    const int tid = threadIdx.x, wid = tid >> 6, lane = tid & 63, nb = gridDim.x, bid = blockIdx.x;
    bf16_t* xb = (bf16_t*)(p.ws + WS_XB);
    constexpr int T_IN = 16 * 40;
    f32x4 tv[3][2];
#pragma unroll
    for (int q = 0; q < 3; ++q) { const int t = bid + q * nb; if (t < T_IN) transpose_load(p.w_in, DIN, (t / 40) * 64, win_src_col((t % 40) * 64), tv[q]); }
    {
        f32x4 g4[4];
#pragma unroll
        for (int i = 0; i < 4; ++i) g4[i] = *(const f32x4*)(p.norm_g + lane * 4 + 256 * i);
        for (int g = bid * 8 + wid; g < MT / 4; g += nb * 8) {
            f32x4 v[4][4]; float s[4];
#pragma unroll
            for (int q = 0; q < 4; ++q) { const int r = g * 4 + q; const float* xr = r < NPROMPT ? p.x_prompt + (size_t)r * DM : p.x_sample + (size_t)(r - NPROMPT) * DM;
#pragma unroll
                for (int i = 0; i < 4; ++i) v[q][i] = *(const f32x4*)(xr + lane * 4 + 256 * i); }
#pragma unroll
            for (int q = 0; q < 4; ++q) { s[q] = 0.f;
#pragma unroll
                for (int i = 0; i < 4; ++i) s[q] += v[q][i][0] * v[q][i][0] + v[q][i][1] * v[q][i][1] + v[q][i][2] * v[q][i][2] + v[q][i][3] * v[q][i][3];
                s[q] = wave_sum(s[q]); }
#pragma unroll
            for (int q = 0; q < 4; ++q) { const int r = g * 4 + q; const float rs = rsqrtf(s[q] * (1.0f / DM) + 1e-6f);
#pragma unroll
                for (int i = 0; i < 4; ++i) { const f32x4 h = v[q][i] * rs * g4[i];
                    *(u32x2*)(xb + (size_t)r * DM + lane * 4 + 256 * i) = (u32x2){cvt_pk_bf16(h[0], h[1]), cvt_pk_bf16(h[2], h[3])}; } }
        }
    }
    {
        float* tile = (float*)shm; bf16_t* win = (bf16_t*)(p.ws + WS_WIN);
#pragma unroll
        for (int q = 0; q < 3; ++q) { const int t = bid + q * nb; if (t < T_IN) transpose_store(tv[q], (t / 40) * 64, win, DM, (t % 40) * 64, tile); }
        for (int t = bid + 3 * nb; t < T_IN; t += nb) transpose_tile(p.w_in, DIN, (t / 40) * 64, win_src_col((t % 40) * 64), win, DM, (t % 40) * 64, tile);
    }
    float* ss = (float*)(p.ws + WS_SS);
    for (int i = bid * 512 + tid; i < MT; i += nb * 512) ss[i] = 0.f;
    for (int i = bid * 512 + tid; i < 16 * 14 * 128; i += nb * 512) { const int c4 = i & 127, rr = i >> 7, b = rr / 14, j = rr % 14;
        *(f32x4*)(p.out + O_SCS + ((size_t)b * 30 + j) * 512 + c4 * 4) = *(const f32x4*)(p.cache_conv + ((size_t)b * 30 + 16 + j) * 512 + c4 * 4); }
}

__device__ __forceinline__ void late_weight_prep(const Params& p, unsigned char* shm, const int bid, const int nb) {
    const int tid = threadIdx.x; float* tile = (float*)shm;
    bf16_t* pw = (bf16_t*)(p.ws + WS_PW); bf16_t* wout = (bf16_t*)(p.ws + WS_WOUT); bf16_t* mix = (bf16_t*)(p.ws + WS_MIX);
    constexpr int T_OUT = 16 * 16, T_PW = 8 * 8;
    for (int t = bid; t < T_OUT + T_PW; t += nb) {
        if (t < T_OUT) transpose_tile(p.w_out, DM, (t >> 4) * 64, (t & 15) * 64, wout, DM, (t & 15) * 64, tile);
        else { const int tt = t - T_OUT; transpose_tile(p.pw_w, 512, (tt >> 3) * 64, (tt & 7) * 64, pw, 512, (tt & 7) * 64, tile); }
    }
    for (int idx = bid * 512 + tid; idx < 512 * 512; idx += nb * 512) { const int n = idx >> 9, k = idx & 511; float v = 0.f;
        if ((n >> 7) == (k >> 7)) v = p.pool_mix[((size_t)(n >> 7) * 128 + (k & 127)) * 128 + (n & 127)] * p.pool_scale[n];
        mix[idx] = (bf16_t)(cvt_pk_bf16(v, 0.f) & 0xffffu); }
    __syncthreads();
}

#define DPP_STEP(v, ctrl) ((v) + __builtin_bit_cast(float, __builtin_amdgcn_update_dpp(0, __builtin_bit_cast(int, (v)), (ctrl), 0xf, 0xf, true)))
__device__ __forceinline__ float wave_sum_hi(float v) {
    v = DPP_STEP(v, 0xB1);
    v = DPP_STEP(v, 0x4E);
    v = DPP_STEP(v, 0x141);
    v = DPP_STEP(v, 0x140);
    v += __builtin_bit_cast(float, __builtin_amdgcn_update_dpp(0, __builtin_bit_cast(int, v), 0x142, 0xa, 0xf, false));
    v += __builtin_bit_cast(float, __builtin_amdgcn_update_dpp(0, __builtin_bit_cast(int, v), 0x143, 0xc, 0xf, false));
    return v;
}
template <int W>
__device__ __forceinline__ void pool_regs(const unsigned (&u)[47], const int pos0, bf16_t* __restrict__ dst  ) {
    f32x2 s = (f32x2){0.f, 0.f};
#pragma unroll
    for (int j = 0; j < W; ++j) s += bf_unpack(u[15 - j]);
#pragma unroll
    for (int i = 0; i < 32; ++i) { const f32x2 cur = bf_unpack(u[15 + i]); const int pos1 = pos0 + i + 1;
        const float inv = pos1 >= W ? (1.0f / W) : __builtin_amdgcn_rcpf((float)pos1);
        const f32x2 o = s * inv - cur;
        *(unsigned*)(dst + (size_t)i * DM) = cvt_pk_bf16(o[0], o[1]);
        if (i + 1 < 32) s += bf_unpack(u[16 + i]) - bf_unpack(u[16 + i - W]); }
}
__device__ __forceinline__ void mixer_chunk(const Params& p, unsigned char* shm, const int r0, const int t0, const int tid, const f32x2 (&w2)[31]) {
    constexpr int T = 64, TH = 32, ROUNDS = 4;
    const int cp = tid & 255, th = tid >> 8, lane = tid & 63, wv = (tid >> 6) & 3;
    const bf16_t* U = (const bf16_t*)(p.ws + WS_U); const bf16_t* V = (const bf16_t*)(p.ws + WS_V); bf16_t* PC = (bf16_t*)(p.ws + WS_PC);
    const unsigned* l32 = (const unsigned*)shm;
    u32x4 val[12];
    {
        const bf16_t* vb = V + (size_t)(r0 - 30) * DH;
#pragma unroll
        for (int k = 0; k < 12; ++k) { const int idx = tid + k * 512, lr = idx >> 6; val[k] = (u32x4){0u, 0u, 0u, 0u};
            if (idx < (T + 30) * 64 && t0 - 30 + lr >= 0) val[k] = *(const u32x4*)(vb + (size_t)idx * 8); }
    }
    unsigned u[47];
    {
        const int f0 = th * TH - 15; const bf16_t* ub = U + (size_t)(r0 + f0) * DH + cp * 2;
#pragma unroll
        for (int k = 0; k < 47; ++k) { u[k] = 0u; if (t0 + f0 + k >= 0) u[k] = *(const unsigned*)(ub + (size_t)k * DH); }
    }
#pragma unroll
    for (int k = 0; k < 12; ++k) { const int idx = tid + k * 512; if (idx < (T + 30) * 64) *(u32x4*)(shm + (size_t)idx * 16) = val[k]; }
    const f32x2 bias = *(const f32x2*)(p.dw_b + cp * 2);
    const f32x2 g2 = *(const f32x2*)(p.ln_g + cp * 2), b2 = *(const f32x2*)(p.ln_b + cp * 2);
    __syncthreads();
    {
        bf16_t* dst = PC + (size_t)(r0 + th * TH) * DM + cp * 2; const int pos0 = t0 + th * TH;
        switch (cp >> 6) { case 0: pool_regs<2>(u, pos0, dst); break; case 1: pool_regs<4>(u, pos0, dst); break; case 2: pool_regs<8>(u, pos0, dst); break; default: pool_regs<16>(u, pos0, dst); break; }
    }
    f32x2* stats = (f32x2*)(shm + (T + 30) * 1024);
#pragma unroll 1
    for (int rd = 0; rd < ROUNDS; ++rd) {
        const int tt = rd * 16 + th * 8;
        f32x2 c[8];
#pragma unroll
        for (int i = 0; i < 8; ++i) c[i] = bias;
#pragma unroll
        for (int q = 0; q < 38; ++q) { const f32x2 v = bf_unpack(l32[(tt + q) * 256 + cp]);
#pragma unroll
            for (int i = 0; i < 8; ++i) if (q - i >= 0 && q - i < 31) c[i] += w2[q - i] * v; }
#pragma unroll
        for (int i = 0; i < 8; ++i) { const float s1 = wave_sum_hi(c[i][0] + c[i][1]), s2 = wave_sum_hi(c[i][0] * c[i][0] + c[i][1] * c[i][1]);
            if (lane == 63) stats[(tt + i) * 4 + wv] = (f32x2){s1, s2}; }
        __syncthreads();
        float mean_l, rs_l;
        { const int ti = tt + (lane & 7);
          const f32x4 sa = *(const f32x4*)(stats + ti * 4), sb = *(const f32x4*)(stats + ti * 4 + 2);
          mean_l = (sa[0] + sa[2] + sb[0] + sb[2]) * (1.0f / 512.0f);
          const float var = (sa[1] + sa[3] + sb[1] + sb[3]) * (1.0f / 512.0f) - mean_l * mean_l;
          rs_l = __builtin_amdgcn_rsqf(var + 1e-5f); }
#pragma unroll
        for (int i = 0; i < 8; ++i) {
            const float mean = __builtin_bit_cast(float, __builtin_amdgcn_readlane(__builtin_bit_cast(int, mean_l), i));
            const float rs = __builtin_bit_cast(float, __builtin_amdgcn_readlane(__builtin_bit_cast(int, rs_l), i));
            const f32x2 y = (c[i] - mean) * rs * g2 + b2;
            *(unsigned*)(PC + (size_t)(r0 + tt + i) * DM + 512 + cp * 2) = cvt_pk_bf16(silu_f(y[0]), silu_f(y[1])); }
    }
    __syncthreads();
}

__device__ __forceinline__ void sample_token(const Params& p, unsigned char* shm, const int s) {
    const int tid = threadIdx.x, wid = tid >> 6, lane = tid & 63, b = s >> 4, t = s & 15, r = NPROMPT + s, ch = tid;
    const bf16_t* U = (const bf16_t*)(p.ws + WS_U); const bf16_t* V = (const bf16_t*)(p.ws + WS_V); bf16_t* PC = (bf16_t*)(p.ws + WS_PC);
    {
        const int w = 2 << (ch >> 7); float sum = 0.f, cur = 0.f;
#pragma unroll
        for (int j = 0; j < 16; ++j) if (j < w) { const int e = t + 15 - j;
            const float v = e < 15 ? p.cache_pool[((size_t)b * 15 + e) * 512 + ch] : __uint_as_float((unsigned)U[(size_t)(NPROMPT + b * 16 + e - 15) * DH + ch] << 16);
            sum += v; if (j == 0) cur = v; }
        const float o = sum / (float)w - cur;
        PC[(size_t)r * DM + ch] = (bf16_t)(cvt_pk_bf16(o, 0.f) & 0xffffu);
    }
    float c = p.dw_b[ch];
#pragma unroll
    for (int j = 0; j < 31; ++j) { const int e = t + j;
        const float v = e < 30 ? p.cache_conv[((size_t)b * 30 + e) * 512 + ch] : __uint_as_float((unsigned)V[(size_t)(NPROMPT + b * 16 + e - 30) * DH + ch] << 16);
        c += p.dw_w[j * 512 + ch] * v; }
    float s1 = wave_sum(c), s2 = wave_sum(c * c);
    f32x2* red = (f32x2*)shm;
    if (lane == 0) red[wid] = (f32x2){s1, s2};
    __syncthreads();
    s1 = 0.f; s2 = 0.f;
#pragma unroll
    for (int w8 = 0; w8 < 8; ++w8) { const f32x2 q = red[w8]; s1 += q[0]; s2 += q[1]; }
    const float mean = s1 * (1.0f / 512.0f), var = s2 * (1.0f / 512.0f) - mean * mean, rs = rsqrtf(var + 1e-5f);
    const float y = (c - mean) * rs * p.ln_g[ch] + p.ln_b[ch];
    PC[(size_t)r * DM + 512 + ch] = (bf16_t)(cvt_pk_bf16(silu_f(y), 0.f) & 0xffffu);
    __syncthreads();
}

__device__ __forceinline__ void phase_mixer_pre(const Params& p, unsigned char* shm, const int s, const int q) {
    int tid = threadIdx.x; asm volatile("" : "+v"(tid));
    sample_token(p, shm, s);
    f32x2 w2[31];
    { const float* wp = p.dw_w + (tid & 255) * 2;
#pragma unroll
      for (int j = 0; j < 31; ++j) w2[j] = *(const f32x2*)(wp + j * 512); }
    mixer_chunk(p, shm, q * 64, (q & 63) * 64, tid, w2);
}

__global__ void __launch_bounds__(512, 2) hymba_fwd(Params p) {
    extern __shared__ __attribute__((aligned(16))) unsigned char shm[];
    LAS unsigned char* lds = (LAS unsigned char*)shm;
    const int G = gridDim.x, c = blockIdx.x;
    volatile LAS unsigned* st = (volatile LAS unsigned*)(lds + pg8::STAGE_BYTES);
    if (threadIdx.x == 0) { st[0] = 0u; st[1] = 0u; st[2] = 0u; st[3] = 0u; }
    __syncthreads();
    const XcdBarrier xb = xcd_barrier_post((unsigned*)(p.ws + WS_BAR), st);
    phase_prep(p, shm);
    xcd_barrier(xb);
    { constexpr int N3 = (MT / 256) * (DIN / 256) - 512;
      if (G == 256 && c >= N3) late_weight_prep(p, shm, c - N3, 256 - N3);
      else if (G != 256) late_weight_prep(p, shm, c, G); }
    { SchedP1 S{(const char*)(p.ws + WS_XB), (const char*)(p.ws + WS_WIN), G, c};
      EpiP1 E{(bf16_t*)(p.ws + WS_U), (bf16_t*)(p.ws + WS_SGP), (bf16_t*)(p.ws + WS_V), (bf16_t*)(p.ws + WS_SGC), p.out};
      f32x4 acc[2][2][4][2]; pg8::gemm_phase(lds, DM, DM, S, E, acc); }
    xcd_barrier(xb);
    const bool uni = st[3] != 0u;
    const int gx = uni ? (int)xb.x : (c & 7), gl = uni ? (int)st[2] : (c >> 3);
    const int sidx = 32 * gx + gl;
    const int pm = 8 * gx + (gl & 7), pn = gl >> 3;
    phase_mixer_pre(p, shm, sidx, 4 * (8 * gx + (gl >> 2)) + (gl & 3));
    if (uni) xcc_barrier(xb, [] {}); else xcd_barrier(xb);
    sample_p3(p, shm, sidx);
    { SchedP3 S{(const char*)(p.ws + WS_PC), (const char*)(p.ws + WS_MIX), (const char*)(p.ws + WS_PW), pm, pn};
      EpiP3 E{(const bf16_t*)(p.ws + WS_SGP), (const bf16_t*)(p.ws + WS_SGC), p.pw_b, (bf16_t*)(p.ws + WS_Z)};
      f32x4 acc[2][2][4][2]; pg8::gemm_phase(lds, DM, 512, S, E, acc); }
    { SchedP4 S{(const char*)(p.ws + WS_Z), (const char*)(p.ws + WS_WOUT), pm, pn};
      EpiP4 E{p.x_prompt, p.final_g, p.out, (float*)(p.ws + WS_XS), (unsigned*)(p.ws + WS_CNT), (const float*)(p.ws + WS_SS), NPROMPT + sidx, uni};
      f32x4 acc[2][2][4][2]; pg8::Unit u4; const bool has4 = S.next(0, u4);
      int tid4 = threadIdx.x; asm volatile("" : "+v"(tid4));
      const int wid4 = __builtin_amdgcn_readfirstlane(tid4 >> 6), lane4 = tid4 & 63;
      const auto hook = [&] { if (has4) E.init(acc, u4, wid4 >> 2, wid4 & 3, lane4 & 15, lane4 >> 4); };
      if (uni) xcc_barrier(xb, hook); else xcd_barrier(xb, hook);
      sample_p4(p, shm, sidx);
      pg8::gemm_phase(lds, DM, DM, S, E, acc); }
}

extern "C" void kernel_launch(void* const* d_in, const int* in_sizes, int n_in, void* d_out, int out_size, void* d_ws, size_t ws_size, hipStream_t stream) {
    constexpr int LDS_BYTES = pg8::STAGE_BYTES + 16;
    static int grid = 0;
    if (grid == 0) {
        if (n_in != 16 || ws_size < WS_END) { fprintf(stderr, "kernel_launch: unexpected inputs (n_in %d, ws %zu)\n", n_in, ws_size); grid = -1; return; }
        int dev = 0, cus = 0, per_cu = 0;
        (void)hipGetDevice(&dev); (void)hipDeviceGetAttribute(&cus, hipDeviceAttributeMultiprocessorCount, dev);
        if (hipFuncSetAttribute((const void*)hymba_fwd, hipFuncAttributeMaxDynamicSharedMemorySize, LDS_BYTES) != hipSuccess) { fprintf(stderr, "kernel_launch: hipFuncSetAttribute failed\n"); grid = -1; return; }
        if (hipOccupancyMaxActiveBlocksPerMultiprocessor(&per_cu, (const void*)hymba_fwd, 512, LDS_BYTES) != hipSuccess || per_cu < 1) { fprintf(stderr, "kernel_launch: occupancy query says %d\n", per_cu); per_cu = 1; (void)hipGetLastError(); }
        if (cus < 256) { fprintf(stderr, "kernel_launch: built for a 256-CU device (got %d CUs)\n", cus); grid = -1; return; }
        grid = 256;
    }
    if (grid < 0) return;
    if (hipMemsetAsync((char*)d_ws + WS_BAR, 0, WS_CTL_BYTES, stream) != hipSuccess) { fprintf(stderr, "kernel_launch: memset of the barrier words failed\n"); return; }
    Params p{};
    p.x_prompt = (const float*)d_in[0]; p.x_sample = (const float*)d_in[1]; p.cache_pool = (const float*)d_in[2]; p.cache_conv = (const float*)d_in[3];
    p.norm_g = (const float*)d_in[4]; p.w_in = (const float*)d_in[5]; p.pool_mix = (const float*)d_in[6]; p.pool_scale = (const float*)d_in[7];
    p.dw_w = (const float*)d_in[8]; p.dw_b = (const float*)d_in[9]; p.ln_g = (const float*)d_in[10]; p.ln_b = (const float*)d_in[11];
    p.pw_w = (const float*)d_in[12]; p.pw_b = (const float*)d_in[13]; p.w_out = (const float*)d_in[14]; p.final_g = (const float*)d_in[15];
    p.out = (float*)d_out; p.ws = (unsigned char*)d_ws;
    void* args[] = {&p};
    hipError_t e = hipLaunchCooperativeKernel((const void*)hymba_fwd, dim3(grid), dim3(512), args, LDS_BYTES, stream);
    if (e != hipSuccess) fprintf(stderr, "kernel_launch: cooperative launch failed: %s (grid %d)\n", hipGetErrorString(e), grid);
}
```

```cpp
#include <hip/hip_runtime.h>
#include <cstdio>

#define LAS __attribute__((address_space(3)))
typedef unsigned short bf16_t;
typedef short bf16x8 __attribute__((ext_vector_type(8)));
typedef float f32x4 __attribute__((ext_vector_type(4)));
typedef float f32x2 __attribute__((ext_vector_type(2)));
typedef unsigned u32x4 __attribute__((ext_vector_type(4)));
typedef unsigned u32x2 __attribute__((ext_vector_type(2)));

constexpr int DM = 1024, NPROMPT = 16384, NSAMP = 256, MT = NPROMPT + NSAMP, DIN = 2560, DH = 512;
constexpr int SEQ = 4096, DSEQ = 16;
constexpr size_t O_Y = 0;
constexpr size_t O_SPP = (size_t)MT * DM;
constexpr size_t O_SCP = O_SPP + 4 * 15 * 512;
constexpr size_t O_SPS = O_SCP + 4 * 30 * 512;
constexpr size_t O_SCS = O_SPS + 16 * 15 * 512;
constexpr size_t WS_XB = 0;
constexpr size_t WS_WIN = WS_XB + (size_t)MT * DM * 2;
constexpr size_t WS_MIX = WS_WIN + (size_t)DIN * DM * 2;
constexpr size_t WS_PW = WS_MIX + (size_t)512 * 512 * 2;
constexpr size_t WS_WOUT = WS_PW + (size_t)512 * 512 * 2;
constexpr size_t WS_U = WS_WOUT + (size_t)1024 * 1024 * 2;
constexpr size_t WS_SGP = WS_U + (size_t)MT * DH * 2;
constexpr size_t WS_V = WS_SGP + (size_t)MT * DH * 2;
constexpr size_t WS_SGC = WS_V + (size_t)MT * DH * 2;
constexpr size_t WS_PC = WS_SGC + (size_t)MT * DH * 2;
constexpr size_t WS_Z = WS_PC + (size_t)MT * DM * 2;
constexpr size_t WS_SS = WS_Z + (size_t)MT * DM * 2;
constexpr size_t WS_BAR = (WS_SS + (size_t)MT * 4 + 255) / 256 * 256;
constexpr size_t WS_CNT = WS_BAR + 4608 * 4;
constexpr size_t WS_CTL_BYTES = 4608 * 4 + 96 * 256;
constexpr int CW_PIECES = 64, CW_RV = 65  , CW_SV = 73  , CW_GV = 81  , CW_LW = 82  ;
constexpr size_t WS_XS = WS_CNT + 96 * 256;
constexpr size_t WS_END = WS_XS + (size_t)64 * 4 * 256 * 4;

struct Params {
    const float* x_prompt; const float* x_sample; const float* cache_pool; const float* cache_conv; const float* norm_g; const float* w_in;
    const float* pool_mix; const float* pool_scale; const float* dw_w; const float* dw_b; const float* ln_g; const float* ln_b;
    const float* pw_w; const float* pw_b; const float* w_out; const float* final_g;
    float* out; unsigned char* ws;
};

__device__ __forceinline__ unsigned cvt_pk_bf16(float lo, float hi) { unsigned r; asm volatile("v_cvt_pk_bf16_f32 %0, %1, %2" : "=v"(r) : "v"(lo), "v"(hi)); return r; }
__device__ __forceinline__ float bf_lo(unsigned u) { return __uint_as_float(u << 16); }
__device__ __forceinline__ float bf_hi(unsigned u) { return __uint_as_float(u & 0xffff0000u); }
__device__ __forceinline__ f32x2 bf_unpack(unsigned u) { return (f32x2){bf_lo(u), bf_hi(u)}; }
__device__ __forceinline__ float sigmoid_f(float x) { return __builtin_amdgcn_rcpf(1.0f + __expf(-x)); }
__device__ __forceinline__ float silu_f(float x) { return x * sigmoid_f(x); }
__device__ __forceinline__ u32x4 pack8(f32x4 a, f32x4 b) { return (u32x4){cvt_pk_bf16(a[0], a[1]), cvt_pk_bf16(a[2], a[3]), cvt_pk_bf16(b[0], b[1]), cvt_pk_bf16(b[2], b[3])}; }
__device__ __forceinline__ float wave_sum(float v) {
#pragma unroll
    for (int o = 32; o > 0; o >>= 1) v += __shfl_xor(v, o);
    return v;
}


#define XB_TMO      128
#define XB_XCNT(j)  (256  + 64 * (j))
#define XB_XSUB(j)  (1280 + 64 * (j))
#define XB_XGEN(j)  (2304 + 64 * (j))
#define XB_TOP      3328
#define XB_TOPGEN   3392
#define XB_XLOC(j)  (3520 + 64 * (j))
#define XCD_BAR_WORDS 4608
#define XB_SPIN_CAP (1u << 18)
__device__ __forceinline__ unsigned xb_ld(unsigned* p)              { return __hip_atomic_load(p, __ATOMIC_RELAXED, __HIP_MEMORY_SCOPE_AGENT); }
__device__ __forceinline__ unsigned xb_add(unsigned* p, unsigned v) { return __hip_atomic_fetch_add(p, v, __ATOMIC_RELAXED, __HIP_MEMORY_SCOPE_AGENT); }
__device__ __forceinline__ unsigned xb_xcc_id() { return (unsigned)__builtin_amdgcn_s_getreg((3 << 11) | 20) & 0xFu; }
#define XB_SPIN(cond, bar) do { unsigned _sp = 0; while (cond) { __builtin_amdgcn_s_sleep(1); \
    if ((++_sp & 255u) == 0u) { if (xb_ld(&(bar)[XB_TMO])) break; if (_sp > XB_SPIN_CAP) { atomicAdd(&(bar)[XB_TMO], 1u); break; } } } } while (0)
struct XcdBarrier { unsigned* bar; unsigned x; volatile LAS unsigned* st; };
__device__ __forceinline__ XcdBarrier xcd_barrier_post(unsigned* bar, volatile LAS unsigned* st) {
    XcdBarrier b; b.bar = bar; b.x = xb_xcc_id(); b.st = st;
    if (threadIdx.x == 0) st[2] = xb_add(&bar[XB_XCNT(b.x)], 1u);
    return b;
}
__device__ __forceinline__ void xcd_barrier_complete(unsigned* bar, unsigned x, unsigned& nloc, unsigned& nx, unsigned& uni) {
    const unsigned G = gridDim.x * gridDim.y * gridDim.z;
    unsigned sum, cnt, mine, sp = 0u;
    for (;;) {
        sum = 0u; cnt = 0u; mine = 0u; uni = 1u;
#pragma unroll
        for (unsigned j = 0; j < 16; ++j) { const unsigned c = xb_ld(&bar[XB_XCNT(j)]); sum += c; cnt += (c > 0u) ? 1u : 0u; mine = (j == x) ? c : mine; uni = (c == (j < 8 ? 32u : 0u)) ? uni : 0u; }
        if (sum == G) break;
        __builtin_amdgcn_s_sleep(1);
        if ((++sp & 255u) == 0u) { if (xb_ld(&bar[XB_TMO])) break; if (sp > XB_SPIN_CAP) { atomicAdd(&bar[XB_TMO], 1u); break; } }
    }
    nloc = mine > 0u ? mine : 1u; nx = cnt > 0u ? cnt : 1u; uni = (sum == G) ? uni : 0u;
}
template <class Hook>
__device__ __forceinline__ void xcd_barrier(const XcdBarrier& b, const Hook& hook) {
    asm volatile("s_waitcnt vmcnt(0)" ::: "memory");
    __syncthreads();
    if (threadIdx.x >= 64) hook();
    if (threadIdx.x == 0) {
        unsigned* bar = b.bar;
        __builtin_amdgcn_s_waitcnt(0);
        unsigned nloc = b.st[0], nx = b.st[1];
        if (nloc == 0u) { unsigned uni; xcd_barrier_complete(bar, b.x, nloc, nx, uni); b.st[0] = nloc; b.st[1] = nx; b.st[3] = uni; }
        const unsigned old = xb_add(&bar[XB_XSUB(b.x)], 1u);
        const unsigned gen = old / nloc;
        if (old + 1u == (gen + 1u) * nloc) {
            __builtin_amdgcn_fence(__ATOMIC_RELEASE, "agent");
            asm volatile("s_waitcnt vmcnt(0)" ::: "memory");
            const unsigned og = xb_add(&bar[XB_TOP], 1u);
            const unsigned tg = og / nx;
            if (og + 1u == (tg + 1u) * nx) xb_add(&bar[XB_TOPGEN], 1u);
            else XB_SPIN(xb_ld(&bar[XB_TOPGEN]) == tg, bar);
            __builtin_amdgcn_fence(__ATOMIC_ACQUIRE, "agent");
            xb_add(&bar[XB_XGEN(b.x)], 1u);
            asm volatile("s_waitcnt vmcnt(0)" ::: "memory");
        } else {
            XB_SPIN(xb_ld(&bar[XB_XGEN(b.x)]) == gen, bar);
            __builtin_amdgcn_fence(__ATOMIC_ACQUIRE, "agent");
            asm volatile("s_waitcnt vmcnt(0)" ::: "memory");
        }
    }
    if (threadIdx.x < 64) hook();
    __syncthreads();
}
__device__ __forceinline__ void xcd_barrier(const XcdBarrier& b) { xcd_barrier(b, [] {}); }
template <class Hook>
__device__ __forceinline__ void xcc_barrier(const XcdBarrier& b, const Hook& hook) {
    asm volatile("s_waitcnt vmcnt(0)" ::: "memory");
    __syncthreads();
    if (threadIdx.x >= 64) hook();
    if (threadIdx.x == 0) {
        unsigned* w = &b.bar[XB_XLOC(b.x)];
        __builtin_amdgcn_s_waitcnt(0);
        const unsigned old = xb_add(w, 1u), target = (old / 32u + 1u) * 32u;
        XB_SPIN(xb_ld(w) < target, b.bar);
        __builtin_amdgcn_fence(__ATOMIC_ACQUIRE, "agent");
        asm volatile("s_waitcnt vmcnt(0)" ::: "memory");
    }
    if (threadIdx.x < 64) hook();
    __syncthreads();
}

namespace pg8 {
constexpr int BM = 256, BK = 64, HALF = 128, HTB = HALF * BK * 2, STAGE_BYTES = 8 * HTB, NXCD = 8, WGM = 8;
__device__ __forceinline__ int lds_byte(int r, int c) { const int st = (r >> 4) * 2 + (c >> 5), rr = r & 15, cc = c & 31, ob = rr * 64 + cc * 2; return st * 1024 + (ob ^ (((ob >> 9) & 1) << 5)); }
__device__ __forceinline__ void stage_rc(int b, int& R, int& C) { const int st = b / 1024, sb = b % 1024, swz = sb ^ (((sb >> 9) & 1) << 5); R = (st >> 1) * 16 + swz / 64; C = (st & 1) * 32 + (swz % 64) / 2; }
__device__ __forceinline__ int perm32(int rho) { const int n = rho >> 4, i = rho & 15; return 8 * (i >> 2) + 4 * n + (i & 3); }

struct Unit { const char* A; const char* B; int pm, pn, nt, kind; };

__device__ __forceinline__ bool tile_order(int i, int G, int c, int nM, int nN, int& pm, int& pn) {
    const int nwg = nM * nN; const long L = (long)i * G + c; if (L >= nwg) return false;
    int wgid = (int)L; { const int q = nwg / NXCD, r = nwg % NXCD, xcd = wgid % NXCD, off = wgid / NXCD; wgid = (xcd < r ? xcd * (q + 1) : r * (q + 1) + (xcd - r) * q) + off; }
    const int nig = WGM * nN, gid = wgid / nig, fm = gid * WGM, gsz = (nM - fm) < WGM ? (nM - fm) : WGM;
    pm = fm + ((wgid % nig) % gsz); pn = (wgid % nig) / gsz; return true;
}

template <class Epi, class Sched>
__device__ __forceinline__ void gemm_phase(LAS unsigned char* lds, const int lda, const int ldb, const Sched& S, const Epi& E, f32x4 (&acc)[2][2][4][2]) {
    int tid_ = threadIdx.x; asm volatile("" : "+v"(tid_));
    const int tid = tid_, wid = __builtin_amdgcn_readfirstlane(tid >> 6), lane = tid & 63, wr = wid >> 2, wc = wid & 3, fr = lane & 15, fq = lane >> 4;
    unsigned voffA[2], voffB[2];
#pragma unroll
    for (int i = 0; i < 2; ++i) { int R, C; stage_rc(tid * 16 + i * 8192, R, C); const int Rb = Epi::PERM ? ((R & ~31) + perm32(R & 31)) : R;
        voffA[i] = (unsigned)(R * lda + C) * 2u; voffB[i] = (unsigned)(Rb * ldb + C) * 2u; }
    const size_t kstep = (size_t)(BK * 2);
    const size_t hstepA = (size_t)HALF * lda * 2, hstepB = (size_t)HALF * ldb * 2;
    const unsigned ldsw = (unsigned)wid * 1024u;
    const int aoff = lds_byte(wr * 64 + fr, fq * 8), boff = lds_byte(wc * 32 + fr, fq * 8);
#define PG8_SA(b, h) (((b) * 2 + (h)) * HTB)
#define PG8_SB(b, h) ((4 + (b) * 2 + (h)) * HTB)
#define PG8_STAGE(bufoff, gbase, voff) do { _Pragma("unroll") for (int _i = 0; _i < 2; ++_i) \
        __builtin_amdgcn_global_load_lds((const unsigned*)((const char*)(gbase) + (voff)[_i]), (LAS unsigned*)(lds + (bufoff) + ldsw + _i * 8192), 16, 0, 0); } while (0)
#define PG8_LDA(dst, b, h) do { _Pragma("unroll") for (int m = 0; m < 4; ++m) _Pragma("unroll") for (int k = 0; k < 2; ++k) dst[m][k] = *(const LAS bf16x8*)(lds + PG8_SA(b, h) + aoff + m * 2048 + k * 1024); } while (0)
#define PG8_LDB(dst, b, h) do { _Pragma("unroll") for (int n = 0; n < 2; ++n) _Pragma("unroll") for (int k = 0; k < 2; ++k) dst[n][k] = *(const LAS bf16x8*)(lds + PG8_SB(b, h) + boff + n * 2048 + k * 1024); } while (0)
#define PG8_MMA(ai, bj, At, Bt) do { __builtin_amdgcn_s_setprio(1); _Pragma("unroll") for (int m = 0; m < 4; ++m) _Pragma("unroll") for (int n = 0; n < 2; ++n) _Pragma("unroll") for (int k = 0; k < 2; ++k) \
        acc[ai][bj][m][n] = __builtin_amdgcn_mfma_f32_16x16x32_bf16(Bt[n][k], At[m][k], acc[ai][bj][m][n], 0, 0, 0); __builtin_amdgcn_s_setprio(0); } while (0)
#define PG8_WAIT_V(n) asm volatile("s_waitcnt vmcnt(" #n ")" ::: "memory")
#define PG8_WAIT_L(n) asm volatile("s_waitcnt lgkmcnt(" #n ")" ::: "memory")
#define PG8_BAR __builtin_amdgcn_s_barrier()
#define PG8_SCHED __builtin_amdgcn_sched_barrier(0)
    Unit cur, nxt; int ui = 0;
    if (!S.next(0, cur)) return;
    if constexpr (!Epi::EXT_INIT) E.init(acc, cur, wr, wc, fr, fq);
    bf16x8 At[4][2], B0[2][2], B1[2][2];
    const char* cA = cur.A; const char* cB = cur.B;
    PG8_STAGE(PG8_SB(0, 0), cB, voffB); PG8_STAGE(PG8_SA(0, 0), cA, voffA); PG8_STAGE(PG8_SB(0, 1), cB + hstepB, voffB); PG8_STAGE(PG8_SA(0, 1), cA + hstepA, voffA);
    if (wr == 1) PG8_BAR;
    PG8_WAIT_V(4); PG8_BAR;
    PG8_STAGE(PG8_SB(1, 0), cB + kstep, voffB); PG8_STAGE(PG8_SA(1, 0), cA + kstep, voffA); PG8_STAGE(PG8_SB(1, 1), cB + hstepB + kstep, voffB);
    PG8_WAIT_V(6); PG8_BAR;
    for (;;) {
        const bool has_next = S.next(ui + 1, nxt);
        const char* nA = has_next ? nxt.A : cA; const char* nB = has_next ? nxt.B : cB;
        const int nt = cur.nt;
        for (int t = 0; t < nt; t += 2) {
            const bool last = (t == nt - 2);
            const char* a1 = cA + (size_t)(t + 1) * kstep;
            const char* a2 = last ? nA : cA + (size_t)(t + 2) * kstep; const char* b2 = last ? nB : cB + (size_t)(t + 2) * kstep;
            const char* a3 = a2 + kstep; const char* b3 = b2 + kstep;
            PG8_LDB(B0, 0, 0); PG8_SCHED; PG8_LDA(At, 0, 0); PG8_STAGE(PG8_SA(1, 1), a1 + hstepA, voffA);
            PG8_WAIT_L(8); PG8_BAR; PG8_WAIT_L(0); PG8_MMA(0, 0, At, B0); PG8_BAR; PG8_SCHED;
            PG8_LDB(B1, 0, 1); PG8_STAGE(PG8_SB(0, 0), b2, voffB);
            PG8_BAR; PG8_WAIT_L(0); PG8_MMA(0, 1, At, B1); PG8_BAR;
            PG8_LDA(At, 0, 1); PG8_STAGE(PG8_SA(0, 0), a2, voffA);
            PG8_BAR; PG8_WAIT_L(0); PG8_MMA(1, 0, At, B0); PG8_BAR; PG8_SCHED;
            PG8_STAGE(PG8_SB(0, 1), b2 + hstepB, voffB);
            PG8_WAIT_V(6); PG8_BAR; PG8_MMA(1, 1, At, B1); PG8_BAR;
            PG8_LDB(B0, 1, 0); PG8_SCHED; PG8_LDA(At, 1, 0); PG8_STAGE(PG8_SA(0, 1), a2 + hstepA, voffA);
            PG8_WAIT_L(8); PG8_BAR; PG8_WAIT_L(0); PG8_MMA(0, 0, At, B0); PG8_BAR; PG8_SCHED;
            PG8_LDB(B1, 1, 1); PG8_STAGE(PG8_SB(1, 0), b3, voffB);
            PG8_BAR; PG8_WAIT_L(0); PG8_MMA(0, 1, At, B1); PG8_BAR;
            PG8_LDA(At, 1, 1); PG8_STAGE(PG8_SA(1, 0), a3, voffA);
            PG8_BAR; PG8_WAIT_L(0); PG8_MMA(1, 0, At, B0); PG8_BAR; PG8_SCHED;
            PG8_STAGE(PG8_SB(1, 1), b3 + hstepB, voffB);
            PG8_WAIT_V(6); PG8_BAR; PG8_MMA(1, 1, At, B1); PG8_BAR;
        }
        if constexpr (!Epi::AFTER_DRAIN) { E(acc, cur, wr, wc, fr, fq); S.done(cur, ui, lane); }
        if (!has_next) break;
        cur = nxt; cA = nA; cB = nB; ++ui;
        E.init(acc, cur, wr, wc, fr, fq);
    }
    PG8_WAIT_V(0);
    if (wr == 0) PG8_BAR;
    PG8_BAR;
    if constexpr (Epi::AFTER_DRAIN) E.fused(acc, cur, wr, wc, fr, fq, lds, tid);
#undef PG8_SA
#undef PG8_SB
#undef PG8_STAGE
#undef PG8_LDA
#undef PG8_LDB
#undef PG8_MMA
#undef PG8_WAIT_V
#undef PG8_WAIT_L
#undef PG8_BAR
#undef PG8_SCHED
}
}

struct SchedP1 {
    const char* xb; const char* win; unsigned* cnt; int gx, gl; bool uni;
    __device__ __forceinline__ bool next(int i, pg8::Unit& u) const {
        const int n_s = gx < 2 ? 2 : 1, j = gl + 32 * i; if (j >= 80 + n_s) return false;
        int pm, pn, kind;
        if (j < n_s) { pm = NPROMPT / 256; pn = gx + 8 * j; kind = 2; }
        else if (j < n_s + 48) { const int k = j - n_s, q = k >> 3; pm = 8 * gx + (k & 7); pn = q < 2 ? q : q + 2; kind = 1; }
        else { const int k = j - n_s - 48, q = k >> 3; pm = 8 * gx + (k & 7); pn = q < 2 ? q + 2 : q + 6; kind = 0; }
        u.pm = pm; u.pn = pn; u.kind = kind; u.nt = 16; u.A = xb + (size_t)pm * 256 * DM * 2; u.B = win + (size_t)pn * 256 * DM * 2; return true;
    }
    __device__ __forceinline__ void done(const pg8::Unit&, int ui, int lane) const {
        const int n_s = gx < 2 ? 2 : 1, nuv = gl < n_s + 16 ? 2 : 1;
        if (ui != nuv - 1) return;
        asm volatile("s_waitcnt vmcnt(0)" ::: "memory");
        if (lane == 0) { const int sm = gl < n_s ? 1 : 0, uv = nuv - sm;
            if (!uni) { __builtin_amdgcn_fence(__ATOMIC_RELEASE, "agent"); asm volatile("s_waitcnt vmcnt(0)" ::: "memory"); }
            (void)xb_add(cnt + 64 * (CW_RV + gx), (unsigned)uv);
            if (sm) (void)xb_add(cnt + 64 * (CW_SV + gx), 1u); }
    }
};
struct EpiP1 {
    static constexpr bool PERM = true, AFTER_DRAIN = false, EXT_INIT = false;
    bf16_t* U; bf16_t* SGP; bf16_t* V; bf16_t* SGC; float* out;
    __device__ __forceinline__ void init(f32x4 (&acc)[2][2][4][2], const pg8::Unit&, int, int, int, int) const {
#pragma unroll
        for (int a = 0; a < 2; ++a)
#pragma unroll
            for (int b = 0; b < 2; ++b)
#pragma unroll
                for (int m = 0; m < 4; ++m)
#pragma unroll
                    for (int n = 0; n < 2; ++n) acc[a][b][m][n] = (f32x4){0.f, 0.f, 0.f, 0.f};
    }
    __device__ __forceinline__ void operator()(const f32x4 (&acc)[2][2][4][2], const pg8::Unit& u, int wr, int wc, int fr, int fq) const {
        const int pn = u.pn, row0 = u.pm * 256 + wr * 64 + fr, cl = wc * 32 + 8 * fq;
        if (pn < 2) {
#pragma unroll
            for (int ai = 0; ai < 2; ++ai)
#pragma unroll
                for (int m = 0; m < 4; ++m) {
                    const int r = row0 + ai * 128 + m * 16; bool st; size_t so;
                    if (r < NPROMPT) { const int t = r & (SEQ - 1); st = t >= SEQ - 15; so = O_SPP + ((size_t)(r >> 12) * 15 + (t - (SEQ - 15))) * 512; }
                    else { const int s = r - NPROMPT, t = s & 15; st = t >= 1; so = O_SPS + ((size_t)(s >> 4) * 15 + (t - 1)) * 512; }
#pragma unroll
                    for (int bj = 0; bj < 2; ++bj) { const int c = pn * 256 + bj * 128 + cl; const f32x4 v0 = acc[ai][bj][m][0], v1 = acc[ai][bj][m][1];
                        *(u32x4*)(U + (size_t)r * DH + c) = pack8(v0, v1);
                        if (st) { *(f32x4*)(out + so + c) = v0; *(f32x4*)(out + so + c + 4) = v1; } }
                }
        } else if (pn < 4 || pn >= 8) {
            bf16_t* dst = pn < 4 ? SGP : SGC; const int cb = (pn < 4 ? pn - 2 : pn - 8) * 256 + cl;
#pragma unroll
            for (int ai = 0; ai < 2; ++ai)
#pragma unroll
                for (int m = 0; m < 4; ++m) { const int r = row0 + ai * 128 + m * 16;
#pragma unroll
                    for (int bj = 0; bj < 2; ++bj) { f32x4 v0 = acc[ai][bj][m][0], v1 = acc[ai][bj][m][1];
#pragma unroll
                        for (int j = 0; j < 4; ++j) { v0[j] = silu_f(v0[j]); v1[j] = silu_f(v1[j]); }
                        *(u32x4*)(dst + (size_t)r * DH + cb + bj * 128) = pack8(v0, v1); }
                }
        } else {
            const int c = (pn - 4) * 128 + cl;
#pragma unroll
            for (int ai = 0; ai < 2; ++ai)
#pragma unroll
                for (int m = 0; m < 4; ++m) {
                    const int r = row0 + ai * 128 + m * 16; bool st; size_t so;
                    if (r < NPROMPT) { const int t = r & (SEQ - 1); st = t >= SEQ - 30; so = O_SCP + ((size_t)(r >> 12) * 30 + (t - (SEQ - 30))) * 512; }
                    else { const int s = r - NPROMPT, t = s & 15; st = true; so = O_SCS + ((size_t)(s >> 4) * 30 + 14 + t) * 512; }
                    f32x4 v0 = acc[ai][0][m][0], v1 = acc[ai][0][m][1]; const f32x4 g0 = acc[ai][1][m][0], g1 = acc[ai][1][m][1];
#pragma unroll
                    for (int j = 0; j < 4; ++j) { v0[j] *= sigmoid_f(g0[j]); v1[j] *= sigmoid_f(g1[j]); }
                    *(u32x4*)(V + (size_t)r * DH + c) = pack8(v0, v1);
                    if (st) { *(f32x4*)(out + so + c) = v0; *(f32x4*)(out + so + c + 4) = v1; }
                }
        }
    }
};

struct SchedP3 {
    const char* pc; const char* mix; const char* pw; int pm0, pn0;
    __device__ __forceinline__ void done(const pg8::Unit&, int, int) const {}
    __device__ __forceinline__ bool next(int i, pg8::Unit& u) const {
        if (i != 0) return false; const int pm = pm0, pn = pn0;
        u.pm = pm; u.pn = pn; u.kind = 0;
        if (pn < 2) { u.nt = 4; u.A = pc + ((size_t)pm * 256 * DM + 256 * pn) * 2; u.B = mix + ((size_t)pn * 256 * 512 + 256 * pn) * 2; }
        else { u.nt = 8; u.A = pc + ((size_t)pm * 256 * DM + 512) * 2; u.B = pw + (size_t)(pn - 2) * 256 * 512 * 2; }
        return true;
    }
};
struct EpiP3 {
    static constexpr bool PERM = true, AFTER_DRAIN = false, EXT_INIT = false;
    const bf16_t* SGP; const bf16_t* SGC; const float* pw_b; bf16_t* Z;
    __device__ __forceinline__ void init(f32x4 (&acc)[2][2][4][2], const pg8::Unit&, int, int, int, int) const {
#pragma unroll
        for (int a = 0; a < 2; ++a)
#pragma unroll
            for (int b = 0; b < 2; ++b)
#pragma unroll
                for (int m = 0; m < 4; ++m)
#pragma unroll
                    for (int n = 0; n < 2; ++n) acc[a][b][m][n] = (f32x4){0.f, 0.f, 0.f, 0.f};
    }
    __device__ __forceinline__ void operator()(const f32x4 (&acc)[2][2][4][2], const pg8::Unit& u, int wr, int wc, int fr, int fq) const {
        const int pn = u.pn, row0 = u.pm * 256 + wr * 64 + fr, cl = wc * 32 + 8 * fq;
        const bool conv = pn >= 2; const bf16_t* gate = conv ? SGC : SGP; const int cb = (conv ? pn - 2 : pn) * 256 + cl;
        f32x4 bv[2][2];
#pragma unroll
        for (int bj = 0; bj < 2; ++bj)
#pragma unroll
            for (int n = 0; n < 2; ++n) bv[bj][n] = conv ? *(const f32x4*)(pw_b + cb + bj * 128 + 4 * n) : (f32x4){0.f, 0.f, 0.f, 0.f};
#pragma unroll
        for (int ai = 0; ai < 2; ++ai) {
            u32x4 gt[4][2];
#pragma unroll
            for (int m = 0; m < 4; ++m)
#pragma unroll
                for (int bj = 0; bj < 2; ++bj) gt[m][bj] = *(const u32x4*)(gate + (size_t)(row0 + ai * 128 + m * 16) * DH + cb + bj * 128);
#pragma unroll
            for (int m = 0; m < 4; ++m) { const int r = row0 + ai * 128 + m * 16;
#pragma unroll
                for (int bj = 0; bj < 2; ++bj) { const int c = cb + bj * 128; const u32x4 g = gt[m][bj];
                    f32x4 v0 = acc[ai][bj][m][0] + bv[bj][0], v1 = acc[ai][bj][m][1] + bv[bj][1];
                    v0[0] *= bf_lo(g[0]); v0[1] *= bf_hi(g[0]); v0[2] *= bf_lo(g[1]); v0[3] *= bf_hi(g[1]);
                    v1[0] *= bf_lo(g[2]); v1[1] *= bf_hi(g[2]); v1[2] *= bf_lo(g[3]); v1[3] *= bf_hi(g[3]);
                    *(u32x4*)(Z + (size_t)r * DM + (conv ? 512 : 0) + c) = pack8(v0, v1); }
            }
        }
    }
};

struct SchedP4 {
    const char* z; const char* wout; int pm0, pn0;
    __device__ __forceinline__ void done(const pg8::Unit&, int, int) const {}
    __device__ __forceinline__ bool next(int i, pg8::Unit& u) const {
        if (i != 0) return false; const int pm = pm0, pn = pn0;
        u.pm = pm; u.pn = pn; u.kind = 0; u.nt = 16; u.A = z + (size_t)pm * 256 * DM * 2; u.B = wout + (size_t)pn * 256 * DM * 2; return true;
    }
};
struct EpiP4 {
    static constexpr bool PERM = false, AFTER_DRAIN = true, EXT_INIT = true;
    const float* x_prompt; const float* final_g; float* out; float* xs; unsigned* cnt; const float* ss; int srow; bool uni;
    __device__ __forceinline__ void init(f32x4 (&acc)[2][2][4][2], const pg8::Unit& u, int wr, int wc, int fr, int fq) const {
        const int row0 = u.pm * 256 + wr * 64 + fr, col0 = u.pn * 256 + wc * 32 + 4 * fq;
#pragma unroll
        for (int ai = 0; ai < 2; ++ai)
#pragma unroll
            for (int m = 0; m < 4; ++m) { const float* xr = x_prompt + (size_t)(row0 + ai * 128 + m * 16) * DM + col0;
#pragma unroll
                for (int bj = 0; bj < 2; ++bj)
#pragma unroll
                    for (int n = 0; n < 2; ++n) acc[ai][bj][m][n] = *(const f32x4*)(xr + bj * 128 + n * 16); }
    }
    __device__ __forceinline__ void fused(const f32x4 (&acc)[2][2][4][2], const pg8::Unit& u, int wr, int wc, int fr, int fq, LAS unsigned char* lds, int tid) const {
        LAS float* lss = (LAS float*)lds;
#pragma unroll
        for (int ai = 0; ai < 2; ++ai)
#pragma unroll
            for (int m = 0; m < 4; ++m) { float s = 0.f;
#pragma unroll
                for (int bj = 0; bj < 2; ++bj)
#pragma unroll
                    for (int n = 0; n < 2; ++n) { const f32x4 y = acc[ai][bj][m][n]; s += y[0] * y[0] + y[1] * y[1] + y[2] * y[2] + y[3] * y[3]; }
                s += __shfl_xor(s, 16); s += __shfl_xor(s, 32);
                if (fq == 0) lss[(ai * 128 + wr * 64 + m * 16 + fr) * 4 + wc] = s; }
        __syncthreads();
        if (tid < 256) { const f32x4 v = *(const LAS f32x4*)(lss + tid * 4); xs[((size_t)u.pm * 4 + u.pn) * 256 + tid] = v[0] + v[1] + v[2] + v[3]; }
        asm volatile("s_waitcnt vmcnt(0)" ::: "memory");
        __syncthreads();
        if (tid == 0) {
            unsigned* cw = cnt + 64 * u.pm; unsigned* cs = cnt + 64 * CW_PIECES;
            if (!uni) __builtin_amdgcn_fence(__ATOMIC_RELEASE, "agent");
            asm volatile("s_waitcnt vmcnt(0)" ::: "memory");
            (void)xb_add(cw, 1u);
            unsigned sp = 0u;
            while (xb_ld(cw) < 4u || xb_ld(cs) < 256u) { __builtin_amdgcn_s_sleep(1); if (++sp > (1u << 22)) break; }
            __builtin_amdgcn_fence(__ATOMIC_ACQUIRE, "agent");
            asm volatile("s_waitcnt vmcnt(0)" ::: "memory");
        }
        __syncthreads();
        if (tid >= 256) { const int t4 = (tid - 256) * 4; const float rs = rsqrtf(ss[srow] * (1.0f / DM) + 1e-6f); float* yr = out + (size_t)srow * DM + t4;
            *(f32x4*)yr = *(const f32x4*)yr * rs * *(const f32x4*)(final_g + t4); }
        if (tid < 256) { const float* xp = xs + (size_t)u.pm * 4 * 256 + tid; const float tot = xp[0] + xp[256] + xp[512] + xp[768];
            lss[1024 + tid] = rsqrtf(tot * (1.0f / DM) + 1e-6f); }
        __syncthreads();
        const int row0 = u.pm * 256 + wr * 64 + fr, col0 = u.pn * 256 + wc * 32 + 4 * fq;
        f32x4 g4[2][2];
#pragma unroll
        for (int bj = 0; bj < 2; ++bj)
#pragma unroll
            for (int n = 0; n < 2; ++n) g4[bj][n] = *(const f32x4*)(final_g + col0 + bj * 128 + n * 16);
#pragma unroll
        for (int ai = 0; ai < 2; ++ai)
#pragma unroll
            for (int m = 0; m < 4; ++m) { const float rs = lss[1024 + ai * 128 + wr * 64 + m * 16 + fr]; float* yr = out + (size_t)(row0 + ai * 128 + m * 16) * DM + col0;
#pragma unroll
                for (int bj = 0; bj < 2; ++bj)
#pragma unroll
                    for (int n = 0; n < 2; ++n) *(f32x4*)(yr + bj * 128 + n * 16) = acc[ai][bj][m][n] * rs * g4[bj][n]; }
    }
    __device__ __forceinline__ void operator()(const f32x4 (&)[2][2][4][2], const pg8::Unit&, int, int, int, int) const {}
};

template <int NF>
__device__ __forceinline__ f32x4 small_gemm(const bf16_t* __restrict__ A, int lda, const bf16_t* __restrict__ Bt, int ldb, int K, int nw, f32x4* red) {
    const int tid = threadIdx.x, wid = tid >> 6, lane = tid & 63, fr = lane & 15, fq = lane >> 4;
    f32x4 acc[NF];
#pragma unroll
    for (int f = 0; f < NF; ++f) acc[f] = (f32x4){0.f, 0.f, 0.f, 0.f};
    if (wid < nw) { const int ks = K / nw; const bf16_t* ap = A + (size_t)fr * lda + wid * ks + fq * 8; const bf16_t* bp = Bt + (size_t)fr * ldb + wid * ks + fq * 8;
        for (int k = 0; k < ks; k += 32) { const bf16x8 a = *(const bf16x8*)(ap + k);
#pragma unroll
            for (int f = 0; f < NF; ++f) { const bf16x8 b = *(const bf16x8*)(bp + (size_t)f * 16 * ldb + k); acc[f] = __builtin_amdgcn_mfma_f32_16x16x32_bf16(b, a, acc[f], 0, 0, 0); } } }
#pragma unroll
    for (int f = 0; f < NF; ++f) red[(wid * NF + f) * 64 + lane] = acc[f];
    __syncthreads();
    f32x4 r = (f32x4){0.f, 0.f, 0.f, 0.f};
    if (tid < 64 * NF) {
#pragma unroll
        for (int w = 0; w < 8; ++w) r += red[(w * NF + wid) * 64 + lane]; }
    return r;
}
__device__ __forceinline__ void sample_p3(const Params& p, unsigned char* shm, const int i) {
    const int tid = threadIdx.x, wid = tid >> 6, lane = tid & 63, fr = lane & 15, fq = lane >> 4; f32x4* red = (f32x4*)shm;
    const bf16_t* PC = (const bf16_t*)(p.ws + WS_PC); bf16_t* Z = (bf16_t*)(p.ws + WS_Z);
    { const int rb = i >> 4, cb = i & 15, row0 = NPROMPT + rb * 16, row = row0 + fr, c = 32 * cb + 16 * wid + 4 * fq;
        {
            const f32x4 r = small_gemm<2>(PC + (size_t)row0 * DM + 512, DM, (const bf16_t*)(p.ws + WS_PW) + (size_t)32 * cb * 512, 512, 512, 8, red);
            if (tid < 128) { const f32x4 bv = *(const f32x4*)(p.pw_b + c); const u32x2 g = *(const u32x2*)((const bf16_t*)(p.ws + WS_SGC) + (size_t)row * DH + c);
                const f32x4 z = (r + bv) * (f32x4){bf_lo(g[0]), bf_hi(g[0]), bf_lo(g[1]), bf_hi(g[1])};
                *(u32x2*)(Z + (size_t)row * DM + 512 + c) = (u32x2){cvt_pk_bf16(z[0], z[1]), cvt_pk_bf16(z[2], z[3])}; }
            __syncthreads();
        }
        {
            const int g128 = (cb >> 2) * 128;
            const f32x4 r = small_gemm<2>(PC + (size_t)row0 * DM + g128, DM, (const bf16_t*)(p.ws + WS_MIX) + (size_t)32 * cb * 512 + g128, 512, 128, 4, red);
            if (tid < 128) { const u32x2 g = *(const u32x2*)((const bf16_t*)(p.ws + WS_SGP) + (size_t)row * DH + c);
                const f32x4 z = r * (f32x4){bf_lo(g[0]), bf_hi(g[0]), bf_lo(g[1]), bf_hi(g[1])};
                *(u32x2*)(Z + (size_t)row * DM + c) = (u32x2){cvt_pk_bf16(z[0], z[1]), cvt_pk_bf16(z[2], z[3])}; }
            __syncthreads();
        }
    }
}
__device__ __forceinline__ void sample_p4(const Params& p, unsigned char* shm, const int i) {
    const int tid = threadIdx.x, wid = tid >> 6, lane = tid & 63, fr = lane & 15, fq = lane >> 4; f32x4* red = (f32x4*)shm;
    float* ss = (float*)(p.ws + WS_SS);
    { const int rb = i >> 4, cb = i & 15, row0 = NPROMPT + rb * 16, row = row0 + fr, c = 64 * cb + 16 * wid + 4 * fq;
        const f32x4 r = small_gemm<4>((const bf16_t*)(p.ws + WS_Z) + (size_t)row0 * DM, DM, (const bf16_t*)(p.ws + WS_WOUT) + (size_t)64 * cb * DM, DM, DM, 8, red);
        if (tid < 256) { const f32x4 y = r + *(const f32x4*)(p.x_sample + (size_t)(row - NPROMPT) * DM + c);
            *(f32x4*)(p.out + (size_t)row * DM + c) = y;
            float s = y[0] * y[0] + y[1] * y[1] + y[2] * y[2] + y[3] * y[3]; s += __shfl_xor(s, 16); s += __shfl_xor(s, 32);
            if (fq == 0) atomicAdd(ss + row, s); }
        asm volatile("s_waitcnt vmcnt(0)" ::: "memory");
        __syncthreads();
        if (tid == 0) { __builtin_amdgcn_fence(__ATOMIC_RELEASE, "agent"); asm volatile("s_waitcnt vmcnt(0)" ::: "memory"); (void)xb_add((unsigned*)(p.ws + WS_CNT) + 64 * CW_PIECES, 1u); }
    }
}
__device__ __forceinline__ void transpose_load(const float* __restrict__ src, int ldsrc, int k0, int n0s, f32x4 (&v)[2]) {
    const int tid = threadIdx.x, kk = tid >> 4, n4 = (tid & 15) * 4;
#pragma unroll
    for (int i = 0; i < 2; ++i) v[i] = *(const f32x4*)(src + (size_t)(k0 + kk + 32 * i) * ldsrc + n0s + n4);
}
__device__ __forceinline__ void transpose_store(const f32x4 (&v)[2], int k0, bf16_t* __restrict__ dst, int ldd, int n0d, float* tile) {
    const int tid = threadIdx.x;
    {
        const int kk = tid >> 4, n4 = (tid & 15) * 4;
#pragma unroll
        for (int i = 0; i < 2; ++i) { const int k = kk + 32 * i;
            tile[k * 65 + n4 + 0] = v[i][0]; tile[k * 65 + n4 + 1] = v[i][1]; tile[k * 65 + n4 + 2] = v[i][2]; tile[k * 65 + n4 + 3] = v[i][3]; }
    }
    __syncthreads();
    {
        const int n = tid >> 3, k8 = (tid & 7) * 8; float w[8];
#pragma unroll
        for (int j = 0; j < 8; ++j) w[j] = tile[(k8 + j) * 65 + n];
        *(u32x4*)(dst + (size_t)(n0d + n) * ldd + k0 + k8) = (u32x4){cvt_pk_bf16(w[0], w[1]), cvt_pk_bf16(w[2], w[3]), cvt_pk_bf16(w[4], w[5]), cvt_pk_bf16(w[6], w[7])};
    }
    __syncthreads();
}
__device__ __forceinline__ void transpose_tile(const float* __restrict__ src, int ldsrc, int k0, int n0s, bf16_t* __restrict__ dst, int ldd, int n0d, float* tile) {
    f32x4 v[2]; transpose_load(src, ldsrc, k0, n0s, v); transpose_store(v, k0, dst, ldd, n0d, tile);
}
__device__ __forceinline__ int win_src_col(int n0) {
    if (n0 >= 1024 && n0 < 2048) { const int q = n0 - 1024, j = q >> 8, i = q & 255; return i < 128 ? 1024 + 128 * j + i : 1536 + 128 * j + (i - 128); }
    return n0;
}

__device__ __forceinline__ void phase_prep(const Params& p, unsigned char* shm) {
    const int tid = threadIdx.x, wid = tid >> 6, lane = tid & 63, nb = gridDim.x, bid = blockIdx.x;
    bf16_t* xb = (bf16_t*)(p.ws + WS_XB);
    constexpr int T_IN = 16 * 40;
    f32x4 tv[3][2];
#pragma unroll
    for (int q = 0; q < 3; ++q) { const int t = bid + q * nb; if (t < T_IN) transpose_load(p.w_in, DIN, (t / 40) * 64, win_src_col((t % 40) * 64), tv[q]); }
    {
        f32x4 g4[4];
#pragma unroll
        for (int i = 0; i < 4; ++i) g4[i] = *(const f32x4*)(p.norm_g + lane * 4 + 256 * i);
        for (int g = bid * 8 + wid; g < MT / 4; g += nb * 8) {
            f32x4 v[4][4]; float s[4];
#pragma unroll
            for (int q = 0; q < 4; ++q) { const int r = g * 4 + q; const float* xr = r < NPROMPT ? p.x_prompt + (size_t)r * DM : p.x_sample + (size_t)(r - NPROMPT) * DM;
#pragma unroll
                for (int i = 0; i < 4; ++i) v[q][i] = *(const f32x4*)(xr + lane * 4 + 256 * i); }
#pragma unroll
            for (int q = 0; q < 4; ++q) { s[q] = 0.f;
#pragma unroll
                for (int i = 0; i < 4; ++i) s[q] += v[q][i][0] * v[q][i][0] + v[q][i][1] * v[q][i][1] + v[q][i][2] * v[q][i][2] + v[q][i][3] * v[q][i][3];
                s[q] = wave_sum(s[q]); }
#pragma unroll
            for (int q = 0; q < 4; ++q) { const int r = g * 4 + q; const float rs = rsqrtf(s[q] * (1.0f / DM) + 1e-6f);
#pragma unroll
                for (int i = 0; i < 4; ++i) { const f32x4 h = v[q][i] * rs * g4[i];
                    *(u32x2*)(xb + (size_t)r * DM + lane * 4 + 256 * i) = (u32x2){cvt_pk_bf16(h[0], h[1]), cvt_pk_bf16(h[2], h[3])}; } }
        }
    }
    {
        float* tile = (float*)shm; bf16_t* win = (bf16_t*)(p.ws + WS_WIN);
#pragma unroll
        for (int q = 0; q < 3; ++q) { const int t = bid + q * nb; if (t < T_IN) transpose_store(tv[q], (t / 40) * 64, win, DM, (t % 40) * 64, tile); }
        for (int t = bid + 3 * nb; t < T_IN; t += nb) transpose_tile(p.w_in, DIN, (t / 40) * 64, win_src_col((t % 40) * 64), win, DM, (t % 40) * 64, tile);
    }
    float* ss = (float*)(p.ws + WS_SS);
    for (int i = bid * 512 + tid; i < MT; i += nb * 512) ss[i] = 0.f;
    for (int i = bid * 512 + tid; i < 16 * 14 * 128; i += nb * 512) { const int c4 = i & 127, rr = i >> 7, b = rr / 14, j = rr % 14;
        *(f32x4*)(p.out + O_SCS + ((size_t)b * 30 + j) * 512 + c4 * 4) = *(const f32x4*)(p.cache_conv + ((size_t)b * 30 + 16 + j) * 512 + c4 * 4); }
}

__device__ __forceinline__ void late_weight_prep(const Params& p, unsigned char* shm, const int bid, const int nb) {
    const int tid = threadIdx.x; float* tile = (float*)shm;
    bf16_t* pw = (bf16_t*)(p.ws + WS_PW); bf16_t* wout = (bf16_t*)(p.ws + WS_WOUT); bf16_t* mix = (bf16_t*)(p.ws + WS_MIX);
    constexpr int T_OUT = 16 * 16, T_PW = 8 * 8;
    for (int t = bid; t < T_OUT + T_PW; t += nb) {
        if (t < T_OUT) transpose_tile(p.w_out, DM, (t >> 4) * 64, (t & 15) * 64, wout, DM, (t & 15) * 64, tile);
        else { const int tt = t - T_OUT; transpose_tile(p.pw_w, 512, (tt >> 3) * 64, (tt & 7) * 64, pw, 512, (tt & 7) * 64, tile); }
    }
    for (int idx = bid * 512 + tid; idx < 512 * 512; idx += nb * 512) { const int n = idx >> 9, k = idx & 511; float v = 0.f;
        if ((n >> 7) == (k >> 7)) v = p.pool_mix[((size_t)(n >> 7) * 128 + (k & 127)) * 128 + (n & 127)] * p.pool_scale[n];
        mix[idx] = (bf16_t)(cvt_pk_bf16(v, 0.f) & 0xffffu); }
    __syncthreads();
}

#define DPP_STEP(v, ctrl) ((v) + __builtin_bit_cast(float, __builtin_amdgcn_update_dpp(0, __builtin_bit_cast(int, (v)), (ctrl), 0xf, 0xf, true)))
__device__ __forceinline__ float wave_sum_hi(float v) {
    v = DPP_STEP(v, 0xB1);
    v = DPP_STEP(v, 0x4E);
    v = DPP_STEP(v, 0x141);
    v = DPP_STEP(v, 0x140);
    v += __builtin_bit_cast(float, __builtin_amdgcn_update_dpp(0, __builtin_bit_cast(int, v), 0x142, 0xa, 0xf, false));
    v += __builtin_bit_cast(float, __builtin_amdgcn_update_dpp(0, __builtin_bit_cast(int, v), 0x143, 0xc, 0xf, false));
    return v;
}
template <int W, int TH>
__device__ __forceinline__ void pool_regs(const unsigned (&u)[TH + 15], const int pos0, bf16_t* __restrict__ dst  ) {
    f32x2 s = (f32x2){0.f, 0.f};
#pragma unroll
    for (int j = 0; j < W; ++j) s += bf_unpack(u[15 - j]);
#pragma unroll
    for (int i = 0; i < TH; ++i) { const f32x2 cur = bf_unpack(u[15 + i]); const int pos1 = pos0 + i + 1;
        const float inv = pos1 >= W ? (1.0f / W) : __builtin_amdgcn_rcpf((float)pos1);
        const f32x2 o = s * inv - cur;
        *(unsigned*)(dst + (size_t)i * DM) = cvt_pk_bf16(o[0], o[1]);
        if (i + 1 < TH) s += bf_unpack(u[16 + i]) - bf_unpack(u[16 + i - W]); }
}
template <int T>
__device__ __forceinline__ void mixer_chunk(const Params& p, unsigned char* shm, const int r0, const int t0, const int tid, const f32x2 (&w2)[31]) {
    constexpr int TH = T / 2, ROUNDS = T / 16, NV = ((T + 30) * 64 + 511) / 512;
    const int cp = tid & 255, th = tid >> 8, lane = tid & 63, wv = (tid >> 6) & 3;
    const bf16_t* U = (const bf16_t*)(p.ws + WS_U); const bf16_t* V = (const bf16_t*)(p.ws + WS_V); bf16_t* PC = (bf16_t*)(p.ws + WS_PC);
    const unsigned* l32 = (const unsigned*)shm;
    u32x4 val[NV];
    {
        const bf16_t* vb = V + (size_t)(r0 - 30) * DH;
#pragma unroll
        for (int k = 0; k < NV; ++k) { const int idx = tid + k * 512, lr = idx >> 6; val[k] = (u32x4){0u, 0u, 0u, 0u};
            if (idx < (T + 30) * 64 && t0 - 30 + lr >= 0) val[k] = *(const u32x4*)(vb + (size_t)idx * 8); }
    }
    unsigned u[TH + 15];
    {
        const int f0 = th * TH - 15; const bf16_t* ub = U + (size_t)(r0 + f0) * DH + cp * 2;
#pragma unroll
        for (int k = 0; k < TH + 15; ++k) { u[k] = 0u; if (t0 + f0 + k >= 0) u[k] = *(const unsigned*)(ub + (size_t)k * DH); }
    }
#pragma unroll
    for (int k = 0; k < NV; ++k) { const int idx = tid + k * 512; if (idx < (T + 30) * 64) *(u32x4*)(shm + (size_t)idx * 16) = val[k]; }
    const f32x2 bias = *(const f32x2*)(p.dw_b + cp * 2);
    const f32x2 g2 = *(const f32x2*)(p.ln_g + cp * 2), b2 = *(const f32x2*)(p.ln_b + cp * 2);
    __syncthreads();
    {
        bf16_t* dst = PC + (size_t)(r0 + th * TH) * DM + cp * 2; const int pos0 = t0 + th * TH;
        switch (cp >> 6) { case 0: pool_regs<2, TH>(u, pos0, dst); break; case 1: pool_regs<4, TH>(u, pos0, dst); break; case 2: pool_regs<8, TH>(u, pos0, dst); break; default: pool_regs<16, TH>(u, pos0, dst); break; }
    }
    f32x2* stats = (f32x2*)(shm + (T + 30) * 1024);
#pragma unroll 1
    for (int rd = 0; rd < ROUNDS; ++rd) {
        const int tt = rd * 16 + th * 8;
        f32x2 c[8];
#pragma unroll
        for (int i = 0; i < 8; ++i) c[i] = bias;
#pragma unroll
        for (int q = 0; q < 38; ++q) { const f32x2 v = bf_unpack(l32[(tt + q) * 256 + cp]);
#pragma unroll
            for (int i = 0; i < 8; ++i) if (q - i >= 0 && q - i < 31) c[i] += w2[q - i] * v; }
#pragma unroll
        for (int i = 0; i < 8; ++i) { const float s1 = wave_sum_hi(c[i][0] + c[i][1]), s2 = wave_sum_hi(c[i][0] * c[i][0] + c[i][1] * c[i][1]);
            if (lane == 63) stats[(tt + i) * 4 + wv] = (f32x2){s1, s2}; }
        __syncthreads();
        float mean_l, rs_l;
        { const int ti = tt + (lane & 7);
          const f32x4 sa = *(const f32x4*)(stats + ti * 4), sb = *(const f32x4*)(stats + ti * 4 + 2);
          mean_l = (sa[0] + sa[2] + sb[0] + sb[2]) * (1.0f / 512.0f);
          const float var = (sa[1] + sa[3] + sb[1] + sb[3]) * (1.0f / 512.0f) - mean_l * mean_l;
          rs_l = __builtin_amdgcn_rsqf(var + 1e-5f); }
#pragma unroll
        for (int i = 0; i < 8; ++i) {
            const float mean = __builtin_bit_cast(float, __builtin_amdgcn_readlane(__builtin_bit_cast(int, mean_l), i));
            const float rs = __builtin_bit_cast(float, __builtin_amdgcn_readlane(__builtin_bit_cast(int, rs_l), i));
            const f32x2 y = (c[i] - mean) * rs * g2 + b2;
            *(unsigned*)(PC + (size_t)(r0 + tt + i) * DM + 512 + cp * 2) = cvt_pk_bf16(silu_f(y[0]), silu_f(y[1])); }
    }
    __syncthreads();
}

__device__ __forceinline__ void sample_token(const Params& p, unsigned char* shm, const int s) {
    const int tid = threadIdx.x, wid = tid >> 6, lane = tid & 63, b = s >> 4, t = s & 15, r = NPROMPT + s, ch = tid;
    const bf16_t* U = (const bf16_t*)(p.ws + WS_U); const bf16_t* V = (const bf16_t*)(p.ws + WS_V); bf16_t* PC = (bf16_t*)(p.ws + WS_PC);
    {
        const int w = 2 << (ch >> 7); float sum = 0.f, cur = 0.f;
#pragma unroll
        for (int j = 0; j < 16; ++j) if (j < w) { const int e = t + 15 - j;
            const float v = e < 15 ? p.cache_pool[((size_t)b * 15 + e) * 512 + ch] : __uint_as_float((unsigned)U[(size_t)(NPROMPT + b * 16 + e - 15) * DH + ch] << 16);
            sum += v; if (j == 0) cur = v; }
        const float o = sum / (float)w - cur;
        PC[(size_t)r * DM + ch] = (bf16_t)(cvt_pk_bf16(o, 0.f) & 0xffffu);
    }
    float c = p.dw_b[ch];
#pragma unroll
    for (int j = 0; j < 31; ++j) { const int e = t + j;
        const float v = e < 30 ? p.cache_conv[((size_t)b * 30 + e) * 512 + ch] : __uint_as_float((unsigned)V[(size_t)(NPROMPT + b * 16 + e - 30) * DH + ch] << 16);
        c += p.dw_w[j * 512 + ch] * v; }
    float s1 = wave_sum(c), s2 = wave_sum(c * c);
    f32x2* red = (f32x2*)shm;
    if (lane == 0) red[wid] = (f32x2){s1, s2};
    __syncthreads();
    s1 = 0.f; s2 = 0.f;
#pragma unroll
    for (int w8 = 0; w8 < 8; ++w8) { const f32x2 q = red[w8]; s1 += q[0]; s2 += q[1]; }
    const float mean = s1 * (1.0f / 512.0f), var = s2 * (1.0f / 512.0f) - mean * mean, rs = rsqrtf(var + 1e-5f);
    const float y = (c - mean) * rs * p.ln_g[ch] + p.ln_b[ch];
    PC[(size_t)r * DM + 512 + ch] = (bf16_t)(cvt_pk_bf16(silu_f(y), 0.f) & 0xffffu);
    __syncthreads();
}

__device__ __forceinline__ void wait_counters(unsigned* c0, unsigned t0, unsigned* c1, unsigned t1, unsigned* c2, unsigned t2) {
    if (threadIdx.x == 0) { unsigned sp = 0u;
        while (xb_ld(c0) < t0 || xb_ld(c1) < t1 || xb_ld(c2) < t2) { __builtin_amdgcn_s_sleep(1); if (++sp > (1u << 22)) break; }
        __builtin_amdgcn_fence(__ATOMIC_ACQUIRE, "agent"); asm volatile("s_waitcnt vmcnt(0)" ::: "memory"); }
    __syncthreads();
}
__device__ __forceinline__ void phase_mixer_pre(const Params& p, unsigned char* shm, const int s, const int gbase, int off, int len) {
    int tid = threadIdx.x; asm volatile("" : "+v"(tid));
    sample_token(p, shm, s);
    f32x2 w2[31];
    { const float* wp = p.dw_w + (tid & 255) * 2;
#pragma unroll
      for (int j = 0; j < 31; ++j) w2[j] = *(const f32x2*)(wp + j * 512); }
#pragma unroll 1
    while (len > 0) {
        const int take = (len >= 96 || len == 64) ? 64 : (len == 80 ? 48 : (len > 64 ? 32 : len)), r0 = gbase + off, t0 = r0 & (SEQ - 1);
        int tq = tid; asm volatile("" : "+v"(tq));
        if (take == 64) mixer_chunk<64>(p, shm, r0, t0, tq, w2); else if (take == 48) mixer_chunk<48>(p, shm, r0, t0, tq, w2); else mixer_chunk<32>(p, shm, r0, t0, tq, w2);
        off += take; len -= take;
    }
}

__global__ void __launch_bounds__(512, 2) hymba_fwd(Params p) {
    extern __shared__ __attribute__((aligned(16))) unsigned char shm[];
    LAS unsigned char* lds = (LAS unsigned char*)shm;
    const int G = gridDim.x, c = blockIdx.x;
    volatile LAS unsigned* st = (volatile LAS unsigned*)(lds + pg8::STAGE_BYTES);
    if (threadIdx.x == 0) { st[0] = 0u; st[1] = 0u; st[2] = 0u; st[3] = 0u; }
    __syncthreads();
    const XcdBarrier xb = xcd_barrier_post((unsigned*)(p.ws + WS_BAR), st);
    phase_prep(p, shm);
    xcd_barrier(xb);
    const bool uni = st[3] != 0u;
    const int gx = uni ? (int)xb.x : (c & 7), gl = uni ? (int)st[2] : (c >> 3);
    const int sidx = 32 * gx + gl;
    const int pm = 8 * gx + (gl & 7), pn = gl >> 3;
    const int n3 = gx < 2 ? 18 : 17;
    unsigned* cw = (unsigned*)(p.ws + WS_CNT);
    if (gl >= n3) {
        late_weight_prep(p, shm, (gx < 2 ? 14 * gx : 28 + 15 * (gx - 2)) + (gl - n3), 118);
        asm volatile("s_waitcnt vmcnt(0)" ::: "memory");
        __syncthreads();
        if (threadIdx.x == 0) { __builtin_amdgcn_fence(__ATOMIC_RELEASE, "agent"); asm volatile("s_waitcnt vmcnt(0)" ::: "memory"); (void)xb_add(cw + 64 * CW_LW, 1u); }
    }
    { SchedP1 S{(const char*)(p.ws + WS_XB), (const char*)(p.ws + WS_WIN), cw, gx, gl, uni};
      EpiP1 E{(bf16_t*)(p.ws + WS_U), (bf16_t*)(p.ws + WS_SGP), (bf16_t*)(p.ws + WS_V), (bf16_t*)(p.ws + WS_SGC), p.out};
      f32x4 acc[2][2][4][2]; pg8::gemm_phase(lds, DM, DM, S, E, acc); }
    if (uni) {
        const unsigned n_s8 = gx < 2 ? 16u : 8u;
        if (gl == 31) {
            wait_counters(cw + 64 * (CW_RV + gx), 384u, cw + 64 * (CW_SV + gx), n_s8, cw + 64 * (CW_SV + gx), n_s8);
            if (threadIdx.x == 0) { __builtin_amdgcn_fence(__ATOMIC_RELEASE, "agent"); asm volatile("s_waitcnt vmcnt(0)" ::: "memory"); (void)xb_add(cw + 64 * CW_GV, 1u); }
        }
        wait_counters(cw + 64 * (CW_RV + gx), 384u, cw + 64 * CW_GV, 8u, cw + 64 * CW_GV, 8u);
    } else xcd_barrier(xb);
    {
      const int E2 = 32 - n3; int off, len;
      if (gl >= n3) { off = 96 * (gl - n3); len = 96; }
      else { const int remu = (2048 - 96 * E2) / 16, base = remu / n3, extra = remu % n3; off = 96 * E2 + 16 * (gl * base + (gl < extra ? gl : extra)); len = 16 * (base + (gl < extra ? 1 : 0)); }
      phase_mixer_pre(p, shm, sidx, 2048 * gx, off, len); }
    if (uni) { xcc_barrier(xb, [] {}); wait_counters(cw + 64 * CW_LW, 118u, cw + 64 * CW_LW, 118u, cw + 64 * CW_LW, 118u); } else xcd_barrier(xb);
    sample_p3(p, shm, sidx);
    { SchedP3 S{(const char*)(p.ws + WS_PC), (const char*)(p.ws + WS_MIX), (const char*)(p.ws + WS_PW), pm, pn};
      EpiP3 E{(const bf16_t*)(p.ws + WS_SGP), (const bf16_t*)(p.ws + WS_SGC), p.pw_b, (bf16_t*)(p.ws + WS_Z)};
      f32x4 acc[2][2][4][2]; pg8::gemm_phase(lds, DM, 512, S, E, acc); }
    { SchedP4 S{(const char*)(p.ws + WS_Z), (const char*)(p.ws + WS_WOUT), pm, pn};
      EpiP4 E{p.x_prompt, p.final_g, p.out, (float*)(p.ws + WS_XS), (unsigned*)(p.ws + WS_CNT), (const float*)(p.ws + WS_SS), NPROMPT + sidx, uni};
      f32x4 acc[2][2][4][2]; pg8::Unit u4; const bool has4 = S.next(0, u4);
      int tid4 = threadIdx.x; asm volatile("" : "+v"(tid4));
      const int wid4 = __builtin_amdgcn_readfirstlane(tid4 >> 6), lane4 = tid4 & 63;
      const auto hook = [&] { if (has4) E.init(acc, u4, wid4 >> 2, wid4 & 3, lane4 & 15, lane4 >> 4); };
      if (uni) xcc_barrier(xb, hook); else xcd_barrier(xb, hook);
      sample_p4(p, shm, sidx);
      pg8::gemm_phase(lds, DM, DM, S, E, acc); }
}

extern "C" void kernel_launch(void* const* d_in, const int* in_sizes, int n_in, void* d_out, int out_size, void* d_ws, size_t ws_size, hipStream_t stream) {
    constexpr int LDS_BYTES = pg8::STAGE_BYTES + 16;
    static int grid = 0;
    if (grid == 0) {
        if (n_in != 16 || ws_size < WS_END) { fprintf(stderr, "kernel_launch: unexpected inputs (n_in %d, ws %zu)\n", n_in, ws_size); grid = -1; return; }
        int dev = 0, cus = 0, per_cu = 0;
        (void)hipGetDevice(&dev); (void)hipDeviceGetAttribute(&cus, hipDeviceAttributeMultiprocessorCount, dev);
        if (hipFuncSetAttribute((const void*)hymba_fwd, hipFuncAttributeMaxDynamicSharedMemorySize, LDS_BYTES) != hipSuccess) { fprintf(stderr, "kernel_launch: hipFuncSetAttribute failed\n"); grid = -1; return; }
        if (hipOccupancyMaxActiveBlocksPerMultiprocessor(&per_cu, (const void*)hymba_fwd, 512, LDS_BYTES) != hipSuccess || per_cu < 1) { fprintf(stderr, "kernel_launch: occupancy query says %d\n", per_cu); per_cu = 1; (void)hipGetLastError(); }
        if (cus < 256) { fprintf(stderr, "kernel_launch: built for a 256-CU device (got %d CUs)\n", cus); grid = -1; return; }
        grid = 256;
    }
    if (grid < 0) return;
    if (hipMemsetAsync((char*)d_ws + WS_BAR, 0, WS_CTL_BYTES, stream) != hipSuccess) { fprintf(stderr, "kernel_launch: memset of the barrier words failed\n"); return; }
    Params p{};
    p.x_prompt = (const float*)d_in[0]; p.x_sample = (const float*)d_in[1]; p.cache_pool = (const float*)d_in[2]; p.cache_conv = (const float*)d_in[3];
    p.norm_g = (const float*)d_in[4]; p.w_in = (const float*)d_in[5]; p.pool_mix = (const float*)d_in[6]; p.pool_scale = (const float*)d_in[7];
    p.dw_w = (const float*)d_in[8]; p.dw_b = (const float*)d_in[9]; p.ln_g = (const float*)d_in[10]; p.ln_b = (const float*)d_in[11];
    p.pw_w = (const float*)d_in[12]; p.pw_b = (const float*)d_in[13]; p.w_out = (const float*)d_in[14]; p.final_g = (const float*)d_in[15];
    p.out = (float*)d_out; p.ws = (unsigned char*)d_ws;
    void* args[] = {&p};
    hipError_t e = hipLaunchCooperativeKernel((const void*)hymba_fwd, dim3(grid), dim3(512), args, LDS_BYTES, stream);
    if (e != hipSuccess) fprintf(stderr, "kernel_launch: cooperative launch failed: %s (grid %d)\n", hipGetErrorString(e), grid);
}
```

```cpp
#include <hip/hip_runtime.h>
#include <cstdio>

#define LAS __attribute__((address_space(3)))
typedef unsigned short bf16_t;
typedef short bf16x8 __attribute__((ext_vector_type(8)));
typedef float f32x4 __attribute__((ext_vector_type(4)));
typedef float f32x2 __attribute__((ext_vector_type(2)));
typedef unsigned u32x4 __attribute__((ext_vector_type(4)));
typedef unsigned u32x2 __attribute__((ext_vector_type(2)));

constexpr int DM = 1024, NPROMPT = 16384, NSAMP = 256, MT = NPROMPT + NSAMP, DIN = 2560, DH = 512;
constexpr int SEQ = 4096, DSEQ = 16;
constexpr size_t O_Y = 0;
constexpr size_t O_SPP = (size_t)MT * DM;
constexpr size_t O_SCP = O_SPP + 4 * 15 * 512;
constexpr size_t O_SPS = O_SCP + 4 * 30 * 512;
constexpr size_t O_SCS = O_SPS + 16 * 15 * 512;
constexpr size_t WS_XB = 0;
constexpr size_t WS_WIN = WS_XB + (size_t)MT * DM * 2;
constexpr size_t WS_MIX = WS_WIN + (size_t)DIN * DM * 2;
constexpr size_t WS_PW = WS_MIX + (size_t)512 * 512 * 2;
constexpr size_t WS_WOUT = WS_PW + (size_t)512 * 512 * 2;
constexpr size_t WS_U = WS_WOUT + (size_t)1024 * 1024 * 2;
constexpr size_t WS_SGP = WS_U + (size_t)MT * DH * 2;
constexpr size_t WS_V = WS_SGP + (size_t)MT * DH * 2;
constexpr size_t WS_SGC = WS_V + (size_t)MT * DH * 2;
constexpr size_t WS_PC = WS_SGC + (size_t)MT * DH * 2;
constexpr size_t WS_Z = WS_PC + (size_t)MT * DM * 2;
constexpr size_t WS_SS = WS_Z + (size_t)MT * DM * 2;
constexpr size_t WS_BAR = (WS_SS + (size_t)MT * 4 + 255) / 256 * 256;
constexpr size_t WS_CNT = WS_BAR + 4608 * 4;
constexpr size_t WS_CTL_BYTES = 4608 * 4 + 96 * 256;
constexpr int CW_PIECES = 64, CW_RV = 65  , CW_SV = 73  , CW_GV = 81  , CW_LW = 82  ;
constexpr size_t WS_XS = WS_CNT + 96 * 256;
constexpr size_t WS_END = WS_XS + (size_t)64 * 4 * 256 * 4;

struct Params {
    const float* x_prompt; const float* x_sample; const float* cache_pool; const float* cache_conv; const float* norm_g; const float* w_in;
    const float* pool_mix; const float* pool_scale; const float* dw_w; const float* dw_b; const float* ln_g; const float* ln_b;
    const float* pw_w; const float* pw_b; const float* w_out; const float* final_g;
    float* out; unsigned char* ws;
};

__device__ __forceinline__ unsigned cvt_pk_bf16(float lo, float hi) { unsigned r; asm volatile("v_cvt_pk_bf16_f32 %0, %1, %2" : "=v"(r) : "v"(lo), "v"(hi)); return r; }
__device__ __forceinline__ float bf_lo(unsigned u) { return __uint_as_float(u << 16); }
__device__ __forceinline__ float bf_hi(unsigned u) { return __uint_as_float(u & 0xffff0000u); }
__device__ __forceinline__ f32x2 bf_unpack(unsigned u) { return (f32x2){bf_lo(u), bf_hi(u)}; }
__device__ __forceinline__ float sigmoid_f(float x) { return __builtin_amdgcn_rcpf(1.0f + __expf(-x)); }
__device__ __forceinline__ float silu_f(float x) { return x * sigmoid_f(x); }
__device__ __forceinline__ u32x4 pack8(f32x4 a, f32x4 b) { return (u32x4){cvt_pk_bf16(a[0], a[1]), cvt_pk_bf16(a[2], a[3]), cvt_pk_bf16(b[0], b[1]), cvt_pk_bf16(b[2], b[3])}; }
__device__ __forceinline__ float wave_sum(float v) {
#pragma unroll
    for (int o = 32; o > 0; o >>= 1) v += __shfl_xor(v, o);
    return v;
}


#define XB_TMO      128
#define XB_XCNT(j)  (256  + 64 * (j))
#define XB_XSUB(j)  (1280 + 64 * (j))
#define XB_XGEN(j)  (2304 + 64 * (j))
#define XB_TOP      3328
#define XB_TOPGEN   3392
#define XB_XLOC(j)  (3520 + 64 * (j))
#define XCD_BAR_WORDS 4608
#define XB_SPIN_CAP (1u << 18)
__device__ __forceinline__ unsigned xb_ld(unsigned* p)              { return __hip_atomic_load(p, __ATOMIC_RELAXED, __HIP_MEMORY_SCOPE_AGENT); }
__device__ __forceinline__ unsigned xb_add(unsigned* p, unsigned v) { return __hip_atomic_fetch_add(p, v, __ATOMIC_RELAXED, __HIP_MEMORY_SCOPE_AGENT); }
__device__ __forceinline__ unsigned xb_xcc_id() { return (unsigned)__builtin_amdgcn_s_getreg((3 << 11) | 20) & 0xFu; }
#define XB_SPIN(cond, bar) do { unsigned _sp = 0; while (cond) { __builtin_amdgcn_s_sleep(1); \
    if ((++_sp & 255u) == 0u) { if (xb_ld(&(bar)[XB_TMO])) break; if (_sp > XB_SPIN_CAP) { atomicAdd(&(bar)[XB_TMO], 1u); break; } } } } while (0)
struct XcdBarrier { unsigned* bar; unsigned x; volatile LAS unsigned* st; };
__device__ __forceinline__ XcdBarrier xcd_barrier_post(unsigned* bar, volatile LAS unsigned* st) {
    XcdBarrier b; b.bar = bar; b.x = xb_xcc_id(); b.st = st;
    if (threadIdx.x == 0) st[2] = xb_add(&bar[XB_XCNT(b.x)], 1u);
    return b;
}
__device__ __forceinline__ void xcd_barrier_complete(unsigned* bar, unsigned x, unsigned& nloc, unsigned& nx, unsigned& uni) {
    const unsigned G = gridDim.x * gridDim.y * gridDim.z;
    unsigned sum, cnt, mine, sp = 0u;
    for (;;) {
        sum = 0u; cnt = 0u; mine = 0u; uni = 1u;
#pragma unroll
        for (unsigned j = 0; j < 16; ++j) { const unsigned c = xb_ld(&bar[XB_XCNT(j)]); sum += c; cnt += (c > 0u) ? 1u : 0u; mine = (j == x) ? c : mine; uni = (c == (j < 8 ? 32u : 0u)) ? uni : 0u; }
        if (sum == G) break;
        __builtin_amdgcn_s_sleep(1);
        if ((++sp & 255u) == 0u) { if (xb_ld(&bar[XB_TMO])) break; if (sp > XB_SPIN_CAP) { atomicAdd(&bar[XB_TMO], 1u); break; } }
    }
    nloc = mine > 0u ? mine : 1u; nx = cnt > 0u ? cnt : 1u; uni = (sum == G) ? uni : 0u;
}
template <class Hook>
__device__ __forceinline__ void xcd_barrier(const XcdBarrier& b, const Hook& hook) {
    asm volatile("s_waitcnt vmcnt(0)" ::: "memory");
    __syncthreads();
    if (threadIdx.x >= 64) hook();
    if (threadIdx.x == 0) {
        unsigned* bar = b.bar;
        __builtin_amdgcn_s_waitcnt(0);
        unsigned nloc = b.st[0], nx = b.st[1];
        if (nloc == 0u) { unsigned uni; xcd_barrier_complete(bar, b.x, nloc, nx, uni); b.st[0] = nloc; b.st[1] = nx; b.st[3] = uni; }
        const unsigned old = xb_add(&bar[XB_XSUB(b.x)], 1u);
        const unsigned gen = old / nloc;
        if (old + 1u == (gen + 1u) * nloc) {
            __builtin_amdgcn_fence(__ATOMIC_RELEASE, "agent");
            asm volatile("s_waitcnt vmcnt(0)" ::: "memory");
            const unsigned og = xb_add(&bar[XB_TOP], 1u);
            const unsigned tg = og / nx;
            if (og + 1u == (tg + 1u) * nx) xb_add(&bar[XB_TOPGEN], 1u);
            else XB_SPIN(xb_ld(&bar[XB_TOPGEN]) == tg, bar);
            __builtin_amdgcn_fence(__ATOMIC_ACQUIRE, "agent");
            xb_add(&bar[XB_XGEN(b.x)], 1u);
            asm volatile("s_waitcnt vmcnt(0)" ::: "memory");
        } else {
            XB_SPIN(xb_ld(&bar[XB_XGEN(b.x)]) == gen, bar);
            __builtin_amdgcn_fence(__ATOMIC_ACQUIRE, "agent");
            asm volatile("s_waitcnt vmcnt(0)" ::: "memory");
        }
    }
    if (threadIdx.x < 64) hook();
    __syncthreads();
}
__device__ __forceinline__ void xcd_barrier(const XcdBarrier& b) { xcd_barrier(b, [] {}); }
template <class Hook>
__device__ __forceinline__ void xcc_barrier(const XcdBarrier& b, const Hook& hook) {
    asm volatile("s_waitcnt vmcnt(0)" ::: "memory");
    __syncthreads();
    if (threadIdx.x >= 64) hook();
    if (threadIdx.x == 0) {
        unsigned* w = &b.bar[XB_XLOC(b.x)];
        __builtin_amdgcn_s_waitcnt(0);
        const unsigned old = xb_add(w, 1u), target = (old / 32u + 1u) * 32u;
        XB_SPIN(xb_ld(w) < target, b.bar);
        __builtin_amdgcn_fence(__ATOMIC_ACQUIRE, "agent");
        asm volatile("s_waitcnt vmcnt(0)" ::: "memory");
    }
    if (threadIdx.x < 64) hook();
    __syncthreads();
}

namespace pg8 {
constexpr int BM = 256, BK = 64, HALF = 128, HTB = HALF * BK * 2, STAGE_BYTES = 8 * HTB, NXCD = 8, WGM = 8;
__device__ __forceinline__ int lds_byte(int r, int c) { const int st = (r >> 4) * 2 + (c >> 5), rr = r & 15, cc = c & 31, ob = rr * 64 + cc * 2; return st * 1024 + (ob ^ (((ob >> 9) & 1) << 5)); }
__device__ __forceinline__ void stage_rc(int b, int& R, int& C) { const int st = b / 1024, sb = b % 1024, swz = sb ^ (((sb >> 9) & 1) << 5); R = (st >> 1) * 16 + swz / 64; C = (st & 1) * 32 + (swz % 64) / 2; }
__device__ __forceinline__ int perm32(int rho) { const int n = rho >> 4, i = rho & 15; return 8 * (i >> 2) + 4 * n + (i & 3); }

struct Unit { const char* A; const char* B; int pm, pn, nt, kind; };

__device__ __forceinline__ bool tile_order(int i, int G, int c, int nM, int nN, int& pm, int& pn) {
    const int nwg = nM * nN; const long L = (long)i * G + c; if (L >= nwg) return false;
    int wgid = (int)L; { const int q = nwg / NXCD, r = nwg % NXCD, xcd = wgid % NXCD, off = wgid / NXCD; wgid = (xcd < r ? xcd * (q + 1) : r * (q + 1) + (xcd - r) * q) + off; }
    const int nig = WGM * nN, gid = wgid / nig, fm = gid * WGM, gsz = (nM - fm) < WGM ? (nM - fm) : WGM;
    pm = fm + ((wgid % nig) % gsz); pn = (wgid % nig) / gsz; return true;
}

template <class Epi, class Sched>
__device__ __forceinline__ void gemm_phase(LAS unsigned char* lds, const int lda, const int ldb, const Sched& S, const Epi& E, f32x4 (&acc)[2][2][4][2]) {
    int tid_ = threadIdx.x; asm volatile("" : "+v"(tid_));
    const int tid = tid_, wid = __builtin_amdgcn_readfirstlane(tid >> 6), lane = tid & 63, wr = wid >> 2, wc = wid & 3, fr = lane & 15, fq = lane >> 4;
    unsigned voffA[2], voffB[2];
#pragma unroll
    for (int i = 0; i < 2; ++i) { int R, C; stage_rc(tid * 16 + i * 8192, R, C); const int Rb = Epi::PERM ? ((R & ~31) + perm32(R & 31)) : R;
        voffA[i] = (unsigned)(R * lda + C) * 2u; voffB[i] = (unsigned)(Rb * ldb + C) * 2u; }
    const size_t kstep = (size_t)(BK * 2);
    const size_t hstepA = (size_t)HALF * lda * 2, hstepB = (size_t)HALF * ldb * 2;
    const unsigned ldsw = (unsigned)wid * 1024u;
    const int aoff = lds_byte(wr * 64 + fr, fq * 8), boff = lds_byte(wc * 32 + fr, fq * 8);
#define PG8_SA(b, h) (((b) * 2 + (h)) * HTB)
#define PG8_SB(b, h) ((4 + (b) * 2 + (h)) * HTB)
#define PG8_STAGE(bufoff, gbase, voff) do { _Pragma("unroll") for (int _i = 0; _i < 2; ++_i) \
        __builtin_amdgcn_global_load_lds((const unsigned*)((const char*)(gbase) + (voff)[_i]), (LAS unsigned*)(lds + (bufoff) + ldsw + _i * 8192), 16, 0, 0); } while (0)
#define PG8_LDA(dst, b, h) do { _Pragma("unroll") for (int m = 0; m < 4; ++m) _Pragma("unroll") for (int k = 0; k < 2; ++k) dst[m][k] = *(const LAS bf16x8*)(lds + PG8_SA(b, h) + aoff + m * 2048 + k * 1024); } while (0)
#define PG8_LDB(dst, b, h) do { _Pragma("unroll") for (int n = 0; n < 2; ++n) _Pragma("unroll") for (int k = 0; k < 2; ++k) dst[n][k] = *(const LAS bf16x8*)(lds + PG8_SB(b, h) + boff + n * 2048 + k * 1024); } while (0)
#define PG8_MMA(ai, bj, At, Bt) do { __builtin_amdgcn_s_setprio(1); _Pragma("unroll") for (int m = 0; m < 4; ++m) _Pragma("unroll") for (int n = 0; n < 2; ++n) _Pragma("unroll") for (int k = 0; k < 2; ++k) \
        acc[ai][bj][m][n] = __builtin_amdgcn_mfma_f32_16x16x32_bf16(Bt[n][k], At[m][k], acc[ai][bj][m][n], 0, 0, 0); __builtin_amdgcn_s_setprio(0); } while (0)
#define PG8_WAIT_V(n) asm volatile("s_waitcnt vmcnt(" #n ")" ::: "memory")
#define PG8_WAIT_L(n) asm volatile("s_waitcnt lgkmcnt(" #n ")" ::: "memory")
#define PG8_BAR __builtin_amdgcn_s_barrier()
#define PG8_SCHED __builtin_amdgcn_sched_barrier(0)
    Unit cur, nxt; int ui = 0;
    if (!S.next(0, cur)) return;
    if constexpr (!Epi::EXT_INIT) E.init(acc, cur, wr, wc, fr, fq);
    bf16x8 At[4][2], B0[2][2], B1[2][2];
    const char* cA = cur.A; const char* cB = cur.B;
    PG8_STAGE(PG8_SB(0, 0), cB, voffB); PG8_STAGE(PG8_SA(0, 0), cA, voffA); PG8_STAGE(PG8_SB(0, 1), cB + hstepB, voffB); PG8_STAGE(PG8_SA(0, 1), cA + hstepA, voffA);
    if (wr == 1) PG8_BAR;
    PG8_WAIT_V(4); PG8_BAR;
    PG8_STAGE(PG8_SB(1, 0), cB + kstep, voffB); PG8_STAGE(PG8_SA(1, 0), cA + kstep, voffA); PG8_STAGE(PG8_SB(1, 1), cB + hstepB + kstep, voffB);
    PG8_WAIT_V(6); PG8_BAR;
    for (;;) {
        const bool has_next = S.next(ui + 1, nxt);
        const char* nA = has_next ? nxt.A : cA; const char* nB = has_next ? nxt.B : cB;
        const int nt = cur.nt;
        for (int t = 0; t < nt; t += 2) {
            const bool last = (t == nt - 2);
            const char* a1 = cA + (size_t)(t + 1) * kstep;
            const char* a2 = last ? nA : cA + (size_t)(t + 2) * kstep; const char* b2 = last ? nB : cB + (size_t)(t + 2) * kstep;
            const char* a3 = a2 + kstep; const char* b3 = b2 + kstep;
            PG8_LDB(B0, 0, 0); PG8_SCHED; PG8_LDA(At, 0, 0); PG8_STAGE(PG8_SA(1, 1), a1 + hstepA, voffA);
            PG8_WAIT_L(8); PG8_BAR; PG8_WAIT_L(0); PG8_MMA(0, 0, At, B0); PG8_BAR; PG8_SCHED;
            PG8_LDB(B1, 0, 1); PG8_STAGE(PG8_SB(0, 0), b2, voffB);
            PG8_BAR; PG8_WAIT_L(0); PG8_MMA(0, 1, At, B1); PG8_BAR;
            PG8_LDA(At, 0, 1); PG8_STAGE(PG8_SA(0, 0), a2, voffA);
            PG8_BAR; PG8_WAIT_L(0); PG8_MMA(1, 0, At, B0); PG8_BAR; PG8_SCHED;
            PG8_STAGE(PG8_SB(0, 1), b2 + hstepB, voffB);
            PG8_WAIT_V(6); PG8_BAR; PG8_MMA(1, 1, At, B1); PG8_BAR;
            PG8_LDB(B0, 1, 0); PG8_SCHED; PG8_LDA(At, 1, 0); PG8_STAGE(PG8_SA(0, 1), a2 + hstepA, voffA);
            PG8_WAIT_L(8); PG8_BAR; PG8_WAIT_L(0); PG8_MMA(0, 0, At, B0); PG8_BAR; PG8_SCHED;
            PG8_LDB(B1, 1, 1); PG8_STAGE(PG8_SB(1, 0), b3, voffB);
            PG8_BAR; PG8_WAIT_L(0); PG8_MMA(0, 1, At, B1); PG8_BAR;
            PG8_LDA(At, 1, 1); PG8_STAGE(PG8_SA(1, 0), a3, voffA);
            PG8_BAR; PG8_WAIT_L(0); PG8_MMA(1, 0, At, B0); PG8_BAR; PG8_SCHED;
            PG8_STAGE(PG8_SB(1, 1), b3 + hstepB, voffB);
            PG8_WAIT_V(6); PG8_BAR; PG8_MMA(1, 1, At, B1); PG8_BAR;
        }
        if constexpr (!Epi::AFTER_DRAIN) { E(acc, cur, wr, wc, fr, fq); S.done(cur, ui, lane); }
        if (!has_next) break;
        cur = nxt; cA = nA; cB = nB; ++ui;
        E.init(acc, cur, wr, wc, fr, fq);
    }
    PG8_WAIT_V(0);
    if (wr == 0) PG8_BAR;
    PG8_BAR;
    if constexpr (Epi::AFTER_DRAIN) E.fused(acc, cur, wr, wc, fr, fq, lds, tid);
#undef PG8_SA
#undef PG8_SB
#undef PG8_STAGE
#undef PG8_LDA
#undef PG8_LDB
#undef PG8_MMA
#undef PG8_WAIT_V
#undef PG8_WAIT_L
#undef PG8_BAR
#undef PG8_SCHED
}
}

struct SchedP1 {
    const char* xb; const char* win; unsigned* cnt; int gx, gl; bool uni;
    __device__ __forceinline__ bool next(int i, pg8::Unit& u) const {
        const int n_s = gx < 2 ? 2 : 1, j = gl + 32 * i; if (j >= 80 + n_s) return false;
        int pm, pn, kind;
        if (j < n_s) { pm = NPROMPT / 256; pn = gx + 8 * j; kind = 2; }
        else if (j < n_s + 48) { const int k = j - n_s, q = k >> 3; pm = 8 * gx + (k & 7); pn = q < 2 ? q : q + 2; kind = 1; }
        else { const int k = j - n_s - 48, q = k >> 3; pm = 8 * gx + (k & 7); pn = q < 2 ? q + 2 : q + 6; kind = 0; }
        u.pm = pm; u.pn = pn; u.kind = kind; u.nt = 16; u.A = xb + (size_t)pm * 256 * DM * 2; u.B = win + (size_t)pn * 256 * DM * 2; return true;
    }
    __device__ __forceinline__ void done(const pg8::Unit&, int ui, int lane) const {
        if (!uni) return;
        const int n_s = gx < 2 ? 2 : 1, nuv = gl < n_s + 16 ? 2 : 1;
        if (ui != nuv - 1) return;
        asm volatile("s_waitcnt vmcnt(0)" ::: "memory");
        if (lane == 0) { const int sm = gl < n_s ? 1 : 0, uv = nuv - sm;
            (void)xb_add(cnt + 64 * (CW_RV + gx), (unsigned)uv);
            if (sm) (void)xb_add(cnt + 64 * (CW_SV + gx), 1u); }
    }
};
struct EpiP1 {
    static constexpr bool PERM = true, AFTER_DRAIN = false, EXT_INIT = false;
    bf16_t* U; bf16_t* SGP; bf16_t* V; bf16_t* SGC; float* out;
    __device__ __forceinline__ void init(f32x4 (&acc)[2][2][4][2], const pg8::Unit&, int, int, int, int) const {
#pragma unroll
        for (int a = 0; a < 2; ++a)
#pragma unroll
            for (int b = 0; b < 2; ++b)
#pragma unroll
                for (int m = 0; m < 4; ++m)
#pragma unroll
                    for (int n = 0; n < 2; ++n) acc[a][b][m][n] = (f32x4){0.f, 0.f, 0.f, 0.f};
    }
    __device__ __forceinline__ void operator()(const f32x4 (&acc)[2][2][4][2], const pg8::Unit& u, int wr, int wc, int fr, int fq) const {
        const int pn = u.pn, row0 = u.pm * 256 + wr * 64 + fr, cl = wc * 32 + 8 * fq;
        if (pn < 2) {
#pragma unroll
            for (int ai = 0; ai < 2; ++ai)
#pragma unroll
                for (int m = 0; m < 4; ++m) {
                    const int r = row0 + ai * 128 + m * 16; bool st; size_t so;
                    if (r < NPROMPT) { const int t = r & (SEQ - 1); st = t >= SEQ - 15; so = O_SPP + ((size_t)(r >> 12) * 15 + (t - (SEQ - 15))) * 512; }
                    else { const int s = r - NPROMPT, t = s & 15; st = t >= 1; so = O_SPS + ((size_t)(s >> 4) * 15 + (t - 1)) * 512; }
#pragma unroll
                    for (int bj = 0; bj < 2; ++bj) { const int c = pn * 256 + bj * 128 + cl; const f32x4 v0 = acc[ai][bj][m][0], v1 = acc[ai][bj][m][1];
                        *(u32x4*)(U + (size_t)r * DH + c) = pack8(v0, v1);
                        if (st) { *(f32x4*)(out + so + c) = v0; *(f32x4*)(out + so + c + 4) = v1; } }
                }
        } else if (pn < 4 || pn >= 8) {
            bf16_t* dst = pn < 4 ? SGP : SGC; const int cb = (pn < 4 ? pn - 2 : pn - 8) * 256 + cl;
#pragma unroll
            for (int ai = 0; ai < 2; ++ai)
#pragma unroll
                for (int m = 0; m < 4; ++m) { const int r = row0 + ai * 128 + m * 16;
#pragma unroll
                    for (int bj = 0; bj < 2; ++bj) { f32x4 v0 = acc[ai][bj][m][0], v1 = acc[ai][bj][m][1];
#pragma unroll
                        for (int j = 0; j < 4; ++j) { v0[j] = silu_f(v0[j]); v1[j] = silu_f(v1[j]); }
                        *(u32x4*)(dst + (size_t)r * DH + cb + bj * 128) = pack8(v0, v1); }
                }
        } else {
            const int c = (pn - 4) * 128 + cl;
#pragma unroll
            for (int ai = 0; ai < 2; ++ai)
#pragma unroll
                for (int m = 0; m < 4; ++m) {
                    const int r = row0 + ai * 128 + m * 16; bool st; size_t so;
                    if (r < NPROMPT) { const int t = r & (SEQ - 1); st = t >= SEQ - 30; so = O_SCP + ((size_t)(r >> 12) * 30 + (t - (SEQ - 30))) * 512; }
                    else { const int s = r - NPROMPT, t = s & 15; st = true; so = O_SCS + ((size_t)(s >> 4) * 30 + 14 + t) * 512; }
                    f32x4 v0 = acc[ai][0][m][0], v1 = acc[ai][0][m][1]; const f32x4 g0 = acc[ai][1][m][0], g1 = acc[ai][1][m][1];
#pragma unroll
                    for (int j = 0; j < 4; ++j) { v0[j] *= sigmoid_f(g0[j]); v1[j] *= sigmoid_f(g1[j]); }
                    *(u32x4*)(V + (size_t)r * DH + c) = pack8(v0, v1);
                    if (st) { *(f32x4*)(out + so + c) = v0; *(f32x4*)(out + so + c + 4) = v1; }
                }
        }
    }
};

struct SchedP3 {
    const char* pc; const char* mix; const char* pw; int pm0, pn0;
    __device__ __forceinline__ void done(const pg8::Unit&, int, int) const {}
    __device__ __forceinline__ bool next(int i, pg8::Unit& u) const {
        if (i != 0) return false; const int pm = pm0, pn = pn0;
        u.pm = pm; u.pn = pn; u.kind = 0;
        if (pn < 2) { u.nt = 4; u.A = pc + ((size_t)pm * 256 * DM + 256 * pn) * 2; u.B = mix + ((size_t)pn * 256 * 512 + 256 * pn) * 2; }
        else { u.nt = 8; u.A = pc + ((size_t)pm * 256 * DM + 512) * 2; u.B = pw + (size_t)(pn - 2) * 256 * 512 * 2; }
        return true;
    }
};
struct EpiP3 {
    static constexpr bool PERM = true, AFTER_DRAIN = false, EXT_INIT = false;
    const bf16_t* SGP; const bf16_t* SGC; const float* pw_b; bf16_t* Z;
    __device__ __forceinline__ void init(f32x4 (&acc)[2][2][4][2], const pg8::Unit&, int, int, int, int) const {
#pragma unroll
        for (int a = 0; a < 2; ++a)
#pragma unroll
            for (int b = 0; b < 2; ++b)
#pragma unroll
                for (int m = 0; m < 4; ++m)
#pragma unroll
                    for (int n = 0; n < 2; ++n) acc[a][b][m][n] = (f32x4){0.f, 0.f, 0.f, 0.f};
    }
    __device__ __forceinline__ void operator()(const f32x4 (&acc)[2][2][4][2], const pg8::Unit& u, int wr, int wc, int fr, int fq) const {
        const int pn = u.pn, row0 = u.pm * 256 + wr * 64 + fr, cl = wc * 32 + 8 * fq;
        const bool conv = pn >= 2; const bf16_t* gate = conv ? SGC : SGP; const int cb = (conv ? pn - 2 : pn) * 256 + cl;
        f32x4 bv[2][2];
#pragma unroll
        for (int bj = 0; bj < 2; ++bj)
#pragma unroll
            for (int n = 0; n < 2; ++n) bv[bj][n] = conv ? *(const f32x4*)(pw_b + cb + bj * 128 + 4 * n) : (f32x4){0.f, 0.f, 0.f, 0.f};
#pragma unroll
        for (int ai = 0; ai < 2; ++ai) {
            u32x4 gt[4][2];
#pragma unroll
            for (int m = 0; m < 4; ++m)
#pragma unroll
                for (int bj = 0; bj < 2; ++bj) gt[m][bj] = *(const u32x4*)(gate + (size_t)(row0 + ai * 128 + m * 16) * DH + cb + bj * 128);
#pragma unroll
            for (int m = 0; m < 4; ++m) { const int r = row0 + ai * 128 + m * 16;
#pragma unroll
                for (int bj = 0; bj < 2; ++bj) { const int c = cb + bj * 128; const u32x4 g = gt[m][bj];
                    f32x4 v0 = acc[ai][bj][m][0] + bv[bj][0], v1 = acc[ai][bj][m][1] + bv[bj][1];
                    v0[0] *= bf_lo(g[0]); v0[1] *= bf_hi(g[0]); v0[2] *= bf_lo(g[1]); v0[3] *= bf_hi(g[1]);
                    v1[0] *= bf_lo(g[2]); v1[1] *= bf_hi(g[2]); v1[2] *= bf_lo(g[3]); v1[3] *= bf_hi(g[3]);
                    *(u32x4*)(Z + (size_t)r * DM + (conv ? 512 : 0) + c) = pack8(v0, v1); }
            }
        }
    }
};

struct SchedP4 {
    const char* z; const char* wout; int pm0, pn0;
    __device__ __forceinline__ void done(const pg8::Unit&, int, int) const {}
    __device__ __forceinline__ bool next(int i, pg8::Unit& u) const {
        if (i != 0) return false; const int pm = pm0, pn = pn0;
        u.pm = pm; u.pn = pn; u.kind = 0; u.nt = 16; u.A = z + (size_t)pm * 256 * DM * 2; u.B = wout + (size_t)pn * 256 * DM * 2; return true;
    }
};
struct EpiP4 {
    static constexpr bool PERM = false, AFTER_DRAIN = true, EXT_INIT = true;
    const float* x_prompt; const float* final_g; float* out; float* xs; unsigned* cnt; const float* ss; int srow; bool uni;
    __device__ __forceinline__ void init(f32x4 (&acc)[2][2][4][2], const pg8::Unit& u, int wr, int wc, int fr, int fq) const {
        const int row0 = u.pm * 256 + wr * 64 + fr, col0 = u.pn * 256 + wc * 32 + 4 * fq;
#pragma unroll
        for (int ai = 0; ai < 2; ++ai)
#pragma unroll
            for (int m = 0; m < 4; ++m) { const float* xr = x_prompt + (size_t)(row0 + ai * 128 + m * 16) * DM + col0;
#pragma unroll
                for (int bj = 0; bj < 2; ++bj)
#pragma unroll
                    for (int n = 0; n < 2; ++n) acc[ai][bj][m][n] = *(const f32x4*)(xr + bj * 128 + n * 16); }
    }
    __device__ __forceinline__ void fused(const f32x4 (&acc)[2][2][4][2], const pg8::Unit& u, int wr, int wc, int fr, int fq, LAS unsigned char* lds, int tid) const {
        LAS float* lss = (LAS float*)lds;
#pragma unroll
        for (int ai = 0; ai < 2; ++ai)
#pragma unroll
            for (int m = 0; m < 4; ++m) { float s = 0.f;
#pragma unroll
                for (int bj = 0; bj < 2; ++bj)
#pragma unroll
                    for (int n = 0; n < 2; ++n) { const f32x4 y = acc[ai][bj][m][n]; s += y[0] * y[0] + y[1] * y[1] + y[2] * y[2] + y[3] * y[3]; }
                s += __shfl_xor(s, 16); s += __shfl_xor(s, 32);
                if (fq == 0) lss[(ai * 128 + wr * 64 + m * 16 + fr) * 4 + wc] = s; }
        __syncthreads();
        if (tid < 256) { const f32x4 v = *(const LAS f32x4*)(lss + tid * 4); xs[((size_t)u.pm * 4 + u.pn) * 256 + tid] = v[0] + v[1] + v[2] + v[3]; }
        asm volatile("s_waitcnt vmcnt(0)" ::: "memory");
        __syncthreads();
        if (tid == 0) {
            unsigned* cw = cnt + 64 * u.pm; unsigned* cs = cnt + 64 * CW_PIECES;
            if (!uni) __builtin_amdgcn_fence(__ATOMIC_RELEASE, "agent");
            asm volatile("s_waitcnt vmcnt(0)" ::: "memory");
            (void)xb_add(cw, 1u);
            unsigned sp = 0u;
            while (xb_ld(cw) < 4u || xb_ld(cs) < 256u) { __builtin_amdgcn_s_sleep(1); if (++sp > (1u << 22)) break; }
            __builtin_amdgcn_fence(__ATOMIC_ACQUIRE, "agent");
            asm volatile("s_waitcnt vmcnt(0)" ::: "memory");
        }
        __syncthreads();
        if (tid >= 256) { const int t4 = (tid - 256) * 4; const float rs = rsqrtf(ss[srow] * (1.0f / DM) + 1e-6f); float* yr = out + (size_t)srow * DM + t4;
            *(f32x4*)yr = *(const f32x4*)yr * rs * *(const f32x4*)(final_g + t4); }
        if (tid < 256) { const float* xp = xs + (size_t)u.pm * 4 * 256 + tid; const float tot = xp[0] + xp[256] + xp[512] + xp[768];
            lss[1024 + tid] = rsqrtf(tot * (1.0f / DM) + 1e-6f); }
        __syncthreads();
        const int row0 = u.pm * 256 + wr * 64 + fr, col0 = u.pn * 256 + wc * 32 + 4 * fq;
        f32x4 g4[2][2];
#pragma unroll
        for (int bj = 0; bj < 2; ++bj)
#pragma unroll
            for (int n = 0; n < 2; ++n) g4[bj][n] = *(const f32x4*)(final_g + col0 + bj * 128 + n * 16);
#pragma unroll
        for (int ai = 0; ai < 2; ++ai)
#pragma unroll
            for (int m = 0; m < 4; ++m) { const float rs = lss[1024 + ai * 128 + wr * 64 + m * 16 + fr]; float* yr = out + (size_t)(row0 + ai * 128 + m * 16) * DM + col0;
#pragma unroll
                for (int bj = 0; bj < 2; ++bj)
#pragma unroll
                    for (int n = 0; n < 2; ++n) *(f32x4*)(yr + bj * 128 + n * 16) = acc[ai][bj][m][n] * rs * g4[bj][n]; }
    }
    __device__ __forceinline__ void operator()(const f32x4 (&)[2][2][4][2], const pg8::Unit&, int, int, int, int) const {}
};

template <int NF>
__device__ __forceinline__ f32x4 small_gemm(const bf16_t* __restrict__ A, int lda, const bf16_t* __restrict__ Bt, int ldb, int K, int nw, f32x4* red) {
    const int tid = threadIdx.x, wid = tid >> 6, lane = tid & 63, fr = lane & 15, fq = lane >> 4;
    f32x4 acc[NF];
#pragma unroll
    for (int f = 0; f < NF; ++f) acc[f] = (f32x4){0.f, 0.f, 0.f, 0.f};
    if (wid < nw) { const int ks = K / nw; const bf16_t* ap = A + (size_t)fr * lda + wid * ks + fq * 8; const bf16_t* bp = Bt + (size_t)fr * ldb + wid * ks + fq * 8;
        for (int k = 0; k < ks; k += 32) { const bf16x8 a = *(const bf16x8*)(ap + k);
#pragma unroll
            for (int f = 0; f < NF; ++f) { const bf16x8 b = *(const bf16x8*)(bp + (size_t)f * 16 * ldb + k); acc[f] = __builtin_amdgcn_mfma_f32_16x16x32_bf16(b, a, acc[f], 0, 0, 0); } } }
#pragma unroll
    for (int f = 0; f < NF; ++f) red[(wid * NF + f) * 64 + lane] = acc[f];
    __syncthreads();
    f32x4 r = (f32x4){0.f, 0.f, 0.f, 0.f};
    if (tid < 64 * NF) {
#pragma unroll
        for (int w = 0; w < 8; ++w) r += red[(w * NF + wid) * 64 + lane]; }
    return r;
}
__device__ __forceinline__ void sample_p3(const Params& p, unsigned char* shm, const int i) {
    const int tid = threadIdx.x, wid = tid >> 6, lane = tid & 63, fr = lane & 15, fq = lane >> 4; f32x4* red = (f32x4*)shm;
    const bf16_t* PC = (const bf16_t*)(p.ws + WS_PC); bf16_t* Z = (bf16_t*)(p.ws + WS_Z);
    { const int rb = i >> 4, cb = i & 15, row0 = NPROMPT + rb * 16, row = row0 + fr, c = 32 * cb + 16 * wid + 4 * fq;
        {
            const f32x4 r = small_gemm<2>(PC + (size_t)row0 * DM + 512, DM, (const bf16_t*)(p.ws + WS_PW) + (size_t)32 * cb * 512, 512, 512, 8, red);
            if (tid < 128) { const f32x4 bv = *(const f32x4*)(p.pw_b + c); const u32x2 g = *(const u32x2*)((const bf16_t*)(p.ws + WS_SGC) + (size_t)row * DH + c);
                const f32x4 z = (r + bv) * (f32x4){bf_lo(g[0]), bf_hi(g[0]), bf_lo(g[1]), bf_hi(g[1])};
                *(u32x2*)(Z + (size_t)row * DM + 512 + c) = (u32x2){cvt_pk_bf16(z[0], z[1]), cvt_pk_bf16(z[2], z[3])}; }
            __syncthreads();
        }
        {
            const int g128 = (cb >> 2) * 128;
            const f32x4 r = small_gemm<2>(PC + (size_t)row0 * DM + g128, DM, (const bf16_t*)(p.ws + WS_MIX) + (size_t)32 * cb * 512 + g128, 512, 128, 4, red);
            if (tid < 128) { const u32x2 g = *(const u32x2*)((const bf16_t*)(p.ws + WS_SGP) + (size_t)row * DH + c);
                const f32x4 z = r * (f32x4){bf_lo(g[0]), bf_hi(g[0]), bf_lo(g[1]), bf_hi(g[1])};
                *(u32x2*)(Z + (size_t)row * DM + c) = (u32x2){cvt_pk_bf16(z[0], z[1]), cvt_pk_bf16(z[2], z[3])}; }
            __syncthreads();
        }
    }
}
__device__ __forceinline__ void sample_p4(const Params& p, unsigned char* shm, const int i) {
    const int tid = threadIdx.x, wid = tid >> 6, lane = tid & 63, fr = lane & 15, fq = lane >> 4; f32x4* red = (f32x4*)shm;
    float* ss = (float*)(p.ws + WS_SS);
    { const int rb = i >> 4, cb = i & 15, row0 = NPROMPT + rb * 16, row = row0 + fr, c = 64 * cb + 16 * wid + 4 * fq;
        const f32x4 r = small_gemm<4>((const bf16_t*)(p.ws + WS_Z) + (size_t)row0 * DM, DM, (const bf16_t*)(p.ws + WS_WOUT) + (size_t)64 * cb * DM, DM, DM, 8, red);
        if (tid < 256) { const f32x4 y = r + *(const f32x4*)(p.x_sample + (size_t)(row - NPROMPT) * DM + c);
            *(f32x4*)(p.out + (size_t)row * DM + c) = y;
            float s = y[0] * y[0] + y[1] * y[1] + y[2] * y[2] + y[3] * y[3]; s += __shfl_xor(s, 16); s += __shfl_xor(s, 32);
            if (fq == 0) atomicAdd(ss + row, s); }
        asm volatile("s_waitcnt vmcnt(0)" ::: "memory");
        __syncthreads();
        if (tid == 0) { __builtin_amdgcn_fence(__ATOMIC_RELEASE, "agent"); asm volatile("s_waitcnt vmcnt(0)" ::: "memory"); (void)xb_add((unsigned*)(p.ws + WS_CNT) + 64 * CW_PIECES, 1u); }
    }
}
__device__ __forceinline__ void transpose_load(const float* __restrict__ src, int ldsrc, int k0, int n0s, f32x4 (&v)[2]) {
    const int tid = threadIdx.x, kk = tid >> 4, n4 = (tid & 15) * 4;
#pragma unroll
    for (int i = 0; i < 2; ++i) v[i] = *(const f32x4*)(src + (size_t)(k0 + kk + 32 * i) * ldsrc + n0s + n4);
}
__device__ __forceinline__ void transpose_store(const f32x4 (&v)[2], int k0, bf16_t* __restrict__ dst, int ldd, int n0d, float* tile) {
    const int tid = threadIdx.x;
    {
        const int kk = tid >> 4, n4 = (tid & 15) * 4;
#pragma unroll
        for (int i = 0; i < 2; ++i) { const int k = kk + 32 * i;
            tile[k * 65 + n4 + 0] = v[i][0]; tile[k * 65 + n4 + 1] = v[i][1]; tile[k * 65 + n4 + 2] = v[i][2]; tile[k * 65 + n4 + 3] = v[i][3]; }
    }
    __syncthreads();
    {
        const int n = tid >> 3, k8 = (tid & 7) * 8; float w[8];
#pragma unroll
        for (int j = 0; j < 8; ++j) w[j] = tile[(k8 + j) * 65 + n];
        *(u32x4*)(dst + (size_t)(n0d + n) * ldd + k0 + k8) = (u32x4){cvt_pk_bf16(w[0], w[1]), cvt_pk_bf16(w[2], w[3]), cvt_pk_bf16(w[4], w[5]), cvt_pk_bf16(w[6], w[7])};
    }
    __syncthreads();
}
__device__ __forceinline__ void transpose_tile(const float* __restrict__ src, int ldsrc, int k0, int n0s, bf16_t* __restrict__ dst, int ldd, int n0d, float* tile) {
    f32x4 v[2]; transpose_load(src, ldsrc, k0, n0s, v); transpose_store(v, k0, dst, ldd, n0d, tile);
}
__device__ __forceinline__ int win_src_col(int n0) {
    if (n0 >= 1024 && n0 < 2048) { const int q = n0 - 1024, j = q >> 8, i = q & 255; return i < 128 ? 1024 + 128 * j + i : 1536 + 128 * j + (i - 128); }
    return n0;
}

__device__ __forceinline__ void phase_prep(const Params& p, unsigned char* shm) {
    const int tid = threadIdx.x, wid = tid >> 6, lane = tid & 63, nb = gridDim.x, bid = blockIdx.x;
    bf16_t* xb = (bf16_t*)(p.ws + WS_XB);
    constexpr int T_IN = 16 * 40;
    f32x4 tv[3][2];
#pragma unroll
    for (int q = 0; q < 3; ++q) { const int t = bid + q * nb; if (t < T_IN) transpose_load(p.w_in, DIN, (t / 40) * 64, win_src_col((t % 40) * 64), tv[q]); }
    {
        f32x4 g4[4];
#pragma unroll
        for (int i = 0; i < 4; ++i) g4[i] = *(const f32x4*)(p.norm_g + lane * 4 + 256 * i);
        for (int g = bid * 8 + wid; g < MT / 4; g += nb * 8) {
            f32x4 v[4][4]; float s[4];
#pragma unroll
            for (int q = 0; q < 4; ++q) { const int r = g * 4 + q; const float* xr = r < NPROMPT ? p.x_prompt + (size_t)r * DM : p.x_sample + (size_t)(r - NPROMPT) * DM;
#pragma unroll
                for (int i = 0; i < 4; ++i) v[q][i] = *(const f32x4*)(xr + lane * 4 + 256 * i); }
#pragma unroll
            for (int q = 0; q < 4; ++q) { s[q] = 0.f;
#pragma unroll
                for (int i = 0; i < 4; ++i) s[q] += v[q][i][0] * v[q][i][0] + v[q][i][1] * v[q][i][1] + v[q][i][2] * v[q][i][2] + v[q][i][3] * v[q][i][3];
                s[q] = wave_sum(s[q]); }
#pragma unroll
            for (int q = 0; q < 4; ++q) { const int r = g * 4 + q; const float rs = rsqrtf(s[q] * (1.0f / DM) + 1e-6f);
#pragma unroll
                for (int i = 0; i < 4; ++i) { const f32x4 h = v[q][i] * rs * g4[i];
                    *(u32x2*)(xb + (size_t)r * DM + lane * 4 + 256 * i) = (u32x2){cvt_pk_bf16(h[0], h[1]), cvt_pk_bf16(h[2], h[3])}; } }
        }
    }
    {
        float* tile = (float*)shm; bf16_t* win = (bf16_t*)(p.ws + WS_WIN);
#pragma unroll
        for (int q = 0; q < 3; ++q) { const int t = bid + q * nb; if (t < T_IN) transpose_store(tv[q], (t / 40) * 64, win, DM, (t % 40) * 64, tile); }
        for (int t = bid + 3 * nb; t < T_IN; t += nb) transpose_tile(p.w_in, DIN, (t / 40) * 64, win_src_col((t % 40) * 64), win, DM, (t % 40) * 64, tile);
    }
    float* ss = (float*)(p.ws + WS_SS);
    for (int i = bid * 512 + tid; i < MT; i += nb * 512) ss[i] = 0.f;
    for (int i = bid * 512 + tid; i < 16 * 14 * 128; i += nb * 512) { const int c4 = i & 127, rr = i >> 7, b = rr / 14, j = rr % 14;
        *(f32x4*)(p.out + O_SCS + ((size_t)b * 30 + j) * 512 + c4 * 4) = *(const f32x4*)(p.cache_conv + ((size_t)b * 30 + 16 + j) * 512 + c4 * 4); }
}

__device__ __forceinline__ void late_weight_prep(const Params& p, unsigned char* shm, const int bid, const int nb) {
    const int tid = threadIdx.x; float* tile = (float*)shm;
    bf16_t* pw = (bf16_t*)(p.ws + WS_PW); bf16_t* wout = (bf16_t*)(p.ws + WS_WOUT); bf16_t* mix = (bf16_t*)(p.ws + WS_MIX);
    constexpr int T_OUT = 16 * 16, T_PW = 8 * 8;
    for (int t = bid; t < T_OUT + T_PW; t += nb) {
        if (t < T_OUT) transpose_tile(p.w_out, DM, (t >> 4) * 64, (t & 15) * 64, wout, DM, (t & 15) * 64, tile);
        else { const int tt = t - T_OUT; transpose_tile(p.pw_w, 512, (tt >> 3) * 64, (tt & 7) * 64, pw, 512, (tt & 7) * 64, tile); }
    }
    for (int idx = bid * 512 + tid; idx < 512 * 512; idx += nb * 512) { const int n = idx >> 9, k = idx & 511; float v = 0.f;
        if ((n >> 7) == (k >> 7)) v = p.pool_mix[((size_t)(n >> 7) * 128 + (k & 127)) * 128 + (n & 127)] * p.pool_scale[n];
        mix[idx] = (bf16_t)(cvt_pk_bf16(v, 0.f) & 0xffffu); }
    __syncthreads();
}

#define DPP_STEP(v, ctrl) ((v) + __builtin_bit_cast(float, __builtin_amdgcn_update_dpp(0, __builtin_bit_cast(int, (v)), (ctrl), 0xf, 0xf, true)))
__device__ __forceinline__ float wave_sum_hi(float v) {
    v = DPP_STEP(v, 0xB1);
    v = DPP_STEP(v, 0x4E);
    v = DPP_STEP(v, 0x141);
    v = DPP_STEP(v, 0x140);
    v += __builtin_bit_cast(float, __builtin_amdgcn_update_dpp(0, __builtin_bit_cast(int, v), 0x142, 0xa, 0xf, false));
    v += __builtin_bit_cast(float, __builtin_amdgcn_update_dpp(0, __builtin_bit_cast(int, v), 0x143, 0xc, 0xf, false));
    return v;
}
template <int W, int TH>
__device__ __forceinline__ void pool_regs(const unsigned (&u)[TH + 15], const int pos0, bf16_t* __restrict__ dst  ) {
    f32x2 s = (f32x2){0.f, 0.f};
#pragma unroll
    for (int j = 0; j < W; ++j) s += bf_unpack(u[15 - j]);
#pragma unroll
    for (int i = 0; i < TH; ++i) { const f32x2 cur = bf_unpack(u[15 + i]); const int pos1 = pos0 + i + 1;
        const float inv = pos1 >= W ? (1.0f / W) : __builtin_amdgcn_rcpf((float)pos1);
        const f32x2 o = s * inv - cur;
        *(unsigned*)(dst + (size_t)i * DM) = cvt_pk_bf16(o[0], o[1]);
        if (i + 1 < TH) s += bf_unpack(u[16 + i]) - bf_unpack(u[16 + i - W]); }
}
template <int T>
__device__ __forceinline__ void mixer_chunk(const Params& p, unsigned char* shm, const int r0, const int t0, const int tid, const f32x2 (&w2)[31]) {
    constexpr int TH = T / 2, ROUNDS = T / 16, NV = ((T + 30) * 64 + 511) / 512;
    const int cp = tid & 255, th = tid >> 8, lane = tid & 63, wv = (tid >> 6) & 3;
    const bf16_t* U = (const bf16_t*)(p.ws + WS_U); const bf16_t* V = (const bf16_t*)(p.ws + WS_V); bf16_t* PC = (bf16_t*)(p.ws + WS_PC);
    const unsigned* l32 = (const unsigned*)shm;
    u32x4 val[NV];
    {
        const bf16_t* vb = V + (size_t)(r0 - 30) * DH;
#pragma unroll
        for (int k = 0; k < NV; ++k) { const int idx = tid + k * 512, lr = idx >> 6; val[k] = (u32x4){0u, 0u, 0u, 0u};
            if (idx < (T + 30) * 64 && t0 - 30 + lr >= 0) val[k] = *(const u32x4*)(vb + (size_t)idx * 8); }
    }
    unsigned u[TH + 15];
    {
        const int f0 = th * TH - 15; const bf16_t* ub = U + (size_t)(r0 + f0) * DH + cp * 2;
#pragma unroll
        for (int k = 0; k < TH + 15; ++k) { u[k] = 0u; if (t0 + f0 + k >= 0) u[k] = *(const unsigned*)(ub + (size_t)k * DH); }
    }
#pragma unroll
    for (int k = 0; k < NV; ++k) { const int idx = tid + k * 512; if (idx < (T + 30) * 64) *(u32x4*)(shm + (size_t)idx * 16) = val[k]; }
    const f32x2 bias = *(const f32x2*)(p.dw_b + cp * 2);
    const f32x2 g2 = *(const f32x2*)(p.ln_g + cp * 2), b2 = *(const f32x2*)(p.ln_b + cp * 2);
    __syncthreads();
    {
        bf16_t* dst = PC + (size_t)(r0 + th * TH) * DM + cp * 2; const int pos0 = t0 + th * TH;
        switch (cp >> 6) { case 0: pool_regs<2, TH>(u, pos0, dst); break; case 1: pool_regs<4, TH>(u, pos0, dst); break; case 2: pool_regs<8, TH>(u, pos0, dst); break; default: pool_regs<16, TH>(u, pos0, dst); break; }
    }
    f32x2* stats = (f32x2*)(shm + (T + 30) * 1024);
#pragma unroll 1
    for (int rd = 0; rd < ROUNDS; ++rd) {
        const int tt = rd * 16 + th * 8;
        f32x2 c[8];
#pragma unroll
        for (int i = 0; i < 8; ++i) c[i] = bias;
#pragma unroll
        for (int q = 0; q < 38; ++q) { const f32x2 v = bf_unpack(l32[(tt + q) * 256 + cp]);
#pragma unroll
            for (int i = 0; i < 8; ++i) if (q - i >= 0 && q - i < 31) c[i] += w2[q - i] * v; }
#pragma unroll
        for (int i = 0; i < 8; ++i) { const float s1 = wave_sum_hi(c[i][0] + c[i][1]), s2 = wave_sum_hi(c[i][0] * c[i][0] + c[i][1] * c[i][1]);
            if (lane == 63) stats[(tt + i) * 4 + wv] = (f32x2){s1, s2}; }
        __syncthreads();
        float mean_l, rs_l;
        { const int ti = tt + (lane & 7);
          const f32x4 sa = *(const f32x4*)(stats + ti * 4), sb = *(const f32x4*)(stats + ti * 4 + 2);
          mean_l = (sa[0] + sa[2] + sb[0] + sb[2]) * (1.0f / 512.0f);
          const float var = (sa[1] + sa[3] + sb[1] + sb[3]) * (1.0f / 512.0f) - mean_l * mean_l;
          rs_l = __builtin_amdgcn_rsqf(var + 1e-5f); }
#pragma unroll
        for (int i = 0; i < 8; ++i) {
            const float mean = __builtin_bit_cast(float, __builtin_amdgcn_readlane(__builtin_bit_cast(int, mean_l), i));
            const float rs = __builtin_bit_cast(float, __builtin_amdgcn_readlane(__builtin_bit_cast(int, rs_l), i));
            const f32x2 y = (c[i] - mean) * rs * g2 + b2;
            *(unsigned*)(PC + (size_t)(r0 + tt + i) * DM + 512 + cp * 2) = cvt_pk_bf16(silu_f(y[0]), silu_f(y[1])); }
    }
    __syncthreads();
}

__device__ __forceinline__ void sample_token(const Params& p, unsigned char* shm, const int s) {
    const int tid = threadIdx.x, wid = tid >> 6, lane = tid & 63, b = s >> 4, t = s & 15, r = NPROMPT + s, ch = tid;
    const bf16_t* U = (const bf16_t*)(p.ws + WS_U); const bf16_t* V = (const bf16_t*)(p.ws + WS_V); bf16_t* PC = (bf16_t*)(p.ws + WS_PC);
    {
        const int w = 2 << (ch >> 7); float sum = 0.f, cur = 0.f;
#pragma unroll
        for (int j = 0; j < 16; ++j) if (j < w) { const int e = t + 15 - j;
            const float v = e < 15 ? p.cache_pool[((size_t)b * 15 + e) * 512 + ch] : __uint_as_float((unsigned)U[(size_t)(NPROMPT + b * 16 + e - 15) * DH + ch] << 16);
            sum += v; if (j == 0) cur = v; }
        const float o = sum / (float)w - cur;
        PC[(size_t)r * DM + ch] = (bf16_t)(cvt_pk_bf16(o, 0.f) & 0xffffu);
    }
    float c = p.dw_b[ch];
#pragma unroll
    for (int j = 0; j < 31; ++j) { const int e = t + j;
        const float v = e < 30 ? p.cache_conv[((size_t)b * 30 + e) * 512 + ch] : __uint_as_float((unsigned)V[(size_t)(NPROMPT + b * 16 + e - 30) * DH + ch] << 16);
        c += p.dw_w[j * 512 + ch] * v; }
    float s1 = wave_sum(c), s2 = wave_sum(c * c);
    f32x2* red = (f32x2*)shm;
    if (lane == 0) red[wid] = (f32x2){s1, s2};
    __syncthreads();
    s1 = 0.f; s2 = 0.f;
#pragma unroll
    for (int w8 = 0; w8 < 8; ++w8) { const f32x2 q = red[w8]; s1 += q[0]; s2 += q[1]; }
    const float mean = s1 * (1.0f / 512.0f), var = s2 * (1.0f / 512.0f) - mean * mean, rs = rsqrtf(var + 1e-5f);
    const float y = (c - mean) * rs * p.ln_g[ch] + p.ln_b[ch];
    PC[(size_t)r * DM + 512 + ch] = (bf16_t)(cvt_pk_bf16(silu_f(y), 0.f) & 0xffffu);
    __syncthreads();
}

__device__ __forceinline__ void wait_counters(unsigned* c0, unsigned t0, unsigned* c1, unsigned t1, unsigned* c2, unsigned t2) {
    if (threadIdx.x == 0) { unsigned sp = 0u;
        while (xb_ld(c0) < t0 || xb_ld(c1) < t1 || xb_ld(c2) < t2) { __builtin_amdgcn_s_sleep(1); if (++sp > (1u << 22)) break; }
        __builtin_amdgcn_fence(__ATOMIC_ACQUIRE, "agent"); asm volatile("s_waitcnt vmcnt(0)" ::: "memory"); }
    __syncthreads();
}
__device__ __forceinline__ void phase_mixer_pre(const Params& p, unsigned char* shm, const int s, const int gbase, int off, int len) {
    int tid = threadIdx.x; asm volatile("" : "+v"(tid));
    sample_token(p, shm, s);
    f32x2 w2[31];
    { const float* wp = p.dw_w + (tid & 255) * 2;
#pragma unroll
      for (int j = 0; j < 31; ++j) w2[j] = *(const f32x2*)(wp + j * 512); }
#pragma unroll 1
    while (len > 0) {
        const int take = (len >= 96 || len == 64) ? 64 : (len == 80 ? 48 : (len > 64 ? 32 : len)), r0 = gbase + off, t0 = r0 & (SEQ - 1);
        int tq = tid; asm volatile("" : "+v"(tq));
        if (take == 64) mixer_chunk<64>(p, shm, r0, t0, tq, w2); else if (take == 48) mixer_chunk<48>(p, shm, r0, t0, tq, w2); else mixer_chunk<32>(p, shm, r0, t0, tq, w2);
        off += take; len -= take;
    }
}

__global__ void __launch_bounds__(512, 2) hymba_fwd(Params p) {
    extern __shared__ __attribute__((aligned(16))) unsigned char shm[];
    LAS unsigned char* lds = (LAS unsigned char*)shm;
    const int G = gridDim.x, c = blockIdx.x;
    volatile LAS unsigned* st = (volatile LAS unsigned*)(lds + pg8::STAGE_BYTES);
    if (threadIdx.x == 0) { st[0] = 0u; st[1] = 0u; st[2] = 0u; st[3] = 0u; }
    __syncthreads();
    const XcdBarrier xb = xcd_barrier_post((unsigned*)(p.ws + WS_BAR), st);
    phase_prep(p, shm);
    xcd_barrier(xb);
    const bool uni = st[3] != 0u;
    const int gx = uni ? (int)xb.x : (c & 7), gl = uni ? (int)st[2] : (c >> 3);
    const int sidx = 32 * gx + gl;
    const int pm = 8 * gx + (gl & 7), pn = gl >> 3;
    const int n3 = gx < 2 ? 18 : 17;
    unsigned* cw = (unsigned*)(p.ws + WS_CNT);
    if (gl >= n3) {
        late_weight_prep(p, shm, (gx < 2 ? 14 * gx : 28 + 15 * (gx - 2)) + (gl - n3), 118);
        asm volatile("s_waitcnt vmcnt(0)" ::: "memory");
        __syncthreads();
        if (threadIdx.x == 0) { __builtin_amdgcn_fence(__ATOMIC_RELEASE, "agent"); asm volatile("s_waitcnt vmcnt(0)" ::: "memory"); (void)xb_add(cw + 64 * CW_LW, 1u); }
    }
    { SchedP1 S{(const char*)(p.ws + WS_XB), (const char*)(p.ws + WS_WIN), cw, gx, gl, uni};
      EpiP1 E{(bf16_t*)(p.ws + WS_U), (bf16_t*)(p.ws + WS_SGP), (bf16_t*)(p.ws + WS_V), (bf16_t*)(p.ws + WS_SGC), p.out};
      f32x4 acc[2][2][4][2]; pg8::gemm_phase(lds, DM, DM, S, E, acc); }
    if (uni) {
        const unsigned n_s8 = gx < 2 ? 16u : 8u;
        if (gl == 31) {
            wait_counters(cw + 64 * (CW_RV + gx), 384u, cw + 64 * (CW_SV + gx), n_s8, cw + 64 * (CW_SV + gx), n_s8);
            if (threadIdx.x == 0) { __builtin_amdgcn_fence(__ATOMIC_RELEASE, "agent"); asm volatile("s_waitcnt vmcnt(0)" ::: "memory"); (void)xb_add(cw + 64 * CW_GV, 1u); }
        }
        wait_counters(cw + 64 * (CW_RV + gx), 384u, cw + 64 * CW_GV, 8u, cw + 64 * CW_GV, 8u);
    } else xcd_barrier(xb);
    {
      const int E2 = 32 - n3; int off, len;
      if (!uni) { off = 64 * gl; len = 64; }
      else if (gl >= n3) { off = 96 * (gl - n3); len = 96; }
      else { const int remu = (2048 - 96 * E2) / 16, base = remu / n3, extra = remu % n3; off = 96 * E2 + 16 * (gl * base + (gl < extra ? gl : extra)); len = 16 * (base + (gl < extra ? 1 : 0)); }
      phase_mixer_pre(p, shm, sidx, 2048 * gx, off, len); }
    if (uni) { xcc_barrier(xb, [] {}); wait_counters(cw + 64 * CW_LW, 118u, cw + 64 * CW_LW, 118u, cw + 64 * CW_LW, 118u); } else xcd_barrier(xb);
    sample_p3(p, shm, sidx);
    { SchedP3 S{(const char*)(p.ws + WS_PC), (const char*)(p.ws + WS_MIX), (const char*)(p.ws + WS_PW), pm, pn};
      EpiP3 E{(const bf16_t*)(p.ws + WS_SGP), (const bf16_t*)(p.ws + WS_SGC), p.pw_b, (bf16_t*)(p.ws + WS_Z)};
      f32x4 acc[2][2][4][2]; pg8::gemm_phase(lds, DM, 512, S, E, acc); }
    { SchedP4 S{(const char*)(p.ws + WS_Z), (const char*)(p.ws + WS_WOUT), pm, pn};
      EpiP4 E{p.x_prompt, p.final_g, p.out, (float*)(p.ws + WS_XS), (unsigned*)(p.ws + WS_CNT), (const float*)(p.ws + WS_SS), NPROMPT + sidx, uni};
      f32x4 acc[2][2][4][2]; pg8::Unit u4; const bool has4 = S.next(0, u4);
      int tid4 = threadIdx.x; asm volatile("" : "+v"(tid4));
      const int wid4 = __builtin_amdgcn_readfirstlane(tid4 >> 6), lane4 = tid4 & 63;
      const auto hook = [&] { if (has4) E.init(acc, u4, wid4 >> 2, wid4 & 3, lane4 & 15, lane4 >> 4); };
      if (uni) xcc_barrier(xb, hook); else xcd_barrier(xb, hook);
      sample_p4(p, shm, sidx);
      pg8::gemm_phase(lds, DM, DM, S, E, acc); }
}

extern "C" void kernel_launch(void* const* d_in, const int* in_sizes, int n_in, void* d_out, int out_size, void* d_ws, size_t ws_size, hipStream_t stream) {
    constexpr int LDS_BYTES = pg8::STAGE_BYTES + 16;
    static int grid = 0;
    if (grid == 0) {
        if (n_in != 16 || ws_size < WS_END) { fprintf(stderr, "kernel_launch: unexpected inputs (n_in %d, ws %zu)\n", n_in, ws_size); grid = -1; return; }
        int dev = 0, cus = 0, per_cu = 0;
        (void)hipGetDevice(&dev); (void)hipDeviceGetAttribute(&cus, hipDeviceAttributeMultiprocessorCount, dev);
        if (hipFuncSetAttribute((const void*)hymba_fwd, hipFuncAttributeMaxDynamicSharedMemorySize, LDS_BYTES) != hipSuccess) { fprintf(stderr, "kernel_launch: hipFuncSetAttribute failed\n"); grid = -1; return; }
        if (hipOccupancyMaxActiveBlocksPerMultiprocessor(&per_cu, (const void*)hymba_fwd, 512, LDS_BYTES) != hipSuccess || per_cu < 1) { fprintf(stderr, "kernel_launch: occupancy query says %d\n", per_cu); per_cu = 1; (void)hipGetLastError(); }
        if (cus < 256) { fprintf(stderr, "kernel_launch: built for a 256-CU device (got %d CUs)\n", cus); grid = -1; return; }
        grid = 256;
    }
    if (grid < 0) return;
    if (hipMemsetAsync((char*)d_ws + WS_BAR, 0, WS_CTL_BYTES, stream) != hipSuccess) { fprintf(stderr, "kernel_launch: memset of the barrier words failed\n"); return; }
    Params p{};
    p.x_prompt = (const float*)d_in[0]; p.x_sample = (const float*)d_in[1]; p.cache_pool = (const float*)d_in[2]; p.cache_conv = (const float*)d_in[3];
    p.norm_g = (const float*)d_in[4]; p.w_in = (const float*)d_in[5]; p.pool_mix = (const float*)d_in[6]; p.pool_scale = (const float*)d_in[7];
    p.dw_w = (const float*)d_in[8]; p.dw_b = (const float*)d_in[9]; p.ln_g = (const float*)d_in[10]; p.ln_b = (const float*)d_in[11];
    p.pw_w = (const float*)d_in[12]; p.pw_b = (const float*)d_in[13]; p.w_out = (const float*)d_in[14]; p.final_g = (const float*)d_in[15];
    p.out = (float*)d_out; p.ws = (unsigned char*)d_ws;
    void* args[] = {&p};
    hipError_t e = hipLaunchCooperativeKernel((const void*)hymba_fwd, dim3(grid), dim3(512), args, LDS_BYTES, stream);
    if (e != hipSuccess) fprintf(stderr, "kernel_launch: cooperative launch failed: %s (grid %d)\n", hipGetErrorString(e), grid);
}
```

```cpp
#include <hip/hip_runtime.h>
#include <cstdio>

#define LAS __attribute__((address_space(3)))
typedef unsigned short bf16_t;
typedef short bf16x8 __attribute__((ext_vector_type(8)));
typedef float f32x4 __attribute__((ext_vector_type(4)));
typedef float f32x2 __attribute__((ext_vector_type(2)));
typedef unsigned u32x4 __attribute__((ext_vector_type(4)));
typedef unsigned u32x2 __attribute__((ext_vector_type(2)));

constexpr int DM = 1024, NPROMPT = 16384, NSAMP = 256, MT = NPROMPT + NSAMP, DIN = 2560, DH = 512;
constexpr int SEQ = 4096, DSEQ = 16;
constexpr size_t O_Y = 0;
constexpr size_t O_SPP = (size_t)MT * DM;
constexpr size_t O_SCP = O_SPP + 4 * 15 * 512;
constexpr size_t O_SPS = O_SCP + 4 * 30 * 512;
constexpr size_t O_SCS = O_SPS + 16 * 15 * 512;
constexpr size_t WS_XB = 0;
constexpr size_t WS_WIN = WS_XB + (size_t)MT * DM * 2;
constexpr size_t WS_MIX = WS_WIN + (size_t)DIN * DM * 2;
constexpr size_t WS_PW = WS_MIX + (size_t)512 * 512 * 2;
constexpr size_t WS_WOUT = WS_PW + (size_t)512 * 512 * 2;
constexpr size_t WS_U = WS_WOUT + (size_t)1024 * 1024 * 2;
constexpr size_t WS_SGP = WS_U + (size_t)MT * DH * 2;
constexpr size_t WS_V = WS_SGP + (size_t)MT * DH * 2;
constexpr size_t WS_SGC = WS_V + (size_t)MT * DH * 2;
constexpr size_t WS_PC = WS_SGC + (size_t)MT * DH * 2;
constexpr size_t WS_Z = WS_PC + (size_t)MT * DM * 2;
constexpr size_t WS_SS = WS_Z + (size_t)MT * DM * 2;
constexpr size_t WS_BAR = (WS_SS + (size_t)MT * 4 + 255) / 256 * 256;
constexpr size_t WS_CNT = WS_BAR + 4608 * 4;
constexpr size_t WS_CTL_BYTES = 4608 * 4 + 96 * 256;
constexpr int CW_PIECES = 64, CW_RV = 65  , CW_SV = 73  , CW_GV = 81  , CW_LW = 82  ;
constexpr size_t WS_XS = WS_CNT + 96 * 256;
constexpr size_t WS_END = WS_XS + (size_t)64 * 4 * 256 * 4;

struct Params {
    const float* x_prompt; const float* x_sample; const float* cache_pool; const float* cache_conv; const float* norm_g; const float* w_in;
    const float* pool_mix; const float* pool_scale; const float* dw_w; const float* dw_b; const float* ln_g; const float* ln_b;
    const float* pw_w; const float* pw_b; const float* w_out; const float* final_g;
    float* out; unsigned char* ws;
};

__device__ __forceinline__ unsigned cvt_pk_bf16(float lo, float hi) { unsigned r; asm volatile("v_cvt_pk_bf16_f32 %0, %1, %2" : "=v"(r) : "v"(lo), "v"(hi)); return r; }
__device__ __forceinline__ float bf_lo(unsigned u) { return __uint_as_float(u << 16); }
__device__ __forceinline__ float bf_hi(unsigned u) { return __uint_as_float(u & 0xffff0000u); }
__device__ __forceinline__ f32x2 bf_unpack(unsigned u) { return (f32x2){bf_lo(u), bf_hi(u)}; }
__device__ __forceinline__ float sigmoid_f(float x) { return __builtin_amdgcn_rcpf(1.0f + __expf(-x)); }
__device__ __forceinline__ float silu_f(float x) { return x * sigmoid_f(x); }
__device__ __forceinline__ u32x4 pack8(f32x4 a, f32x4 b) { return (u32x4){cvt_pk_bf16(a[0], a[1]), cvt_pk_bf16(a[2], a[3]), cvt_pk_bf16(b[0], b[1]), cvt_pk_bf16(b[2], b[3])}; }
__device__ __forceinline__ float wave_sum(float v) {
#pragma unroll
    for (int o = 32; o > 0; o >>= 1) v += __shfl_xor(v, o);
    return v;
}


#define XB_TMO      128
#define XB_XCNT(j)  (256  + 64 * (j))
#define XB_XSUB(j)  (1280 + 64 * (j))
#define XB_XGEN(j)  (2304 + 64 * (j))
#define XB_TOP      3328
#define XB_TOPGEN   3392
#define XB_XLOC(j)  (3520 + 64 * (j))
#define XCD_BAR_WORDS 4608
#define XB_SPIN_CAP (1u << 18)
__device__ __forceinline__ unsigned xb_ld(unsigned* p)              { return __hip_atomic_load(p, __ATOMIC_RELAXED, __HIP_MEMORY_SCOPE_AGENT); }
__device__ __forceinline__ unsigned xb_add(unsigned* p, unsigned v) { return __hip_atomic_fetch_add(p, v, __ATOMIC_RELAXED, __HIP_MEMORY_SCOPE_AGENT); }
__device__ __forceinline__ unsigned xb_xcc_id() { return (unsigned)__builtin_amdgcn_s_getreg((3 << 11) | 20) & 0xFu; }
#define XB_SPIN(cond, bar) do { unsigned _sp = 0; while (cond) { __builtin_amdgcn_s_sleep(1); \
    if ((++_sp & 255u) == 0u) { if (xb_ld(&(bar)[XB_TMO])) break; if (_sp > XB_SPIN_CAP) { atomicAdd(&(bar)[XB_TMO], 1u); break; } } } } while (0)
struct XcdBarrier { unsigned* bar; unsigned x; volatile LAS unsigned* st; };
__device__ __forceinline__ XcdBarrier xcd_barrier_post(unsigned* bar, volatile LAS unsigned* st) {
    XcdBarrier b; b.bar = bar; b.x = xb_xcc_id(); b.st = st;
    if (threadIdx.x == 0) st[2] = xb_add(&bar[XB_XCNT(b.x)], 1u);
    return b;
}
__device__ __forceinline__ void xcd_barrier_complete(unsigned* bar, unsigned x, unsigned& nloc, unsigned& nx, unsigned& uni) {
    const unsigned G = gridDim.x * gridDim.y * gridDim.z;
    unsigned sum, cnt, mine, sp = 0u;
    for (;;) {
        sum = 0u; cnt = 0u; mine = 0u; uni = 1u;
#pragma unroll
        for (unsigned j = 0; j < 16; ++j) { const unsigned c = xb_ld(&bar[XB_XCNT(j)]); sum += c; cnt += (c > 0u) ? 1u : 0u; mine = (j == x) ? c : mine; uni = (c == (j < 8 ? 32u : 0u)) ? uni : 0u; }
        if (sum == G) break;
        __builtin_amdgcn_s_sleep(1);
        if ((++sp & 255u) == 0u) { if (xb_ld(&bar[XB_TMO])) break; if (sp > XB_SPIN_CAP) { atomicAdd(&bar[XB_TMO], 1u); break; } }
    }
    nloc = mine > 0u ? mine : 1u; nx = cnt > 0u ? cnt : 1u; uni = (sum == G) ? uni : 0u;
}
template <class Hook>
__device__ __forceinline__ void xcd_barrier(const XcdBarrier& b, const Hook& hook) {
    asm volatile("s_waitcnt vmcnt(0)" ::: "memory");
    __syncthreads();
    if (threadIdx.x >= 64) hook();
    if (threadIdx.x == 0) {
        unsigned* bar = b.bar;
        __builtin_amdgcn_s_waitcnt(0);
        unsigned nloc = b.st[0], nx = b.st[1];
        if (nloc == 0u) { unsigned uni; xcd_barrier_complete(bar, b.x, nloc, nx, uni); b.st[0] = nloc; b.st[1] = nx; b.st[3] = uni; }
        const unsigned old = xb_add(&bar[XB_XSUB(b.x)], 1u);
        const unsigned gen = old / nloc;
        if (old + 1u == (gen + 1u) * nloc) {
            __builtin_amdgcn_fence(__ATOMIC_RELEASE, "agent");
            asm volatile("s_waitcnt vmcnt(0)" ::: "memory");
            const unsigned og = xb_add(&bar[XB_TOP], 1u);
            const unsigned tg = og / nx;
            if (og + 1u == (tg + 1u) * nx) xb_add(&bar[XB_TOPGEN], 1u);
            else XB_SPIN(xb_ld(&bar[XB_TOPGEN]) == tg, bar);
            __builtin_amdgcn_fence(__ATOMIC_ACQUIRE, "agent");
            xb_add(&bar[XB_XGEN(b.x)], 1u);
            asm volatile("s_waitcnt vmcnt(0)" ::: "memory");
        } else {
            XB_SPIN(xb_ld(&bar[XB_XGEN(b.x)]) == gen, bar);
            __builtin_amdgcn_fence(__ATOMIC_ACQUIRE, "agent");
            asm volatile("s_waitcnt vmcnt(0)" ::: "memory");
        }
    }
    if (threadIdx.x < 64) hook();
    __syncthreads();
}
__device__ __forceinline__ void xcd_barrier(const XcdBarrier& b) { xcd_barrier(b, [] {}); }
template <class Hook>
__device__ __forceinline__ void xcc_barrier(const XcdBarrier& b, const Hook& hook) {
    asm volatile("s_waitcnt vmcnt(0)" ::: "memory");
    __syncthreads();
    if (threadIdx.x >= 64) hook();
    if (threadIdx.x == 0) {
        unsigned* w = &b.bar[XB_XLOC(b.x)];
        __builtin_amdgcn_s_waitcnt(0);
        const unsigned old = xb_add(w, 1u), target = (old / 32u + 1u) * 32u;
        XB_SPIN(xb_ld(w) < target, b.bar);
        __builtin_amdgcn_fence(__ATOMIC_ACQUIRE, "agent");
        asm volatile("s_waitcnt vmcnt(0)" ::: "memory");
    }
    if (threadIdx.x < 64) hook();
    __syncthreads();
}

namespace pg8 {
constexpr int BM = 256, BK = 64, HALF = 128, HTB = HALF * BK * 2, STAGE_BYTES = 8 * HTB, NXCD = 8, WGM = 8;
__device__ __forceinline__ int lds_byte(int r, int c) { const int st = (r >> 4) * 2 + (c >> 5), rr = r & 15, cc = c & 31, ob = rr * 64 + cc * 2; return st * 1024 + (ob ^ (((ob >> 9) & 1) << 5)); }
__device__ __forceinline__ void stage_rc(int b, int& R, int& C) { const int st = b / 1024, sb = b % 1024, swz = sb ^ (((sb >> 9) & 1) << 5); R = (st >> 1) * 16 + swz / 64; C = (st & 1) * 32 + (swz % 64) / 2; }
__device__ __forceinline__ int perm32(int rho) { const int n = rho >> 4, i = rho & 15; return 8 * (i >> 2) + 4 * n + (i & 3); }

struct Unit { const char* A; const char* B; int pm, pn, nt, kind; };

__device__ __forceinline__ bool tile_order(int i, int G, int c, int nM, int nN, int& pm, int& pn) {
    const int nwg = nM * nN; const long L = (long)i * G + c; if (L >= nwg) return false;
    int wgid = (int)L; { const int q = nwg / NXCD, r = nwg % NXCD, xcd = wgid % NXCD, off = wgid / NXCD; wgid = (xcd < r ? xcd * (q + 1) : r * (q + 1) + (xcd - r) * q) + off; }
    const int nig = WGM * nN, gid = wgid / nig, fm = gid * WGM, gsz = (nM - fm) < WGM ? (nM - fm) : WGM;
    pm = fm + ((wgid % nig) % gsz); pn = (wgid % nig) / gsz; return true;
}

template <class Epi, class Sched>
__device__ __forceinline__ void gemm_phase(LAS unsigned char* lds, const int lda, const int ldb, const Sched& S, const Epi& E, f32x4 (&acc)[2][2][4][2]) {
    int tid_ = threadIdx.x; asm volatile("" : "+v"(tid_));
    const int tid = tid_, wid = __builtin_amdgcn_readfirstlane(tid >> 6), lane = tid & 63, wr = wid >> 2, wc = wid & 3, fr = lane & 15, fq = lane >> 4;
    unsigned voffA[2], voffB[2];
#pragma unroll
    for (int i = 0; i < 2; ++i) { int R, C; stage_rc(tid * 16 + i * 8192, R, C); const int Rb = Epi::PERM ? ((R & ~31) + perm32(R & 31)) : R;
        voffA[i] = (unsigned)(R * lda + C) * 2u; voffB[i] = (unsigned)(Rb * ldb + C) * 2u; }
    const size_t kstep = (size_t)(BK * 2);
    const size_t hstepA = (size_t)HALF * lda * 2, hstepB = (size_t)HALF * ldb * 2;
    const unsigned ldsw = (unsigned)wid * 1024u;
    const int aoff = lds_byte(wr * 64 + fr, fq * 8), boff = lds_byte(wc * 32 + fr, fq * 8);
#define PG8_SA(b, h) (((b) * 2 + (h)) * HTB)
#define PG8_SB(b, h) ((4 + (b) * 2 + (h)) * HTB)
#define PG8_STAGE(bufoff, gbase, voff) do { _Pragma("unroll") for (int _i = 0; _i < 2; ++_i) \
        __builtin_amdgcn_global_load_lds((const unsigned*)((const char*)(gbase) + (voff)[_i]), (LAS unsigned*)(lds + (bufoff) + ldsw + _i * 8192), 16, 0, 0); } while (0)
#define PG8_LDA(dst, b, h) do { _Pragma("unroll") for (int m = 0; m < 4; ++m) _Pragma("unroll") for (int k = 0; k < 2; ++k) dst[m][k] = *(const LAS bf16x8*)(lds + PG8_SA(b, h) + aoff + m * 2048 + k * 1024); } while (0)
#define PG8_LDB(dst, b, h) do { _Pragma("unroll") for (int n = 0; n < 2; ++n) _Pragma("unroll") for (int k = 0; k < 2; ++k) dst[n][k] = *(const LAS bf16x8*)(lds + PG8_SB(b, h) + boff + n * 2048 + k * 1024); } while (0)
#define PG8_MMA(ai, bj, At, Bt) do { __builtin_amdgcn_s_setprio(1); _Pragma("unroll") for (int m = 0; m < 4; ++m) _Pragma("unroll") for (int n = 0; n < 2; ++n) _Pragma("unroll") for (int k = 0; k < 2; ++k) \
        acc[ai][bj][m][n] = __builtin_amdgcn_mfma_f32_16x16x32_bf16(Bt[n][k], At[m][k], acc[ai][bj][m][n], 0, 0, 0); __builtin_amdgcn_s_setprio(0); } while (0)
#define PG8_WAIT_V(n) asm volatile("s_waitcnt vmcnt(" #n ")" ::: "memory")
#define PG8_WAIT_L(n) asm volatile("s_waitcnt lgkmcnt(" #n ")" ::: "memory")
#define PG8_BAR __builtin_amdgcn_s_barrier()
#define PG8_SCHED __builtin_amdgcn_sched_barrier(0)
    Unit cur, nxt; int ui = 0;
    if (!S.next(0, cur)) return;
    if constexpr (!Epi::EXT_INIT) E.init(acc, cur, wr, wc, fr, fq);
    bf16x8 At[4][2], B0[2][2], B1[2][2];
    const char* cA = cur.A; const char* cB = cur.B;
    PG8_STAGE(PG8_SB(0, 0), cB, voffB); PG8_STAGE(PG8_SA(0, 0), cA, voffA); PG8_STAGE(PG8_SB(0, 1), cB + hstepB, voffB); PG8_STAGE(PG8_SA(0, 1), cA + hstepA, voffA);
    if (wr == 1) PG8_BAR;
    PG8_WAIT_V(4); PG8_BAR;
    PG8_STAGE(PG8_SB(1, 0), cB + kstep, voffB); PG8_STAGE(PG8_SA(1, 0), cA + kstep, voffA); PG8_STAGE(PG8_SB(1, 1), cB + hstepB + kstep, voffB);
    PG8_WAIT_V(6); PG8_BAR;
    for (;;) {
        const bool has_next = S.next(ui + 1, nxt);
        const char* nA = has_next ? nxt.A : cA; const char* nB = has_next ? nxt.B : cB;
        const int nt = cur.nt;
        for (int t = 0; t < nt; t += 2) {
            const bool last = (t == nt - 2);
            const char* a1 = cA + (size_t)(t + 1) * kstep;
            const char* a2 = last ? nA : cA + (size_t)(t + 2) * kstep; const char* b2 = last ? nB : cB + (size_t)(t + 2) * kstep;
            const char* a3 = a2 + kstep; const char* b3 = b2 + kstep;
            PG8_LDB(B0, 0, 0); PG8_SCHED; PG8_LDA(At, 0, 0); PG8_STAGE(PG8_SA(1, 1), a1 + hstepA, voffA);
            PG8_WAIT_L(8); PG8_BAR; PG8_WAIT_L(0); PG8_MMA(0, 0, At, B0); PG8_BAR; PG8_SCHED;
            PG8_LDB(B1, 0, 1); PG8_STAGE(PG8_SB(0, 0), b2, voffB);
            PG8_BAR; PG8_WAIT_L(0); PG8_MMA(0, 1, At, B1); PG8_BAR;
            PG8_LDA(At, 0, 1); PG8_STAGE(PG8_SA(0, 0), a2, voffA);
            PG8_BAR; PG8_WAIT_L(0); PG8_MMA(1, 0, At, B0); PG8_BAR; PG8_SCHED;
            PG8_STAGE(PG8_SB(0, 1), b2 + hstepB, voffB);
            PG8_WAIT_V(6); PG8_BAR; PG8_MMA(1, 1, At, B1); PG8_BAR;
            PG8_LDB(B0, 1, 0); PG8_SCHED; PG8_LDA(At, 1, 0); PG8_STAGE(PG8_SA(0, 1), a2 + hstepA, voffA);
            PG8_WAIT_L(8); PG8_BAR; PG8_WAIT_L(0); PG8_MMA(0, 0, At, B0); PG8_BAR; PG8_SCHED;
            PG8_LDB(B1, 1, 1); PG8_STAGE(PG8_SB(1, 0), b3, voffB);
            PG8_BAR; PG8_WAIT_L(0); PG8_MMA(0, 1, At, B1); PG8_BAR;
            PG8_LDA(At, 1, 1); PG8_STAGE(PG8_SA(1, 0), a3, voffA);
            PG8_BAR; PG8_WAIT_L(0); PG8_MMA(1, 0, At, B0); PG8_BAR; PG8_SCHED;
            PG8_STAGE(PG8_SB(1, 1), b3 + hstepB, voffB);
            PG8_WAIT_V(6); PG8_BAR; PG8_MMA(1, 1, At, B1); PG8_BAR;
        }
        if constexpr (!Epi::AFTER_DRAIN) { E(acc, cur, wr, wc, fr, fq); S.done(cur, ui, lane); }
        if (!has_next) break;
        cur = nxt; cA = nA; cB = nB; ++ui;
        E.init(acc, cur, wr, wc, fr, fq);
    }
    PG8_WAIT_V(0);
    if (wr == 0) PG8_BAR;
    PG8_BAR;
    if constexpr (Epi::AFTER_DRAIN) E.fused(acc, cur, wr, wc, fr, fq, lds, tid);
#undef PG8_SA
#undef PG8_SB
#undef PG8_STAGE
#undef PG8_LDA
#undef PG8_LDB
#undef PG8_MMA
#undef PG8_WAIT_V
#undef PG8_WAIT_L
#undef PG8_BAR
#undef PG8_SCHED
}
}

struct SchedP1 {
    const char* xb; const char* win; unsigned* cnt; int gx, gl; bool uni;
    __device__ __forceinline__ bool next(int i, pg8::Unit& u) const {
        const int n_s = gx < 2 ? 2 : 1, j = gl + 32 * i; if (j >= 80 + n_s) return false;
        int pm, pn, kind;
        if (j < n_s) { pm = NPROMPT / 256; pn = gx + 8 * j; kind = 2; }
        else if (j < n_s + 48) { const int k = j - n_s, q = k >> 3; pm = 8 * gx + (k & 7); pn = q < 2 ? q : q + 2; kind = 1; }
        else { const int k = j - n_s - 48, q = k >> 3; pm = 8 * gx + (k & 7); pn = q < 2 ? q + 2 : q + 6; kind = 0; }
        u.pm = pm; u.pn = pn; u.kind = kind; u.nt = 16; u.A = xb + (size_t)pm * 256 * DM * 2; u.B = win + (size_t)pn * 256 * DM * 2; return true;
    }
    __device__ __forceinline__ void done(const pg8::Unit&, int ui, int lane) const {
        if (!uni) return;
        const int n_s = gx < 2 ? 2 : 1, nuv = gl < n_s + 16 ? 2 : 1;
        if (ui != nuv - 1) return;
        asm volatile("s_waitcnt vmcnt(0)" ::: "memory");
        if (lane == 0) { const int sm = gl < n_s ? 1 : 0, uv = nuv - sm;
            (void)xb_add(cnt + 64 * (CW_RV + gx), (unsigned)uv);
            if (sm) (void)xb_add(cnt + 64 * (CW_SV + gx), 1u); }
    }
};
struct EpiP1 {
    static constexpr bool PERM = true, AFTER_DRAIN = false, EXT_INIT = false;
    bf16_t* U; bf16_t* SGP; bf16_t* V; bf16_t* SGC; float* out;
    __device__ __forceinline__ void init(f32x4 (&acc)[2][2][4][2], const pg8::Unit&, int, int, int, int) const {
#pragma unroll
        for (int a = 0; a < 2; ++a)
#pragma unroll
            for (int b = 0; b < 2; ++b)
#pragma unroll
                for (int m = 0; m < 4; ++m)
#pragma unroll
                    for (int n = 0; n < 2; ++n) acc[a][b][m][n] = (f32x4){0.f, 0.f, 0.f, 0.f};
    }
    __device__ __forceinline__ void operator()(const f32x4 (&acc)[2][2][4][2], const pg8::Unit& u, int wr, int wc, int fr, int fq) const {
        const int pn = u.pn, row0 = u.pm * 256 + wr * 64 + fr, cl = wc * 32 + 8 * fq;
        if (pn < 2) {
#pragma unroll
            for (int ai = 0; ai < 2; ++ai)
#pragma unroll
                for (int m = 0; m < 4; ++m) {
                    const int r = row0 + ai * 128 + m * 16; bool st; size_t so;
                    if (r < NPROMPT) { const int t = r & (SEQ - 1); st = t >= SEQ - 15; so = O_SPP + ((size_t)(r >> 12) * 15 + (t - (SEQ - 15))) * 512; }
                    else { const int s = r - NPROMPT, t = s & 15; st = t >= 1; so = O_SPS + ((size_t)(s >> 4) * 15 + (t - 1)) * 512; }
#pragma unroll
                    for (int bj = 0; bj < 2; ++bj) { const int c = pn * 256 + bj * 128 + cl; const f32x4 v0 = acc[ai][bj][m][0], v1 = acc[ai][bj][m][1];
                        *(u32x4*)(U + (size_t)r * DH + c) = pack8(v0, v1);
                        if (st) { *(f32x4*)(out + so + c) = v0; *(f32x4*)(out + so + c + 4) = v1; } }
                }
        } else if (pn < 4 || pn >= 8) {
            bf16_t* dst = pn < 4 ? SGP : SGC; const int cb = (pn < 4 ? pn - 2 : pn - 8) * 256 + cl;
#pragma unroll
            for (int ai = 0; ai < 2; ++ai)
#pragma unroll
                for (int m = 0; m < 4; ++m) { const int r = row0 + ai * 128 + m * 16;
#pragma unroll
                    for (int bj = 0; bj < 2; ++bj) { f32x4 v0 = acc[ai][bj][m][0], v1 = acc[ai][bj][m][1];
#pragma unroll
                        for (int j = 0; j < 4; ++j) { v0[j] = silu_f(v0[j]); v1[j] = silu_f(v1[j]); }
                        *(u32x4*)(dst + (size_t)r * DH + cb + bj * 128) = pack8(v0, v1); }
                }
        } else {
            const int c = (pn - 4) * 128 + cl;
#pragma unroll
            for (int ai = 0; ai < 2; ++ai)
#pragma unroll
                for (int m = 0; m < 4; ++m) {
                    const int r = row0 + ai * 128 + m * 16; bool st; size_t so;
                    if (r < NPROMPT) { const int t = r & (SEQ - 1); st = t >= SEQ - 30; so = O_SCP + ((size_t)(r >> 12) * 30 + (t - (SEQ - 30))) * 512; }
                    else { const int s = r - NPROMPT, t = s & 15; st = true; so = O_SCS + ((size_t)(s >> 4) * 30 + 14 + t) * 512; }
                    f32x4 v0 = acc[ai][0][m][0], v1 = acc[ai][0][m][1]; const f32x4 g0 = acc[ai][1][m][0], g1 = acc[ai][1][m][1];
#pragma unroll
                    for (int j = 0; j < 4; ++j) { v0[j] *= sigmoid_f(g0[j]); v1[j] *= sigmoid_f(g1[j]); }
                    *(u32x4*)(V + (size_t)r * DH + c) = pack8(v0, v1);
                    if (st) { *(f32x4*)(out + so + c) = v0; *(f32x4*)(out + so + c + 4) = v1; }
                }
        }
    }
};

struct SchedP3 {
    const char* pc; const char* mix; const char* pw; int pm0, pn0;
    __device__ __forceinline__ void done(const pg8::Unit&, int, int) const {}
    __device__ __forceinline__ bool next(int i, pg8::Unit& u) const {
        if (i != 0) return false; const int pm = pm0, pn = pn0;
        u.pm = pm; u.pn = pn; u.kind = 0;
        if (pn < 2) { u.nt = 4; u.A = pc + ((size_t)pm * 256 * DM + 256 * pn) * 2; u.B = mix + ((size_t)pn * 256 * 512 + 256 * pn) * 2; }
        else { u.nt = 8; u.A = pc + ((size_t)pm * 256 * DM + 512) * 2; u.B = pw + (size_t)(pn - 2) * 256 * 512 * 2; }
        return true;
    }
};
struct EpiP3 {
    static constexpr bool PERM = true, AFTER_DRAIN = false, EXT_INIT = false;
    const bf16_t* SGP; const bf16_t* SGC; const float* pw_b; bf16_t* Z;
    __device__ __forceinline__ void init(f32x4 (&acc)[2][2][4][2], const pg8::Unit&, int, int, int, int) const {
#pragma unroll
        for (int a = 0; a < 2; ++a)
#pragma unroll
            for (int b = 0; b < 2; ++b)
#pragma unroll
                for (int m = 0; m < 4; ++m)
#pragma unroll
                    for (int n = 0; n < 2; ++n) acc[a][b][m][n] = (f32x4){0.f, 0.f, 0.f, 0.f};
    }
    __device__ __forceinline__ void operator()(const f32x4 (&acc)[2][2][4][2], const pg8::Unit& u, int wr, int wc, int fr, int fq) const {
        const int pn = u.pn, row0 = u.pm * 256 + wr * 64 + fr, cl = wc * 32 + 8 * fq;
        const bool conv = pn >= 2; const bf16_t* gate = conv ? SGC : SGP; const int cb = (conv ? pn - 2 : pn) * 256 + cl;
        f32x4 bv[2][2];
#pragma unroll
        for (int bj = 0; bj < 2; ++bj)
#pragma unroll
            for (int n = 0; n < 2; ++n) bv[bj][n] = conv ? *(const f32x4*)(pw_b + cb + bj * 128 + 4 * n) : (f32x4){0.f, 0.f, 0.f, 0.f};
#pragma unroll
        for (int ai = 0; ai < 2; ++ai) {
            u32x4 gt[4][2];
#pragma unroll
            for (int m = 0; m < 4; ++m)
#pragma unroll
                for (int bj = 0; bj < 2; ++bj) gt[m][bj] = *(const u32x4*)(gate + (size_t)(row0 + ai * 128 + m * 16) * DH + cb + bj * 128);
#pragma unroll
            for (int m = 0; m < 4; ++m) { const int r = row0 + ai * 128 + m * 16;
#pragma unroll
                for (int bj = 0; bj < 2; ++bj) { const int c = cb + bj * 128; const u32x4 g = gt[m][bj];
                    f32x4 v0 = acc[ai][bj][m][0] + bv[bj][0], v1 = acc[ai][bj][m][1] + bv[bj][1];
                    v0[0] *= bf_lo(g[0]); v0[1] *= bf_hi(g[0]); v0[2] *= bf_lo(g[1]); v0[3] *= bf_hi(g[1]);
                    v1[0] *= bf_lo(g[2]); v1[1] *= bf_hi(g[2]); v1[2] *= bf_lo(g[3]); v1[3] *= bf_hi(g[3]);
                    *(u32x4*)(Z + (size_t)r * DM + (conv ? 512 : 0) + c) = pack8(v0, v1); }
            }
        }
    }
};

struct SchedP4 {
    const char* z; const char* wout; int pm0, pn0;
    __device__ __forceinline__ void done(const pg8::Unit&, int, int) const {}
    __device__ __forceinline__ bool next(int i, pg8::Unit& u) const {
        if (i != 0) return false; const int pm = pm0, pn = pn0;
        u.pm = pm; u.pn = pn; u.kind = 0; u.nt = 16; u.A = z + (size_t)pm * 256 * DM * 2; u.B = wout + (size_t)pn * 256 * DM * 2; return true;
    }
};
struct EpiP4 {
    static constexpr bool PERM = false, AFTER_DRAIN = true, EXT_INIT = true;
    const float* x_prompt; const float* final_g; float* out; float* xs; unsigned* cnt; const float* ss; int srow; bool uni;
    __device__ __forceinline__ void init(f32x4 (&acc)[2][2][4][2], const pg8::Unit& u, int wr, int wc, int fr, int fq) const {
        const int row0 = u.pm * 256 + wr * 64 + fr, col0 = u.pn * 256 + wc * 32 + 4 * fq;
#pragma unroll
        for (int ai = 0; ai < 2; ++ai)
#pragma unroll
            for (int m = 0; m < 4; ++m) { const float* xr = x_prompt + (size_t)(row0 + ai * 128 + m * 16) * DM + col0;
#pragma unroll
                for (int bj = 0; bj < 2; ++bj)
#pragma unroll
                    for (int n = 0; n < 2; ++n) acc[ai][bj][m][n] = *(const f32x4*)(xr + bj * 128 + n * 16); }
    }
    __device__ __forceinline__ void fused(const f32x4 (&acc)[2][2][4][2], const pg8::Unit& u, int wr, int wc, int fr, int fq, LAS unsigned char* lds, int tid) const {
        LAS float* lss = (LAS float*)lds;
#pragma unroll
        for (int ai = 0; ai < 2; ++ai)
#pragma unroll
            for (int m = 0; m < 4; ++m) { float s = 0.f;
#pragma unroll
                for (int bj = 0; bj < 2; ++bj)
#pragma unroll
                    for (int n = 0; n < 2; ++n) { const f32x4 y = acc[ai][bj][m][n]; s += y[0] * y[0] + y[1] * y[1] + y[2] * y[2] + y[3] * y[3]; }
                s += __shfl_xor(s, 16); s += __shfl_xor(s, 32);
                if (fq == 0) lss[(ai * 128 + wr * 64 + m * 16 + fr) * 4 + wc] = s; }
        __syncthreads();
        if (tid < 256) { const f32x4 v = *(const LAS f32x4*)(lss + tid * 4); xs[((size_t)u.pm * 4 + u.pn) * 256 + tid] = v[0] + v[1] + v[2] + v[3]; }
        asm volatile("s_waitcnt vmcnt(0)" ::: "memory");
        __syncthreads();
        if (tid == 0) {
            unsigned* cw = cnt + 64 * u.pm; unsigned* cs = cnt + 64 * CW_PIECES;
            if (!uni) __builtin_amdgcn_fence(__ATOMIC_RELEASE, "agent");
            asm volatile("s_waitcnt vmcnt(0)" ::: "memory");
            (void)xb_add(cw, 1u);
            unsigned sp = 0u;
            while (xb_ld(cw) < 4u || xb_ld(cs) < 256u) { __builtin_amdgcn_s_sleep(1); if (++sp > (1u << 22)) break; }
            __builtin_amdgcn_fence(__ATOMIC_ACQUIRE, "agent");
            asm volatile("s_waitcnt vmcnt(0)" ::: "memory");
        }
        __syncthreads();
        if (tid >= 256) { const int t4 = (tid - 256) * 4; const float rs = rsqrtf(ss[srow] * (1.0f / DM) + 1e-6f); float* yr = out + (size_t)srow * DM + t4;
            *(f32x4*)yr = *(const f32x4*)yr * rs * *(const f32x4*)(final_g + t4); }
        if (tid < 256) { const float* xp = xs + (size_t)u.pm * 4 * 256 + tid; const float tot = xp[0] + xp[256] + xp[512] + xp[768];
            lss[1024 + tid] = rsqrtf(tot * (1.0f / DM) + 1e-6f); }
        __syncthreads();
        const int row0 = u.pm * 256 + wr * 64 + fr, col0 = u.pn * 256 + wc * 32 + 4 * fq;
        f32x4 g4[2][2];
#pragma unroll
        for (int bj = 0; bj < 2; ++bj)
#pragma unroll
            for (int n = 0; n < 2; ++n) g4[bj][n] = *(const f32x4*)(final_g + col0 + bj * 128 + n * 16);
#pragma unroll
        for (int ai = 0; ai < 2; ++ai)
#pragma unroll
            for (int m = 0; m < 4; ++m) { const float rs = lss[1024 + ai * 128 + wr * 64 + m * 16 + fr]; float* yr = out + (size_t)(row0 + ai * 128 + m * 16) * DM + col0;
#pragma unroll
                for (int bj = 0; bj < 2; ++bj)
#pragma unroll
                    for (int n = 0; n < 2; ++n) *(f32x4*)(yr + bj * 128 + n * 16) = acc[ai][bj][m][n] * rs * g4[bj][n]; }
    }
    __device__ __forceinline__ void operator()(const f32x4 (&)[2][2][4][2], const pg8::Unit&, int, int, int, int) const {}
};

template <int NF>
__device__ __forceinline__ f32x4 small_gemm(const bf16_t* __restrict__ A, int lda, const bf16_t* __restrict__ Bt, int ldb, int K, int nw, f32x4* red) {
    const int tid = threadIdx.x, wid = tid >> 6, lane = tid & 63, fr = lane & 15, fq = lane >> 4;
    f32x4 acc[NF];
#pragma unroll
    for (int f = 0; f < NF; ++f) acc[f] = (f32x4){0.f, 0.f, 0.f, 0.f};
    if (wid < nw) { const int ks = K / nw; const bf16_t* ap = A + (size_t)fr * lda + wid * ks + fq * 8; const bf16_t* bp = Bt + (size_t)fr * ldb + wid * ks + fq * 8;
        for (int k = 0; k < ks; k += 32) { const bf16x8 a = *(const bf16x8*)(ap + k);
#pragma unroll
            for (int f = 0; f < NF; ++f) { const bf16x8 b = *(const bf16x8*)(bp + (size_t)f * 16 * ldb + k); acc[f] = __builtin_amdgcn_mfma_f32_16x16x32_bf16(b, a, acc[f], 0, 0, 0); } } }
#pragma unroll
    for (int f = 0; f < NF; ++f) red[(wid * NF + f) * 64 + lane] = acc[f];
    __syncthreads();
    f32x4 r = (f32x4){0.f, 0.f, 0.f, 0.f};
    if (tid < 64 * NF) {
#pragma unroll
        for (int w = 0; w < 8; ++w) r += red[(w * NF + wid) * 64 + lane]; }
    return r;
}
__device__ __forceinline__ void sample_p3(const Params& p, unsigned char* shm, const int i) {
    const int tid = threadIdx.x, wid = tid >> 6, lane = tid & 63, fr = lane & 15, fq = lane >> 4; f32x4* red = (f32x4*)shm;
    const bf16_t* PC = (const bf16_t*)(p.ws + WS_PC); bf16_t* Z = (bf16_t*)(p.ws + WS_Z);
    { const int rb = i >> 4, cb = i & 15, row0 = NPROMPT + rb * 16, row = row0 + fr, c = 32 * cb + 16 * wid + 4 * fq;
        {
            const f32x4 r = small_gemm<2>(PC + (size_t)row0 * DM + 512, DM, (const bf16_t*)(p.ws + WS_PW) + (size_t)32 * cb * 512, 512, 512, 8, red);
            if (tid < 128) { const f32x4 bv = *(const f32x4*)(p.pw_b + c); const u32x2 g = *(const u32x2*)((const bf16_t*)(p.ws + WS_SGC) + (size_t)row * DH + c);
                const f32x4 z = (r + bv) * (f32x4){bf_lo(g[0]), bf_hi(g[0]), bf_lo(g[1]), bf_hi(g[1])};
                *(u32x2*)(Z + (size_t)row * DM + 512 + c) = (u32x2){cvt_pk_bf16(z[0], z[1]), cvt_pk_bf16(z[2], z[3])}; }
            __syncthreads();
        }
        {
            const int g128 = (cb >> 2) * 128;
            const f32x4 r = small_gemm<2>(PC + (size_t)row0 * DM + g128, DM, (const bf16_t*)(p.ws + WS_MIX) + (size_t)32 * cb * 512 + g128, 512, 128, 4, red);
            if (tid < 128) { const u32x2 g = *(const u32x2*)((const bf16_t*)(p.ws + WS_SGP) + (size_t)row * DH + c);
                const f32x4 z = r * (f32x4){bf_lo(g[0]), bf_hi(g[0]), bf_lo(g[1]), bf_hi(g[1])};
                *(u32x2*)(Z + (size_t)row * DM + c) = (u32x2){cvt_pk_bf16(z[0], z[1]), cvt_pk_bf16(z[2], z[3])}; }
            __syncthreads();
        }
    }
}
__device__ __forceinline__ void sample_p4(const Params& p, unsigned char* shm, const int i) {
    const int tid = threadIdx.x, wid = tid >> 6, lane = tid & 63, fr = lane & 15, fq = lane >> 4; f32x4* red = (f32x4*)shm;
    float* ss = (float*)(p.ws + WS_SS);
    { const int rb = i >> 4, cb = i & 15, row0 = NPROMPT + rb * 16, row = row0 + fr, c = 64 * cb + 16 * wid + 4 * fq;
        const f32x4 r = small_gemm<4>((const bf16_t*)(p.ws + WS_Z) + (size_t)row0 * DM, DM, (const bf16_t*)(p.ws + WS_WOUT) + (size_t)64 * cb * DM, DM, DM, 8, red);
        if (tid < 256) { const f32x4 y = r + *(const f32x4*)(p.x_sample + (size_t)(row - NPROMPT) * DM + c);
            *(f32x4*)(p.out + (size_t)row * DM + c) = y;
            float s = y[0] * y[0] + y[1] * y[1] + y[2] * y[2] + y[3] * y[3]; s += __shfl_xor(s, 16); s += __shfl_xor(s, 32);
            if (fq == 0) atomicAdd(ss + row, s); }
        asm volatile("s_waitcnt vmcnt(0)" ::: "memory");
        __syncthreads();
        if (tid == 0) { __builtin_amdgcn_fence(__ATOMIC_RELEASE, "agent"); asm volatile("s_waitcnt vmcnt(0)" ::: "memory"); (void)xb_add((unsigned*)(p.ws + WS_CNT) + 64 * CW_PIECES, 1u); }
    }
}
__device__ __forceinline__ void transpose_load(const float* __restrict__ src, int ldsrc, int k0, int n0s, f32x4 (&v)[2]) {
    const int tid = threadIdx.x, kk = tid >> 4, n4 = (tid & 15) * 4;
#pragma unroll
    for (int i = 0; i < 2; ++i) v[i] = *(const f32x4*)(src + (size_t)(k0 + kk + 32 * i) * ldsrc + n0s + n4);
}
__device__ __forceinline__ void transpose_store(const f32x4 (&v)[2], int k0, bf16_t* __restrict__ dst, int ldd, int n0d, float* tile) {
    const int tid = threadIdx.x;
    {
        const int kk = tid >> 4, n4 = (tid & 15) * 4;
#pragma unroll
        for (int i = 0; i < 2; ++i) { const int k = kk + 32 * i;
            tile[k * 65 + n4 + 0] = v[i][0]; tile[k * 65 + n4 + 1] = v[i][1]; tile[k * 65 + n4 + 2] = v[i][2]; tile[k * 65 + n4 + 3] = v[i][3]; }
    }
    __syncthreads();
    {
        const int n = tid >> 3, k8 = (tid & 7) * 8; float w[8];
#pragma unroll
        for (int j = 0; j < 8; ++j) w[j] = tile[(k8 + j) * 65 + n];
        *(u32x4*)(dst + (size_t)(n0d + n) * ldd + k0 + k8) = (u32x4){cvt_pk_bf16(w[0], w[1]), cvt_pk_bf16(w[2], w[3]), cvt_pk_bf16(w[4], w[5]), cvt_pk_bf16(w[6], w[7])};
    }
    __syncthreads();
}
__device__ __forceinline__ void transpose_tile(const float* __restrict__ src, int ldsrc, int k0, int n0s, bf16_t* __restrict__ dst, int ldd, int n0d, float* tile) {
    f32x4 v[2]; transpose_load(src, ldsrc, k0, n0s, v); transpose_store(v, k0, dst, ldd, n0d, tile);
}
__device__ __forceinline__ int win_src_col(int n0) {
    if (n0 >= 1024 && n0 < 2048) { const int q = n0 - 1024, j = q >> 8, i = q & 255; return i < 128 ? 1024 + 128 * j + i : 1536 + 128 * j + (i - 128); }
    return n0;
}

__device__ __forceinline__ void phase_prep(const Params& p, unsigned char* shm) {
    const int tid = threadIdx.x, wid = tid >> 6, lane = tid & 63, nb = gridDim.x, bid = blockIdx.x;
    bf16_t* xb = (bf16_t*)(p.ws + WS_XB);
    constexpr int T_IN = 16 * 40;
    f32x4 tv[3][2];
#pragma unroll
    for (int q = 0; q < 3; ++q) { const int t = bid + q * nb; if (t < T_IN) transpose_load(p.w_in, DIN, (t / 40) * 64, win_src_col((t % 40) * 64), tv[q]); }
    {
        f32x4 g4[4];
#pragma unroll
        for (int i = 0; i < 4; ++i) g4[i] = *(const f32x4*)(p.norm_g + lane * 4 + 256 * i);
        for (int g = bid * 8 + wid; g < MT / 4; g += nb * 8) {
            f32x4 v[4][4]; float s[4];
#pragma unroll
            for (int q = 0; q < 4; ++q) { const int r = g * 4 + q; const float* xr = r < NPROMPT ? p.x_prompt + (size_t)r * DM : p.x_sample + (size_t)(r - NPROMPT) * DM;
#pragma unroll
                for (int i = 0; i < 4; ++i) v[q][i] = *(const f32x4*)(xr + lane * 4 + 256 * i); }
#pragma unroll
            for (int q = 0; q < 4; ++q) { s[q] = 0.f;
#pragma unroll
                for (int i = 0; i < 4; ++i) s[q] += v[q][i][0] * v[q][i][0] + v[q][i][1] * v[q][i][1] + v[q][i][2] * v[q][i][2] + v[q][i][3] * v[q][i][3];
                s[q] = wave_sum(s[q]); }
#pragma unroll
            for (int q = 0; q < 4; ++q) { const int r = g * 4 + q; const float rs = rsqrtf(s[q] * (1.0f / DM) + 1e-6f);
#pragma unroll
                for (int i = 0; i < 4; ++i) { const f32x4 h = v[q][i] * rs * g4[i];
                    *(u32x2*)(xb + (size_t)r * DM + lane * 4 + 256 * i) = (u32x2){cvt_pk_bf16(h[0], h[1]), cvt_pk_bf16(h[2], h[3])}; } }
        }
    }
    {
        float* tile = (float*)shm; bf16_t* win = (bf16_t*)(p.ws + WS_WIN);
#pragma unroll
        for (int q = 0; q < 3; ++q) { const int t = bid + q * nb; if (t < T_IN) transpose_store(tv[q], (t / 40) * 64, win, DM, (t % 40) * 64, tile); }
        for (int t = bid + 3 * nb; t < T_IN; t += nb) transpose_tile(p.w_in, DIN, (t / 40) * 64, win_src_col((t % 40) * 64), win, DM, (t % 40) * 64, tile);
    }
    float* ss = (float*)(p.ws + WS_SS);
    for (int i = bid * 512 + tid; i < MT; i += nb * 512) ss[i] = 0.f;
    for (int i = bid * 512 + tid; i < 16 * 14 * 128; i += nb * 512) { const int c4 = i & 127, rr = i >> 7, b = rr / 14, j = rr % 14;
        *(f32x4*)(p.out + O_SCS + ((size_t)b * 30 + j) * 512 + c4 * 4) = *(const f32x4*)(p.cache_conv + ((size_t)b * 30 + 16 + j) * 512 + c4 * 4); }
}

__device__ __forceinline__ void late_weight_prep(const Params& p, unsigned char* shm, const int bid, const int nb) {
    const int tid = threadIdx.x; float* tile = (float*)shm;
    bf16_t* pw = (bf16_t*)(p.ws + WS_PW); bf16_t* wout = (bf16_t*)(p.ws + WS_WOUT); bf16_t* mix = (bf16_t*)(p.ws + WS_MIX);
    constexpr int T_OUT = 16 * 16, T_PW = 8 * 8;
    for (int t = bid; t < T_OUT + T_PW; t += nb) {
        if (t < T_OUT) transpose_tile(p.w_out, DM, (t >> 4) * 64, (t & 15) * 64, wout, DM, (t & 15) * 64, tile);
        else { const int tt = t - T_OUT; transpose_tile(p.pw_w, 512, (tt >> 3) * 64, (tt & 7) * 64, pw, 512, (tt & 7) * 64, tile); }
    }
    for (int idx = bid * 512 + tid; idx < 512 * 512; idx += nb * 512) { const int n = idx >> 9, k = idx & 511; float v = 0.f;
        if ((n >> 7) == (k >> 7)) v = p.pool_mix[((size_t)(n >> 7) * 128 + (k & 127)) * 128 + (n & 127)] * p.pool_scale[n];
        mix[idx] = (bf16_t)(cvt_pk_bf16(v, 0.f) & 0xffffu); }
    __syncthreads();
}

#define DPP_STEP(v, ctrl) ((v) + __builtin_bit_cast(float, __builtin_amdgcn_update_dpp(0, __builtin_bit_cast(int, (v)), (ctrl), 0xf, 0xf, true)))
__device__ __forceinline__ float wave_sum_hi(float v) {
    v = DPP_STEP(v, 0xB1);
    v = DPP_STEP(v, 0x4E);
    v = DPP_STEP(v, 0x141);
    v = DPP_STEP(v, 0x140);
    v += __builtin_bit_cast(float, __builtin_amdgcn_update_dpp(0, __builtin_bit_cast(int, v), 0x142, 0xa, 0xf, false));
    v += __builtin_bit_cast(float, __builtin_amdgcn_update_dpp(0, __builtin_bit_cast(int, v), 0x143, 0xc, 0xf, false));
    return v;
}
template <int W, int TH>
__device__ __forceinline__ void pool_regs(const unsigned (&u)[TH + 15], const int pos0, bf16_t* __restrict__ dst  ) {
    f32x2 s = (f32x2){0.f, 0.f};
#pragma unroll
    for (int j = 0; j < W; ++j) s += bf_unpack(u[15 - j]);
#pragma unroll
    for (int i = 0; i < TH; ++i) { const f32x2 cur = bf_unpack(u[15 + i]); const int pos1 = pos0 + i + 1;
        const float inv = pos1 >= W ? (1.0f / W) : __builtin_amdgcn_rcpf((float)pos1);
        const f32x2 o = s * inv - cur;
        *(unsigned*)(dst + (size_t)i * DM) = cvt_pk_bf16(o[0], o[1]);
        if (i + 1 < TH) s += bf_unpack(u[16 + i]) - bf_unpack(u[16 + i - W]); }
}
template <int T>
__device__ __forceinline__ void mixer_chunk(const Params& p, unsigned char* shm, const int r0, const int t0, const int tid, const f32x2 (&w2)[31]) {
    constexpr int TH = T / 2, ROUNDS = T / 16, NV = ((T + 30) * 64 + 511) / 512;
    const int cp = tid & 255, th = tid >> 8, lane = tid & 63, wv = (tid >> 6) & 3;
    const bf16_t* U = (const bf16_t*)(p.ws + WS_U); const bf16_t* V = (const bf16_t*)(p.ws + WS_V); bf16_t* PC = (bf16_t*)(p.ws + WS_PC);
    const unsigned* l32 = (const unsigned*)shm;
    u32x4 val[NV];
    {
        const bf16_t* vb = V + (size_t)(r0 - 30) * DH;
#pragma unroll
        for (int k = 0; k < NV; ++k) { const int idx = tid + k * 512, lr = idx >> 6; val[k] = (u32x4){0u, 0u, 0u, 0u};
            if (idx < (T + 30) * 64 && t0 - 30 + lr >= 0) val[k] = *(const u32x4*)(vb + (size_t)idx * 8); }
    }
    unsigned u[TH + 15];
    {
        const int f0 = th * TH - 15; const bf16_t* ub = U + (size_t)(r0 + f0) * DH + cp * 2;
#pragma unroll
        for (int k = 0; k < TH + 15; ++k) { u[k] = 0u; if (t0 + f0 + k >= 0) u[k] = *(const unsigned*)(ub + (size_t)k * DH); }
    }
#pragma unroll
    for (int k = 0; k < NV; ++k) { const int idx = tid + k * 512; if (idx < (T + 30) * 64) *(u32x4*)(shm + (size_t)idx * 16) = val[k]; }
    const f32x2 bias = *(const f32x2*)(p.dw_b + cp * 2);
    const f32x2 g2 = *(const f32x2*)(p.ln_g + cp * 2), b2 = *(const f32x2*)(p.ln_b + cp * 2);
    __syncthreads();
    {
        bf16_t* dst = PC + (size_t)(r0 + th * TH) * DM + cp * 2; const int pos0 = t0 + th * TH;
        switch (cp >> 6) { case 0: pool_regs<2, TH>(u, pos0, dst); break; case 1: pool_regs<4, TH>(u, pos0, dst); break; case 2: pool_regs<8, TH>(u, pos0, dst); break; default: pool_regs<16, TH>(u, pos0, dst); break; }
    }
    f32x2* stats = (f32x2*)(shm + (T + 30) * 1024);
#pragma unroll 1
    for (int rd = 0; rd < ROUNDS; ++rd) {
        const int tt = rd * 16 + th * 8;
        f32x2 c[8];
#pragma unroll
        for (int i = 0; i < 8; ++i) c[i] = bias;
#pragma unroll
        for (int q = 0; q < 38; ++q) { const f32x2 v = bf_unpack(l32[(tt + q) * 256 + cp]);
#pragma unroll
            for (int i = 0; i < 8; ++i) if (q - i >= 0 && q - i < 31) c[i] += w2[q - i] * v; }
#pragma unroll
        for (int i = 0; i < 8; ++i) { const float s1 = wave_sum_hi(c[i][0] + c[i][1]), s2 = wave_sum_hi(c[i][0] * c[i][0] + c[i][1] * c[i][1]);
            if (lane == 63) stats[(tt + i) * 4 + wv] = (f32x2){s1, s2}; }
        __syncthreads();
        float mean_l, rs_l;
        { const int ti = tt + (lane & 7);
          const f32x4 sa = *(const f32x4*)(stats + ti * 4), sb = *(const f32x4*)(stats + ti * 4 + 2);
          mean_l = (sa[0] + sa[2] + sb[0] + sb[2]) * (1.0f / 512.0f);
          const float var = (sa[1] + sa[3] + sb[1] + sb[3]) * (1.0f / 512.0f) - mean_l * mean_l;
          rs_l = __builtin_amdgcn_rsqf(var + 1e-5f); }
#pragma unroll
        for (int i = 0; i < 8; ++i) {
            const float mean = __builtin_bit_cast(float, __builtin_amdgcn_readlane(__builtin_bit_cast(int, mean_l), i));
            const float rs = __builtin_bit_cast(float, __builtin_amdgcn_readlane(__builtin_bit_cast(int, rs_l), i));
            const f32x2 y = (c[i] - mean) * rs * g2 + b2;
            *(unsigned*)(PC + (size_t)(r0 + tt + i) * DM + 512 + cp * 2) = cvt_pk_bf16(silu_f(y[0]), silu_f(y[1])); }
    }
    __syncthreads();
}

__device__ __forceinline__ void sample_token(const Params& p, unsigned char* shm, const int s) {
    const int tid = threadIdx.x, wid = tid >> 6, lane = tid & 63, b = s >> 4, t = s & 15, r = NPROMPT + s, ch = tid;
    const bf16_t* U = (const bf16_t*)(p.ws + WS_U); const bf16_t* V = (const bf16_t*)(p.ws + WS_V); bf16_t* PC = (bf16_t*)(p.ws + WS_PC);
    {
        const int w = 2 << (ch >> 7); float sum = 0.f, cur = 0.f;
#pragma unroll
        for (int j = 0; j < 16; ++j) if (j < w) { const int e = t + 15 - j;
            const float v = e < 15 ? p.cache_pool[((size_t)b * 15 + e) * 512 + ch] : __uint_as_float((unsigned)U[(size_t)(NPROMPT + b * 16 + e - 15) * DH + ch] << 16);
            sum += v; if (j == 0) cur = v; }
        const float o = sum / (float)w - cur;
        PC[(size_t)r * DM + ch] = (bf16_t)(cvt_pk_bf16(o, 0.f) & 0xffffu);
    }
    float c = p.dw_b[ch];
#pragma unroll
    for (int j = 0; j < 31; ++j) { const int e = t + j;
        const float v = e < 30 ? p.cache_conv[((size_t)b * 30 + e) * 512 + ch] : __uint_as_float((unsigned)V[(size_t)(NPROMPT + b * 16 + e - 30) * DH + ch] << 16);
        c += p.dw_w[j * 512 + ch] * v; }
    float s1 = wave_sum(c), s2 = wave_sum(c * c);
    f32x2* red = (f32x2*)shm;
    if (lane == 0) red[wid] = (f32x2){s1, s2};
    __syncthreads();
    s1 = 0.f; s2 = 0.f;
#pragma unroll
    for (int w8 = 0; w8 < 8; ++w8) { const f32x2 q = red[w8]; s1 += q[0]; s2 += q[1]; }
    const float mean = s1 * (1.0f / 512.0f), var = s2 * (1.0f / 512.0f) - mean * mean, rs = rsqrtf(var + 1e-5f);
    const float y = (c - mean) * rs * p.ln_g[ch] + p.ln_b[ch];
    PC[(size_t)r * DM + 512 + ch] = (bf16_t)(cvt_pk_bf16(silu_f(y), 0.f) & 0xffffu);
    __syncthreads();
}

__device__ __forceinline__ void wait_counters(unsigned* c0, unsigned t0, unsigned* c1, unsigned t1, unsigned* c2, unsigned t2) {
    if (threadIdx.x == 0) { unsigned sp = 0u;
        while (xb_ld(c0) < t0 || xb_ld(c1) < t1 || xb_ld(c2) < t2) { __builtin_amdgcn_s_sleep(1); if (++sp > (1u << 22)) break; }
        __builtin_amdgcn_fence(__ATOMIC_ACQUIRE, "agent"); asm volatile("s_waitcnt vmcnt(0)" ::: "memory"); }
    __syncthreads();
}
__device__ __forceinline__ void phase_mixer_pre(const Params& p, unsigned char* shm, const int gbase, int off, int len) {
    int tid = threadIdx.x; asm volatile("" : "+v"(tid));
    f32x2 w2[31];
    { const float* wp = p.dw_w + (tid & 255) * 2;
#pragma unroll
      for (int j = 0; j < 31; ++j) w2[j] = *(const f32x2*)(wp + j * 512); }
#pragma unroll 1
    while (len > 0) {
        const int take = (len >= 96 || len == 64) ? 64 : (len == 80 ? 48 : (len > 64 ? 32 : len)), r0 = gbase + off, t0 = r0 & (SEQ - 1);
        int tq = tid; asm volatile("" : "+v"(tq));
        if (take == 64) mixer_chunk<64>(p, shm, r0, t0, tq, w2); else if (take == 48) mixer_chunk<48>(p, shm, r0, t0, tq, w2); else mixer_chunk<32>(p, shm, r0, t0, tq, w2);
        off += take; len -= take;
    }
}

__global__ void __launch_bounds__(512, 2) hymba_fwd(Params p) {
    extern __shared__ __attribute__((aligned(16))) unsigned char shm[];
    LAS unsigned char* lds = (LAS unsigned char*)shm;
    const int G = gridDim.x, c = blockIdx.x;
    volatile LAS unsigned* st = (volatile LAS unsigned*)(lds + pg8::STAGE_BYTES);
    if (threadIdx.x == 0) { st[0] = 0u; st[1] = 0u; st[2] = 0u; st[3] = 0u; }
    __syncthreads();
    const XcdBarrier xb = xcd_barrier_post((unsigned*)(p.ws + WS_BAR), st);
    phase_prep(p, shm);
    xcd_barrier(xb);
    const bool uni = st[3] != 0u;
    const int gx = uni ? (int)xb.x : (c & 7), gl = uni ? (int)st[2] : (c >> 3);
    const int sidx = 32 * gx + gl;
    const int pm = 8 * gx + (gl & 7), pn = gl >> 3;
    const int n3 = gx < 2 ? 18 : 17;
    unsigned* cw = (unsigned*)(p.ws + WS_CNT);
    if (gl >= n3) {
        late_weight_prep(p, shm, (gx < 2 ? 14 * gx : 28 + 15 * (gx - 2)) + (gl - n3), 118);
        asm volatile("s_waitcnt vmcnt(0)" ::: "memory");
        __syncthreads();
        if (threadIdx.x == 0) { __builtin_amdgcn_fence(__ATOMIC_RELEASE, "agent"); asm volatile("s_waitcnt vmcnt(0)" ::: "memory"); (void)xb_add(cw + 64 * CW_LW, 1u); }
    }
    { SchedP1 S{(const char*)(p.ws + WS_XB), (const char*)(p.ws + WS_WIN), cw, gx, gl, uni};
      EpiP1 E{(bf16_t*)(p.ws + WS_U), (bf16_t*)(p.ws + WS_SGP), (bf16_t*)(p.ws + WS_V), (bf16_t*)(p.ws + WS_SGC), p.out};
      f32x4 acc[2][2][4][2]; pg8::gemm_phase(lds, DM, DM, S, E, acc); }
    if (uni) {
        const unsigned n_s8 = gx < 2 ? 16u : 8u;
        if (gl == 31) {
            wait_counters(cw + 64 * (CW_RV + gx), 384u, cw + 64 * (CW_SV + gx), n_s8, cw + 64 * (CW_SV + gx), n_s8);
            if (threadIdx.x == 0) { __builtin_amdgcn_fence(__ATOMIC_RELEASE, "agent"); asm volatile("s_waitcnt vmcnt(0)" ::: "memory"); (void)xb_add(cw + 64 * CW_GV, 1u); }
        }
        const bool halo = (gx & 1) && gl == n3;
        wait_counters(cw + 64 * (CW_RV + gx), 384u, cw + 64 * CW_GV, halo ? 8u : 0u, cw + 64 * CW_GV, 0u);
    } else xcd_barrier(xb);
    {
      const int E2 = 32 - n3; int off, len;
      if (!uni) { off = 64 * gl; len = 64; }
      else if (gl >= n3) { off = 96 * (gl - n3); len = 96; }
      else { const int remu = (2048 - 96 * E2) / 16, base = remu / n3, extra = remu % n3; off = 96 * E2 + 16 * (gl * base + (gl < extra ? gl : extra)); len = 16 * (base + (gl < extra ? 1 : 0)); }
      phase_mixer_pre(p, shm, 2048 * gx, off, len); }
    if (uni) wait_counters(cw + 64 * CW_GV, 8u, cw + 64 * CW_GV, 8u, cw + 64 * CW_GV, 8u);
    sample_token(p, shm, sidx);
    if (uni) { xcc_barrier(xb, [] {}); wait_counters(cw + 64 * CW_LW, 118u, cw + 64 * CW_LW, 118u, cw + 64 * CW_LW, 118u); } else xcd_barrier(xb);
    sample_p3(p, shm, sidx);
    { SchedP3 S{(const char*)(p.ws + WS_PC), (const char*)(p.ws + WS_MIX), (const char*)(p.ws + WS_PW), pm, pn};
      EpiP3 E{(const bf16_t*)(p.ws + WS_SGP), (const bf16_t*)(p.ws + WS_SGC), p.pw_b, (bf16_t*)(p.ws + WS_Z)};
      f32x4 acc[2][2][4][2]; pg8::gemm_phase(lds, DM, 512, S, E, acc); }
    { SchedP4 S{(const char*)(p.ws + WS_Z), (const char*)(p.ws + WS_WOUT), pm, pn};
      EpiP4 E{p.x_prompt, p.final_g, p.out, (float*)(p.ws + WS_XS), (unsigned*)(p.ws + WS_CNT), (const float*)(p.ws + WS_SS), NPROMPT + sidx, uni};
      f32x4 acc[2][2][4][2]; pg8::Unit u4; const bool has4 = S.next(0, u4);
      int tid4 = threadIdx.x; asm volatile("" : "+v"(tid4));
      const int wid4 = __builtin_amdgcn_readfirstlane(tid4 >> 6), lane4 = tid4 & 63;
      const auto hook = [&] { if (has4) E.init(acc, u4, wid4 >> 2, wid4 & 3, lane4 & 15, lane4 >> 4); };
      if (uni) xcc_barrier(xb, hook); else xcd_barrier(xb, hook);
      sample_p4(p, shm, sidx);
      pg8::gemm_phase(lds, DM, DM, S, E, acc); }
}

extern "C" void kernel_launch(void* const* d_in, const int* in_sizes, int n_in, void* d_out, int out_size, void* d_ws, size_t ws_size, hipStream_t stream) {
    constexpr int LDS_BYTES = pg8::STAGE_BYTES + 16;
    static int grid = 0;
    if (grid == 0) {
        if (n_in != 16 || ws_size < WS_END) { fprintf(stderr, "kernel_launch: unexpected inputs (n_in %d, ws %zu)\n", n_in, ws_size); grid = -1; return; }
        int dev = 0, cus = 0, per_cu = 0;
        (void)hipGetDevice(&dev); (void)hipDeviceGetAttribute(&cus, hipDeviceAttributeMultiprocessorCount, dev);
        if (hipFuncSetAttribute((const void*)hymba_fwd, hipFuncAttributeMaxDynamicSharedMemorySize, LDS_BYTES) != hipSuccess) { fprintf(stderr, "kernel_launch: hipFuncSetAttribute failed\n"); grid = -1; return; }
        if (hipOccupancyMaxActiveBlocksPerMultiprocessor(&per_cu, (const void*)hymba_fwd, 512, LDS_BYTES) != hipSuccess || per_cu < 1) { fprintf(stderr, "kernel_launch: occupancy query says %d\n", per_cu); per_cu = 1; (void)hipGetLastError(); }
        if (cus < 256) { fprintf(stderr, "kernel_launch: built for a 256-CU device (got %d CUs)\n", cus); grid = -1; return; }
        grid = 256;
    }
    if (grid < 0) return;
    if (hipMemsetAsync((char*)d_ws + WS_BAR, 0, WS_CTL_BYTES, stream) != hipSuccess) { fprintf(stderr, "kernel_launch: memset of the barrier words failed\n"); return; }
    Params p{};
    p.x_prompt = (const float*)d_in[0]; p.x_sample = (const float*)d_in[1]; p.cache_pool = (const float*)d_in[2]; p.cache_conv = (const float*)d_in[3];
    p.norm_g = (const float*)d_in[4]; p.w_in = (const float*)d_in[5]; p.pool_mix = (const float*)d_in[6]; p.pool_scale = (const float*)d_in[7];
    p.dw_w = (const float*)d_in[8]; p.dw_b = (const float*)d_in[9]; p.ln_g = (const float*)d_in[10]; p.ln_b = (const float*)d_in[11];
    p.pw_w = (const float*)d_in[12]; p.pw_b = (const float*)d_in[13]; p.w_out = (const float*)d_in[14]; p.final_g = (const float*)d_in[15];
    p.out = (float*)d_out; p.ws = (unsigned char*)d_ws;
    void* args[] = {&p};
    hipError_t e = hipLaunchCooperativeKernel((const void*)hymba_fwd, dim3(grid), dim3(512), args, LDS_BYTES, stream);
    if (e != hipSuccess) fprintf(stderr, "kernel_launch: cooperative launch failed: %s (grid %d)\n", hipGetErrorString(e), grid);
}
```

```cpp
#include <hip/hip_runtime.h>
#include <cstdio>

#define LAS __attribute__((address_space(3)))
typedef unsigned short bf16_t;
typedef short bf16x8 __attribute__((ext_vector_type(8)));
typedef float f32x4 __attribute__((ext_vector_type(4)));
typedef float f32x2 __attribute__((ext_vector_type(2)));
typedef unsigned u32x4 __attribute__((ext_vector_type(4)));
typedef unsigned u32x2 __attribute__((ext_vector_type(2)));

constexpr int DM = 1024, NPROMPT = 16384, NSAMP = 256, MT = NPROMPT + NSAMP, DIN = 2560, DH = 512;
constexpr int SEQ = 4096, DSEQ = 16;
constexpr size_t O_Y = 0;
constexpr size_t O_SPP = (size_t)MT * DM;
constexpr size_t O_SCP = O_SPP + 4 * 15 * 512;
constexpr size_t O_SPS = O_SCP + 4 * 30 * 512;
constexpr size_t O_SCS = O_SPS + 16 * 15 * 512;
constexpr size_t WS_XB = 0;
constexpr size_t WS_WIN = WS_XB + (size_t)MT * DM * 2;
constexpr size_t WS_MIX = WS_WIN + (size_t)DIN * DM * 2;
constexpr size_t WS_PW = WS_MIX + (size_t)512 * 512 * 2;
constexpr size_t WS_WOUT = WS_PW + (size_t)512 * 512 * 2;
constexpr size_t WS_U = WS_WOUT + (size_t)1024 * 1024 * 2;
constexpr size_t WS_SGP = WS_U + (size_t)MT * DH * 2;
constexpr size_t WS_V = WS_SGP + (size_t)MT * DH * 2;
constexpr size_t WS_SGC = WS_V + (size_t)MT * DH * 2;
constexpr size_t WS_PC = WS_SGC + (size_t)MT * DH * 2;
constexpr size_t WS_Z = WS_PC + (size_t)MT * DM * 2;
constexpr size_t WS_SS = WS_Z + (size_t)MT * DM * 2;
constexpr size_t WS_BAR = (WS_SS + (size_t)MT * 4 + 255) / 256 * 256;
constexpr size_t WS_CNT = WS_BAR + 4608 * 4;
constexpr size_t WS_CTL_BYTES = 4608 * 4 + 96 * 256;
constexpr int CW_PIECES = 64, CW_RV = 65  , CW_SV = 73  , CW_GV = 81  , CW_LW = 82  ;
constexpr size_t WS_XS = WS_CNT + 96 * 256;
constexpr size_t WS_END = WS_XS + (size_t)64 * 4 * 256 * 4;

struct Params {
    const float* x_prompt; const float* x_sample; const float* cache_pool; const float* cache_conv; const float* norm_g; const float* w_in;
    const float* pool_mix; const float* pool_scale; const float* dw_w; const float* dw_b; const float* ln_g; const float* ln_b;
    const float* pw_w; const float* pw_b; const float* w_out; const float* final_g;
    float* out; unsigned char* ws;
};

__device__ __forceinline__ unsigned cvt_pk_bf16(float lo, float hi) { unsigned r; asm volatile("v_cvt_pk_bf16_f32 %0, %1, %2" : "=v"(r) : "v"(lo), "v"(hi)); return r; }
__device__ __forceinline__ float bf_lo(unsigned u) { return __uint_as_float(u << 16); }
__device__ __forceinline__ float bf_hi(unsigned u) { return __uint_as_float(u & 0xffff0000u); }
__device__ __forceinline__ f32x2 bf_unpack(unsigned u) { return (f32x2){bf_lo(u), bf_hi(u)}; }
__device__ __forceinline__ float sigmoid_f(float x) { return __builtin_amdgcn_rcpf(1.0f + __expf(-x)); }
__device__ __forceinline__ float silu_f(float x) { return x * sigmoid_f(x); }
__device__ __forceinline__ u32x4 pack8(f32x4 a, f32x4 b) { return (u32x4){cvt_pk_bf16(a[0], a[1]), cvt_pk_bf16(a[2], a[3]), cvt_pk_bf16(b[0], b[1]), cvt_pk_bf16(b[2], b[3])}; }
__device__ __forceinline__ float wave_sum(float v) {
#pragma unroll
    for (int o = 32; o > 0; o >>= 1) v += __shfl_xor(v, o);
    return v;
}


#define XB_TMO      128
#define XB_XCNT(j)  (256  + 64 * (j))
#define XB_XSUB(j)  (1280 + 64 * (j))
#define XB_XGEN(j)  (2304 + 64 * (j))
#define XB_TOP      3328
#define XB_TOPGEN   3392
#define XB_XLOC(j)  (3520 + 64 * (j))
#define XCD_BAR_WORDS 4608
#define XB_SPIN_CAP (1u << 18)
__device__ __forceinline__ unsigned xb_ld(unsigned* p)              { return __hip_atomic_load(p, __ATOMIC_RELAXED, __HIP_MEMORY_SCOPE_AGENT); }
__device__ __forceinline__ unsigned xb_add(unsigned* p, unsigned v) { return __hip_atomic_fetch_add(p, v, __ATOMIC_RELAXED, __HIP_MEMORY_SCOPE_AGENT); }
__device__ __forceinline__ unsigned xb_xcc_id() { return (unsigned)__builtin_amdgcn_s_getreg((3 << 11) | 20) & 0xFu; }
#define XB_SPIN(cond, bar) do { unsigned _sp = 0; while (cond) { __builtin_amdgcn_s_sleep(1); \
    if ((++_sp & 255u) == 0u) { if (xb_ld(&(bar)[XB_TMO])) break; if (_sp > XB_SPIN_CAP) { atomicAdd(&(bar)[XB_TMO], 1u); break; } } } } while (0)
struct XcdBarrier { unsigned* bar; unsigned x; volatile LAS unsigned* st; };
__device__ __forceinline__ XcdBarrier xcd_barrier_post(unsigned* bar, volatile LAS unsigned* st) {
    XcdBarrier b; b.bar = bar; b.x = xb_xcc_id(); b.st = st;
    if (threadIdx.x == 0) st[2] = xb_add(&bar[XB_XCNT(b.x)], 1u);
    return b;
}
__device__ __forceinline__ void xcd_barrier_complete(unsigned* bar, unsigned x, unsigned& nloc, unsigned& nx, unsigned& uni) {
    const unsigned G = gridDim.x * gridDim.y * gridDim.z;
    unsigned sum, cnt, mine, sp = 0u;
    for (;;) {
        sum = 0u; cnt = 0u; mine = 0u; uni = 1u;
#pragma unroll
        for (unsigned j = 0; j < 16; ++j) { const unsigned c = xb_ld(&bar[XB_XCNT(j)]); sum += c; cnt += (c > 0u) ? 1u : 0u; mine = (j == x) ? c : mine; uni = (c == (j < 8 ? 32u : 0u)) ? uni : 0u; }
        if (sum == G) break;
        __builtin_amdgcn_s_sleep(1);
        if ((++sp & 255u) == 0u) { if (xb_ld(&bar[XB_TMO])) break; if (sp > XB_SPIN_CAP) { atomicAdd(&bar[XB_TMO], 1u); break; } }
    }
    nloc = mine > 0u ? mine : 1u; nx = cnt > 0u ? cnt : 1u; uni = (sum == G) ? uni : 0u;
}
template <class Hook>
__device__ __forceinline__ void xcd_barrier(const XcdBarrier& b, const Hook& hook) {
    asm volatile("s_waitcnt vmcnt(0)" ::: "memory");
    __syncthreads();
    if (threadIdx.x >= 64) hook();
    if (threadIdx.x == 0) {
        unsigned* bar = b.bar;
        __builtin_amdgcn_s_waitcnt(0);
        unsigned nloc = b.st[0], nx = b.st[1];
        if (nloc == 0u) { unsigned uni; xcd_barrier_complete(bar, b.x, nloc, nx, uni); b.st[0] = nloc; b.st[1] = nx; b.st[3] = uni; }
        const unsigned old = xb_add(&bar[XB_XSUB(b.x)], 1u);
        const unsigned gen = old / nloc;
        if (old + 1u == (gen + 1u) * nloc) {
            __builtin_amdgcn_fence(__ATOMIC_RELEASE, "agent");
            asm volatile("s_waitcnt vmcnt(0)" ::: "memory");
            const unsigned og = xb_add(&bar[XB_TOP], 1u);
            const unsigned tg = og / nx;
            if (og + 1u == (tg + 1u) * nx) xb_add(&bar[XB_TOPGEN], 1u);
            else XB_SPIN(xb_ld(&bar[XB_TOPGEN]) == tg, bar);
            __builtin_amdgcn_fence(__ATOMIC_ACQUIRE, "agent");
            xb_add(&bar[XB_XGEN(b.x)], 1u);
            asm volatile("s_waitcnt vmcnt(0)" ::: "memory");
        } else {
            XB_SPIN(xb_ld(&bar[XB_XGEN(b.x)]) == gen, bar);
            __builtin_amdgcn_fence(__ATOMIC_ACQUIRE, "agent");
            asm volatile("s_waitcnt vmcnt(0)" ::: "memory");
        }
    }
    if (threadIdx.x < 64) hook();
    __syncthreads();
}
__device__ __forceinline__ void xcd_barrier(const XcdBarrier& b) { xcd_barrier(b, [] {}); }
template <class Hook>
__device__ __forceinline__ void xcc_barrier(const XcdBarrier& b, const Hook& hook) {
    asm volatile("s_waitcnt vmcnt(0)" ::: "memory");
    __syncthreads();
    if (threadIdx.x >= 64) hook();
    if (threadIdx.x == 0) {
        unsigned* w = &b.bar[XB_XLOC(b.x)];
        __builtin_amdgcn_s_waitcnt(0);
        const unsigned old = xb_add(w, 1u), target = (old / 32u + 1u) * 32u;
        XB_SPIN(xb_ld(w) < target, b.bar);
        __builtin_amdgcn_fence(__ATOMIC_ACQUIRE, "agent");
        asm volatile("s_waitcnt vmcnt(0)" ::: "memory");
    }
    if (threadIdx.x < 64) hook();
    __syncthreads();
}

namespace pg8 {
constexpr int BM = 256, BK = 64, HALF = 128, HTB = HALF * BK * 2, STAGE_BYTES = 8 * HTB, NXCD = 8, WGM = 8;
__device__ __forceinline__ int lds_byte(int r, int c) { const int st = (r >> 4) * 2 + (c >> 5), rr = r & 15, cc = c & 31, ob = rr * 64 + cc * 2; return st * 1024 + (ob ^ (((ob >> 9) & 1) << 5)); }
__device__ __forceinline__ void stage_rc(int b, int& R, int& C) { const int st = b / 1024, sb = b % 1024, swz = sb ^ (((sb >> 9) & 1) << 5); R = (st >> 1) * 16 + swz / 64; C = (st & 1) * 32 + (swz % 64) / 2; }
__device__ __forceinline__ int perm32(int rho) { const int n = rho >> 4, i = rho & 15; return 8 * (i >> 2) + 4 * n + (i & 3); }

struct Unit { const char* A; const char* B; int pm, pn, nt, kind; };

__device__ __forceinline__ bool tile_order(int i, int G, int c, int nM, int nN, int& pm, int& pn) {
    const int nwg = nM * nN; const long L = (long)i * G + c; if (L >= nwg) return false;
    int wgid = (int)L; { const int q = nwg / NXCD, r = nwg % NXCD, xcd = wgid % NXCD, off = wgid / NXCD; wgid = (xcd < r ? xcd * (q + 1) : r * (q + 1) + (xcd - r) * q) + off; }
    const int nig = WGM * nN, gid = wgid / nig, fm = gid * WGM, gsz = (nM - fm) < WGM ? (nM - fm) : WGM;
    pm = fm + ((wgid % nig) % gsz); pn = (wgid % nig) / gsz; return true;
}

template <class Epi, class Sched>
__device__ __forceinline__ void gemm_phase(LAS unsigned char* lds, const int lda, const int ldb, const Sched& S, const Epi& E, f32x4 (&acc)[2][2][4][2]) {
    int tid_ = threadIdx.x; asm volatile("" : "+v"(tid_));
    const int tid = tid_, wid = __builtin_amdgcn_readfirstlane(tid >> 6), lane = tid & 63, wr = wid >> 2, wc = wid & 3, fr = lane & 15, fq = lane >> 4;
    unsigned voffA[2], voffB[2];
#pragma unroll
    for (int i = 0; i < 2; ++i) { int R, C; stage_rc(tid * 16 + i * 8192, R, C); const int Rb = Epi::PERM ? ((R & ~31) + perm32(R & 31)) : R;
        voffA[i] = (unsigned)(R * lda + C) * 2u; voffB[i] = (unsigned)(Rb * ldb + C) * 2u; }
    const size_t kstep = (size_t)(BK * 2);
    const size_t hstepA = (size_t)HALF * lda * 2, hstepB = (size_t)HALF * ldb * 2;
    const unsigned ldsw = (unsigned)wid * 1024u;
    const int aoff = lds_byte(wr * 64 + fr, fq * 8), boff = lds_byte(wc * 32 + fr, fq * 8);
#define PG8_SA(b, h) (((b) * 2 + (h)) * HTB)
#define PG8_SB(b, h) ((4 + (b) * 2 + (h)) * HTB)
#define PG8_STAGE(bufoff, gbase, voff) do { _Pragma("unroll") for (int _i = 0; _i < 2; ++_i) \
        __builtin_amdgcn_global_load_lds((const unsigned*)((const char*)(gbase) + (voff)[_i]), (LAS unsigned*)(lds + (bufoff) + ldsw + _i * 8192), 16, 0, 0); } while (0)
#define PG8_LDA(dst, b, h) do { _Pragma("unroll") for (int m = 0; m < 4; ++m) _Pragma("unroll") for (int k = 0; k < 2; ++k) dst[m][k] = *(const LAS bf16x8*)(lds + PG8_SA(b, h) + aoff + m * 2048 + k * 1024); } while (0)
#define PG8_LDB(dst, b, h) do { _Pragma("unroll") for (int n = 0; n < 2; ++n) _Pragma("unroll") for (int k = 0; k < 2; ++k) dst[n][k] = *(const LAS bf16x8*)(lds + PG8_SB(b, h) + boff + n * 2048 + k * 1024); } while (0)
#define PG8_MMA(ai, bj, At, Bt) do { __builtin_amdgcn_s_setprio(1); _Pragma("unroll") for (int m = 0; m < 4; ++m) _Pragma("unroll") for (int n = 0; n < 2; ++n) _Pragma("unroll") for (int k = 0; k < 2; ++k) \
        acc[ai][bj][m][n] = __builtin_amdgcn_mfma_f32_16x16x32_bf16(Bt[n][k], At[m][k], acc[ai][bj][m][n], 0, 0, 0); __builtin_amdgcn_s_setprio(0); } while (0)
#define PG8_WAIT_V(n) asm volatile("s_waitcnt vmcnt(" #n ")" ::: "memory")
#define PG8_WAIT_L(n) asm volatile("s_waitcnt lgkmcnt(" #n ")" ::: "memory")
#define PG8_BAR __builtin_amdgcn_s_barrier()
#define PG8_SCHED __builtin_amdgcn_sched_barrier(0)
    Unit cur, nxt; int ui = 0;
    if (!S.next(0, cur)) return;
    if constexpr (!Epi::EXT_INIT) E.init(acc, cur, wr, wc, fr, fq);
    bf16x8 At[4][2], B0[2][2], B1[2][2];
    const char* cA = cur.A; const char* cB = cur.B;
    PG8_STAGE(PG8_SB(0, 0), cB, voffB); PG8_STAGE(PG8_SA(0, 0), cA, voffA); PG8_STAGE(PG8_SB(0, 1), cB + hstepB, voffB); PG8_STAGE(PG8_SA(0, 1), cA + hstepA, voffA);
    if (wr == 1) PG8_BAR;
    PG8_WAIT_V(4); PG8_BAR;
    PG8_STAGE(PG8_SB(1, 0), cB + kstep, voffB); PG8_STAGE(PG8_SA(1, 0), cA + kstep, voffA); PG8_STAGE(PG8_SB(1, 1), cB + hstepB + kstep, voffB);
    PG8_WAIT_V(6); PG8_BAR;
    for (;;) {
        const bool has_next = S.next(ui + 1, nxt);
        const char* nA = has_next ? nxt.A : cA; const char* nB = has_next ? nxt.B : cB;
        const int nt = cur.nt;
        for (int t = 0; t < nt; t += 2) {
            const bool last = (t == nt - 2);
            const char* a1 = cA + (size_t)(t + 1) * kstep;
            const char* a2 = last ? nA : cA + (size_t)(t + 2) * kstep; const char* b2 = last ? nB : cB + (size_t)(t + 2) * kstep;
            const char* a3 = a2 + kstep; const char* b3 = b2 + kstep;
            PG8_LDB(B0, 0, 0); PG8_SCHED; PG8_LDA(At, 0, 0); PG8_STAGE(PG8_SA(1, 1), a1 + hstepA, voffA);
            PG8_WAIT_L(8); PG8_BAR; PG8_WAIT_L(0); PG8_MMA(0, 0, At, B0); PG8_BAR; PG8_SCHED;
            PG8_LDB(B1, 0, 1); PG8_STAGE(PG8_SB(0, 0), b2, voffB);
            PG8_BAR; PG8_WAIT_L(0); PG8_MMA(0, 1, At, B1); PG8_BAR;
            PG8_LDA(At, 0, 1); PG8_STAGE(PG8_SA(0, 0), a2, voffA);
            PG8_BAR; PG8_WAIT_L(0); PG8_MMA(1, 0, At, B0); PG8_BAR; PG8_SCHED;
            PG8_STAGE(PG8_SB(0, 1), b2 + hstepB, voffB);
            PG8_WAIT_V(6); PG8_BAR; PG8_MMA(1, 1, At, B1); PG8_BAR;
            PG8_LDB(B0, 1, 0); PG8_SCHED; PG8_LDA(At, 1, 0); PG8_STAGE(PG8_SA(0, 1), a2 + hstepA, voffA);
            PG8_WAIT_L(8); PG8_BAR; PG8_WAIT_L(0); PG8_MMA(0, 0, At, B0); PG8_BAR; PG8_SCHED;
            PG8_LDB(B1, 1, 1); PG8_STAGE(PG8_SB(1, 0), b3, voffB);
            PG8_BAR; PG8_WAIT_L(0); PG8_MMA(0, 1, At, B1); PG8_BAR;
            PG8_LDA(At, 1, 1); PG8_STAGE(PG8_SA(1, 0), a3, voffA);
            PG8_BAR; PG8_WAIT_L(0); PG8_MMA(1, 0, At, B0); PG8_BAR; PG8_SCHED;
            PG8_STAGE(PG8_SB(1, 1), b3 + hstepB, voffB);
            PG8_WAIT_V(6); PG8_BAR; PG8_MMA(1, 1, At, B1); PG8_BAR;
        }
        if constexpr (!Epi::AFTER_DRAIN) { E(acc, cur, wr, wc, fr, fq); S.done(cur, ui, lane); }
        if (!has_next) break;
        cur = nxt; cA = nA; cB = nB; ++ui;
        E.init(acc, cur, wr, wc, fr, fq);
    }
    PG8_WAIT_V(0);
    if (wr == 0) PG8_BAR;
    PG8_BAR;
    if constexpr (Epi::AFTER_DRAIN) E.fused(acc, cur, wr, wc, fr, fq, lds, tid);
#undef PG8_SA
#undef PG8_SB
#undef PG8_STAGE
#undef PG8_LDA
#undef PG8_LDB
#undef PG8_MMA
#undef PG8_WAIT_V
#undef PG8_WAIT_L
#undef PG8_BAR
#undef PG8_SCHED
}
}

struct SchedP1 {
    const char* xb; const char* win; unsigned* cnt; int gx, gl; bool uni;
    __device__ __forceinline__ bool next(int i, pg8::Unit& u) const {
        const int n_s = gx < 2 ? 2 : 1, j = gl + 32 * i; if (j >= 80 + n_s) return false;
        int pm, pn, kind;
        if (j < n_s) { pm = NPROMPT / 256; pn = gx + 8 * j; kind = 2; }
        else if (j < n_s + 48) { const int k = j - n_s, q = k >> 3; pm = 8 * gx + (k & 7); pn = q < 2 ? q : q + 2; kind = 1; }
        else { const int k = j - n_s - 48, q = k >> 3; pm = 8 * gx + (k & 7); pn = q < 2 ? q + 2 : q + 6; kind = 0; }
        u.pm = pm; u.pn = pn; u.kind = kind; u.nt = 16; u.A = xb + (size_t)pm * 256 * DM * 2; u.B = win + (size_t)pn * 256 * DM * 2; return true;
    }
    __device__ __forceinline__ void done(const pg8::Unit&, int ui, int lane) const {
        if (!uni) return;
        const int n_s = gx < 2 ? 2 : 1, nuv = gl < n_s + 16 ? 2 : 1;
        if (ui != nuv - 1) return;
        asm volatile("s_waitcnt vmcnt(0)" ::: "memory");
        if (lane == 0) { const int sm = gl < n_s ? 1 : 0, uv = nuv - sm;
            (void)xb_add(cnt + 64 * (CW_RV + gx), (unsigned)uv);
            if (sm) (void)xb_add(cnt + 64 * (CW_SV + gx), 1u); }
    }
};
struct EpiP1 {
    static constexpr bool PERM = true, AFTER_DRAIN = false, EXT_INIT = false;
    bf16_t* U; bf16_t* SGP; bf16_t* V; bf16_t* SGC; float* out;
    __device__ __forceinline__ void init(f32x4 (&acc)[2][2][4][2], const pg8::Unit&, int, int, int, int) const {
#pragma unroll
        for (int a = 0; a < 2; ++a)
#pragma unroll
            for (int b = 0; b < 2; ++b)
#pragma unroll
                for (int m = 0; m < 4; ++m)
#pragma unroll
                    for (int n = 0; n < 2; ++n) acc[a][b][m][n] = (f32x4){0.f, 0.f, 0.f, 0.f};
    }
    __device__ __forceinline__ void operator()(const f32x4 (&acc)[2][2][4][2], const pg8::Unit& u, int wr, int wc, int fr, int fq) const {
        const int pn = u.pn, row0 = u.pm * 256 + wr * 64 + fr, cl = wc * 32 + 8 * fq;
        if (pn < 2) {
#pragma unroll
            for (int ai = 0; ai < 2; ++ai)
#pragma unroll
                for (int m = 0; m < 4; ++m) {
                    const int r = row0 + ai * 128 + m * 16; bool st; size_t so;
                    if (r < NPROMPT) { const int t = r & (SEQ - 1); st = t >= SEQ - 15; so = O_SPP + ((size_t)(r >> 12) * 15 + (t - (SEQ - 15))) * 512; }
                    else { const int s = r - NPROMPT, t = s & 15; st = t >= 1; so = O_SPS + ((size_t)(s >> 4) * 15 + (t - 1)) * 512; }
#pragma unroll
                    for (int bj = 0; bj < 2; ++bj) { const int c = pn * 256 + bj * 128 + cl; const f32x4 v0 = acc[ai][bj][m][0], v1 = acc[ai][bj][m][1];
                        *(u32x4*)(U + (size_t)r * DH + c) = pack8(v0, v1);
                        if (st) { *(f32x4*)(out + so + c) = v0; *(f32x4*)(out + so + c + 4) = v1; } }
                }
        } else if (pn < 4 || pn >= 8) {
            bf16_t* dst = pn < 4 ? SGP : SGC; const int cb = (pn < 4 ? pn - 2 : pn - 8) * 256 + cl;
#pragma unroll
            for (int ai = 0; ai < 2; ++ai)
#pragma unroll
                for (int m = 0; m < 4; ++m) { const int r = row0 + ai * 128 + m * 16;
#pragma unroll
                    for (int bj = 0; bj < 2; ++bj) { f32x4 v0 = acc[ai][bj][m][0], v1 = acc[ai][bj][m][1];
#pragma unroll
                        for (int j = 0; j < 4; ++j) { v0[j] = silu_f(v0[j]); v1[j] = silu_f(v1[j]); }
                        *(u32x4*)(dst + (size_t)r * DH + cb + bj * 128) = pack8(v0, v1); }
                }
        } else {
            const int c = (pn - 4) * 128 + cl;
#pragma unroll
            for (int ai = 0; ai < 2; ++ai)
#pragma unroll
                for (int m = 0; m < 4; ++m) {
                    const int r = row0 + ai * 128 + m * 16; bool st; size_t so;
                    if (r < NPROMPT) { const int t = r & (SEQ - 1); st = t >= SEQ - 30; so = O_SCP + ((size_t)(r >> 12) * 30 + (t - (SEQ - 30))) * 512; }
                    else { const int s = r - NPROMPT, t = s & 15; st = true; so = O_SCS + ((size_t)(s >> 4) * 30 + 14 + t) * 512; }
                    f32x4 v0 = acc[ai][0][m][0], v1 = acc[ai][0][m][1]; const f32x4 g0 = acc[ai][1][m][0], g1 = acc[ai][1][m][1];
#pragma unroll
                    for (int j = 0; j < 4; ++j) { v0[j] *= sigmoid_f(g0[j]); v1[j] *= sigmoid_f(g1[j]); }
                    *(u32x4*)(V + (size_t)r * DH + c) = pack8(v0, v1);
                    if (st) { *(f32x4*)(out + so + c) = v0; *(f32x4*)(out + so + c + 4) = v1; }
                }
        }
    }
};

struct SchedP3 {
    const char* pc; const char* mix; const char* pw; int pm0, pn0;
    __device__ __forceinline__ void done(const pg8::Unit&, int, int) const {}
    __device__ __forceinline__ bool next(int i, pg8::Unit& u) const {
        if (i != 0) return false; const int pm = pm0, pn = pn0;
        u.pm = pm; u.pn = pn; u.kind = 0;
        if (pn < 2) { u.nt = 4; u.A = pc + ((size_t)pm * 256 * DM + 256 * pn) * 2; u.B = mix + ((size_t)pn * 256 * 512 + 256 * pn) * 2; }
        else { u.nt = 8; u.A = pc + ((size_t)pm * 256 * DM + 512) * 2; u.B = pw + (size_t)(pn - 2) * 256 * 512 * 2; }
        return true;
    }
};
struct EpiP3 {
    static constexpr bool PERM = true, AFTER_DRAIN = false, EXT_INIT = false;
    const bf16_t* SGP; const bf16_t* SGC; const float* pw_b; bf16_t* Z;
    __device__ __forceinline__ void init(f32x4 (&acc)[2][2][4][2], const pg8::Unit&, int, int, int, int) const {
#pragma unroll
        for (int a = 0; a < 2; ++a)
#pragma unroll
            for (int b = 0; b < 2; ++b)
#pragma unroll
                for (int m = 0; m < 4; ++m)
#pragma unroll
                    for (int n = 0; n < 2; ++n) acc[a][b][m][n] = (f32x4){0.f, 0.f, 0.f, 0.f};
    }
    __device__ __forceinline__ void operator()(const f32x4 (&acc)[2][2][4][2], const pg8::Unit& u, int wr, int wc, int fr, int fq) const {
        const int pn = u.pn, row0 = u.pm * 256 + wr * 64 + fr, cl = wc * 32 + 8 * fq;
        const bool conv = pn >= 2; const bf16_t* gate = conv ? SGC : SGP; const int cb = (conv ? pn - 2 : pn) * 256 + cl;
        f32x4 bv[2][2];
#pragma unroll
        for (int bj = 0; bj < 2; ++bj)
#pragma unroll
            for (int n = 0; n < 2; ++n) bv[bj][n] = conv ? *(const f32x4*)(pw_b + cb + bj * 128 + 4 * n) : (f32x4){0.f, 0.f, 0.f, 0.f};
#pragma unroll
        for (int ai = 0; ai < 2; ++ai) {
            u32x4 gt[4][2];
#pragma unroll
            for (int m = 0; m < 4; ++m)
#pragma unroll
                for (int bj = 0; bj < 2; ++bj) gt[m][bj] = *(const u32x4*)(gate + (size_t)(row0 + ai * 128 + m * 16) * DH + cb + bj * 128);
#pragma unroll
            for (int m = 0; m < 4; ++m) { const int r = row0 + ai * 128 + m * 16;
#pragma unroll
                for (int bj = 0; bj < 2; ++bj) { const int c = cb + bj * 128; const u32x4 g = gt[m][bj];
                    f32x4 v0 = acc[ai][bj][m][0] + bv[bj][0], v1 = acc[ai][bj][m][1] + bv[bj][1];
                    v0[0] *= bf_lo(g[0]); v0[1] *= bf_hi(g[0]); v0[2] *= bf_lo(g[1]); v0[3] *= bf_hi(g[1]);
                    v1[0] *= bf_lo(g[2]); v1[1] *= bf_hi(g[2]); v1[2] *= bf_lo(g[3]); v1[3] *= bf_hi(g[3]);
                    *(u32x4*)(Z + (size_t)r * DM + (conv ? 512 : 0) + c) = pack8(v0, v1); }
            }
        }
    }
};

struct SchedP4 {
    const char* z; const char* wout; int pm0, pn0;
    __device__ __forceinline__ void done(const pg8::Unit&, int, int) const {}
    __device__ __forceinline__ bool next(int i, pg8::Unit& u) const {
        if (i != 0) return false; const int pm = pm0, pn = pn0;
        u.pm = pm; u.pn = pn; u.kind = 0; u.nt = 16; u.A = z + (size_t)pm * 256 * DM * 2; u.B = wout + (size_t)pn * 256 * DM * 2; return true;
    }
};
struct EpiP4 {
    static constexpr bool PERM = false, AFTER_DRAIN = true, EXT_INIT = true;
    const float* x_prompt; const float* final_g; float* out; float* xs; unsigned* cnt; const float* ss; int srow; bool uni;
    __device__ __forceinline__ void init(f32x4 (&acc)[2][2][4][2], const pg8::Unit& u, int wr, int wc, int fr, int fq) const {
        const int row0 = u.pm * 256 + wr * 64 + fr, col0 = u.pn * 256 + wc * 32 + 4 * fq;
#pragma unroll
        for (int ai = 0; ai < 2; ++ai)
#pragma unroll
            for (int m = 0; m < 4; ++m) { const float* xr = x_prompt + (size_t)(row0 + ai * 128 + m * 16) * DM + col0;
#pragma unroll
                for (int bj = 0; bj < 2; ++bj)
#pragma unroll
                    for (int n = 0; n < 2; ++n) acc[ai][bj][m][n] = *(const f32x4*)(xr + bj * 128 + n * 16); }
    }
    __device__ __forceinline__ void fused(const f32x4 (&acc)[2][2][4][2], const pg8::Unit& u, int wr, int wc, int fr, int fq, LAS unsigned char* lds, int tid) const {
        LAS float* lss = (LAS float*)lds;
#pragma unroll
        for (int ai = 0; ai < 2; ++ai)
#pragma unroll
            for (int m = 0; m < 4; ++m) { float s = 0.f;
#pragma unroll
                for (int bj = 0; bj < 2; ++bj)
#pragma unroll
                    for (int n = 0; n < 2; ++n) { const f32x4 y = acc[ai][bj][m][n]; s += y[0] * y[0] + y[1] * y[1] + y[2] * y[2] + y[3] * y[3]; }
                s += __shfl_xor(s, 16); s += __shfl_xor(s, 32);
                if (fq == 0) lss[(ai * 128 + wr * 64 + m * 16 + fr) * 4 + wc] = s; }
        __syncthreads();
        if (tid < 256) { const f32x4 v = *(const LAS f32x4*)(lss + tid * 4); xs[((size_t)u.pm * 4 + u.pn) * 256 + tid] = v[0] + v[1] + v[2] + v[3]; }
        asm volatile("s_waitcnt vmcnt(0)" ::: "memory");
        __syncthreads();
        if (tid == 0) {
            unsigned* cw = cnt + 64 * u.pm; unsigned* cs = cnt + 64 * CW_PIECES;
            if (!uni) __builtin_amdgcn_fence(__ATOMIC_RELEASE, "agent");
            asm volatile("s_waitcnt vmcnt(0)" ::: "memory");
            (void)xb_add(cw, 1u);
            unsigned sp = 0u;
            while (xb_ld(cw) < 4u || xb_ld(cs) < 256u) { __builtin_amdgcn_s_sleep(1); if (++sp > (1u << 22)) break; }
            __builtin_amdgcn_fence(__ATOMIC_ACQUIRE, "agent");
            asm volatile("s_waitcnt vmcnt(0)" ::: "memory");
        }
        __syncthreads();
        if (tid >= 256) { const int t4 = (tid - 256) * 4; const float rs = rsqrtf(ss[srow] * (1.0f / DM) + 1e-6f); float* yr = out + (size_t)srow * DM + t4;
            *(f32x4*)yr = *(const f32x4*)yr * rs * *(const f32x4*)(final_g + t4); }
        if (tid < 256) { const float* xp = xs + (size_t)u.pm * 4 * 256 + tid; const float tot = xp[0] + xp[256] + xp[512] + xp[768];
            lss[1024 + tid] = rsqrtf(tot * (1.0f / DM) + 1e-6f); }
        __syncthreads();
        const int row0 = u.pm * 256 + wr * 64 + fr, col0 = u.pn * 256 + wc * 32 + 4 * fq;
        f32x4 g4[2][2];
#pragma unroll
        for (int bj = 0; bj < 2; ++bj)
#pragma unroll
            for (int n = 0; n < 2; ++n) g4[bj][n] = *(const f32x4*)(final_g + col0 + bj * 128 + n * 16);
#pragma unroll
        for (int ai = 0; ai < 2; ++ai)
#pragma unroll
            for (int m = 0; m < 4; ++m) { const float rs = lss[1024 + ai * 128 + wr * 64 + m * 16 + fr]; float* yr = out + (size_t)(row0 + ai * 128 + m * 16) * DM + col0;
#pragma unroll
                for (int bj = 0; bj < 2; ++bj)
#pragma unroll
                    for (int n = 0; n < 2; ++n) *(f32x4*)(yr + bj * 128 + n * 16) = acc[ai][bj][m][n] * rs * g4[bj][n]; }
    }
    __device__ __forceinline__ void operator()(const f32x4 (&)[2][2][4][2], const pg8::Unit&, int, int, int, int) const {}
};

template <int NF>
__device__ __forceinline__ f32x4 small_gemm(const bf16_t* __restrict__ A, int lda, const bf16_t* __restrict__ Bt, int ldb, int K, int nw, f32x4* red) {
    const int tid = threadIdx.x, wid = tid >> 6, lane = tid & 63, fr = lane & 15, fq = lane >> 4;
    f32x4 acc[NF];
#pragma unroll
    for (int f = 0; f < NF; ++f) acc[f] = (f32x4){0.f, 0.f, 0.f, 0.f};
    if (wid < nw) { const int ks = K / nw; const bf16_t* ap = A + (size_t)fr * lda + wid * ks + fq * 8; const bf16_t* bp = Bt + (size_t)fr * ldb + wid * ks + fq * 8;
        for (int k = 0; k < ks; k += 32) { const bf16x8 a = *(const bf16x8*)(ap + k);
#pragma unroll
            for (int f = 0; f < NF; ++f) { const bf16x8 b = *(const bf16x8*)(bp + (size_t)f * 16 * ldb + k); acc[f] = __builtin_amdgcn_mfma_f32_16x16x32_bf16(b, a, acc[f], 0, 0, 0); } } }
#pragma unroll
    for (int f = 0; f < NF; ++f) red[(wid * NF + f) * 64 + lane] = acc[f];
    __syncthreads();
    f32x4 r = (f32x4){0.f, 0.f, 0.f, 0.f};
    if (tid < 64 * NF) {
#pragma unroll
        for (int w = 0; w < 8; ++w) r += red[(w * NF + wid) * 64 + lane]; }
    return r;
}
__device__ __forceinline__ void sample_p3(const Params& p, unsigned char* shm, const int i) {
    const int tid = threadIdx.x, wid = tid >> 6, lane = tid & 63, fr = lane & 15, fq = lane >> 4; f32x4* red = (f32x4*)shm;
    const bf16_t* PC = (const bf16_t*)(p.ws + WS_PC); bf16_t* Z = (bf16_t*)(p.ws + WS_Z);
    { const int rb = i >> 4, cb = i & 15, row0 = NPROMPT + rb * 16, row = row0 + fr, c = 32 * cb + 16 * wid + 4 * fq;
        {
            const f32x4 r = small_gemm<2>(PC + (size_t)row0 * DM + 512, DM, (const bf16_t*)(p.ws + WS_PW) + (size_t)32 * cb * 512, 512, 512, 8, red);
            if (tid < 128) { const f32x4 bv = *(const f32x4*)(p.pw_b + c); const u32x2 g = *(const u32x2*)((const bf16_t*)(p.ws + WS_SGC) + (size_t)row * DH + c);
                const f32x4 z = (r + bv) * (f32x4){bf_lo(g[0]), bf_hi(g[0]), bf_lo(g[1]), bf_hi(g[1])};
                *(u32x2*)(Z + (size_t)row * DM + 512 + c) = (u32x2){cvt_pk_bf16(z[0], z[1]), cvt_pk_bf16(z[2], z[3])}; }
            __syncthreads();
        }
        {
            const int g128 = (cb >> 2) * 128;
            const f32x4 r = small_gemm<2>(PC + (size_t)row0 * DM + g128, DM, (const bf16_t*)(p.ws + WS_MIX) + (size_t)32 * cb * 512 + g128, 512, 128, 4, red);
            if (tid < 128) { const u32x2 g = *(const u32x2*)((const bf16_t*)(p.ws + WS_SGP) + (size_t)row * DH + c);
                const f32x4 z = r * (f32x4){bf_lo(g[0]), bf_hi(g[0]), bf_lo(g[1]), bf_hi(g[1])};
                *(u32x2*)(Z + (size_t)row * DM + c) = (u32x2){cvt_pk_bf16(z[0], z[1]), cvt_pk_bf16(z[2], z[3])}; }
            __syncthreads();
        }
    }
}
__device__ __forceinline__ void sample_p4(const Params& p, unsigned char* shm, const int i) {
    const int tid = threadIdx.x, wid = tid >> 6, lane = tid & 63, fr = lane & 15, fq = lane >> 4; f32x4* red = (f32x4*)shm;
    float* ss = (float*)(p.ws + WS_SS);
    { const int rb = i >> 4, cb = i & 15, row0 = NPROMPT + rb * 16, row = row0 + fr, c = 64 * cb + 16 * wid + 4 * fq;
        const f32x4 r = small_gemm<4>((const bf16_t*)(p.ws + WS_Z) + (size_t)row0 * DM, DM, (const bf16_t*)(p.ws + WS_WOUT) + (size_t)64 * cb * DM, DM, DM, 8, red);
        if (tid < 256) { const f32x4 y = r + *(const f32x4*)(p.x_sample + (size_t)(row - NPROMPT) * DM + c);
            *(f32x4*)(p.out + (size_t)row * DM + c) = y;
            float s = y[0] * y[0] + y[1] * y[1] + y[2] * y[2] + y[3] * y[3]; s += __shfl_xor(s, 16); s += __shfl_xor(s, 32);
            if (fq == 0) atomicAdd(ss + row, s); }
        asm volatile("s_waitcnt vmcnt(0)" ::: "memory");
        __syncthreads();
        if (tid == 0) { __builtin_amdgcn_fence(__ATOMIC_RELEASE, "agent"); asm volatile("s_waitcnt vmcnt(0)" ::: "memory"); (void)xb_add((unsigned*)(p.ws + WS_CNT) + 64 * CW_PIECES, 1u); }
    }
}
__device__ __forceinline__ void transpose_load(const float* __restrict__ src, int ldsrc, int k0, int n0s, f32x4 (&v)[2]) {
    const int tid = threadIdx.x, kk = tid >> 4, n4 = (tid & 15) * 4;
#pragma unroll
    for (int i = 0; i < 2; ++i) v[i] = *(const f32x4*)(src + (size_t)(k0 + kk + 32 * i) * ldsrc + n0s + n4);
}
__device__ __forceinline__ void transpose_store(const f32x4 (&v)[2], int k0, bf16_t* __restrict__ dst, int ldd, int n0d, float* tile) {
    const int tid = threadIdx.x;
    {
        const int kk = tid >> 4, n4 = (tid & 15) * 4;
#pragma unroll
        for (int i = 0; i < 2; ++i) { const int k = kk + 32 * i;
            tile[k * 65 + n4 + 0] = v[i][0]; tile[k * 65 + n4 + 1] = v[i][1]; tile[k * 65 + n4 + 2] = v[i][2]; tile[k * 65 + n4 + 3] = v[i][3]; }
    }
    __syncthreads();
    {
        const int n = tid >> 3, k8 = (tid & 7) * 8; float w[8];
#pragma unroll
        for (int j = 0; j < 8; ++j) w[j] = tile[(k8 + j) * 65 + n];
        *(u32x4*)(dst + (size_t)(n0d + n) * ldd + k0 + k8) = (u32x4){cvt_pk_bf16(w[0], w[1]), cvt_pk_bf16(w[2], w[3]), cvt_pk_bf16(w[4], w[5]), cvt_pk_bf16(w[6], w[7])};
    }
    __syncthreads();
}
__device__ __forceinline__ void transpose_tile(const float* __restrict__ src, int ldsrc, int k0, int n0s, bf16_t* __restrict__ dst, int ldd, int n0d, float* tile) {
    f32x4 v[2]; transpose_load(src, ldsrc, k0, n0s, v); transpose_store(v, k0, dst, ldd, n0d, tile);
}
__device__ __forceinline__ int win_src_col(int n0) {
    if (n0 >= 1024 && n0 < 2048) { const int q = n0 - 1024, j = q >> 8, i = q & 255; return i < 128 ? 1024 + 128 * j + i : 1536 + 128 * j + (i - 128); }
    return n0;
}

__device__ __forceinline__ void phase_prep(const Params& p, unsigned char* shm) {
    const int tid = threadIdx.x, wid = tid >> 6, lane = tid & 63, nb = gridDim.x, bid = blockIdx.x;
    bf16_t* xb = (bf16_t*)(p.ws + WS_XB);
    constexpr int T_IN = 16 * 40;
    f32x4 tv[3][2];
#pragma unroll
    for (int q = 0; q < 3; ++q) { const int t = bid + q * nb; if (t < T_IN) transpose_load(p.w_in, DIN, (t / 40) * 64, win_src_col((t % 40) * 64), tv[q]); }
    {
        f32x4 g4[4];
#pragma unroll
        for (int i = 0; i < 4; ++i) g4[i] = *(const f32x4*)(p.norm_g + lane * 4 + 256 * i);
        for (int g = bid * 8 + wid; g < MT / 4; g += nb * 8) {
            f32x4 v[4][4]; float s[4];
#pragma unroll
            for (int q = 0; q < 4; ++q) { const int r = g * 4 + q; const float* xr = r < NPROMPT ? p.x_prompt + (size_t)r * DM : p.x_sample + (size_t)(r - NPROMPT) * DM;
#pragma unroll
                for (int i = 0; i < 4; ++i) v[q][i] = *(const f32x4*)(xr + lane * 4 + 256 * i); }
#pragma unroll
            for (int q = 0; q < 4; ++q) { s[q] = 0.f;
#pragma unroll
                for (int i = 0; i < 4; ++i) s[q] += v[q][i][0] * v[q][i][0] + v[q][i][1] * v[q][i][1] + v[q][i][2] * v[q][i][2] + v[q][i][3] * v[q][i][3];
                s[q] = wave_sum(s[q]); }
#pragma unroll
            for (int q = 0; q < 4; ++q) { const int r = g * 4 + q; const float rs = rsqrtf(s[q] * (1.0f / DM) + 1e-6f);
#pragma unroll
                for (int i = 0; i < 4; ++i) { const f32x4 h = v[q][i] * rs * g4[i];
                    *(u32x2*)(xb + (size_t)r * DM + lane * 4 + 256 * i) = (u32x2){cvt_pk_bf16(h[0], h[1]), cvt_pk_bf16(h[2], h[3])}; } }
        }
    }
    {
        float* tile = (float*)shm; bf16_t* win = (bf16_t*)(p.ws + WS_WIN);
#pragma unroll
        for (int q = 0; q < 3; ++q) { const int t = bid + q * nb; if (t < T_IN) transpose_store(tv[q], (t / 40) * 64, win, DM, (t % 40) * 64, tile); }
        for (int t = bid + 3 * nb; t < T_IN; t += nb) transpose_tile(p.w_in, DIN, (t / 40) * 64, win_src_col((t % 40) * 64), win, DM, (t % 40) * 64, tile);
    }
    float* ss = (float*)(p.ws + WS_SS);
    for (int i = bid * 512 + tid; i < MT; i += nb * 512) ss[i] = 0.f;
    for (int i = bid * 512 + tid; i < 16 * 14 * 128; i += nb * 512) { const int c4 = i & 127, rr = i >> 7, b = rr / 14, j = rr % 14;
        *(f32x4*)(p.out + O_SCS + ((size_t)b * 30 + j) * 512 + c4 * 4) = *(const f32x4*)(p.cache_conv + ((size_t)b * 30 + 16 + j) * 512 + c4 * 4); }
}

__device__ __forceinline__ void late_weight_prep(const Params& p, unsigned char* shm, const int bid, const int nb) {
    const int tid = threadIdx.x; float* tile = (float*)shm;
    bf16_t* pw = (bf16_t*)(p.ws + WS_PW); bf16_t* wout = (bf16_t*)(p.ws + WS_WOUT); bf16_t* mix = (bf16_t*)(p.ws + WS_MIX);
    constexpr int T_OUT = 16 * 16, T_PW = 8 * 8;
    for (int t = bid; t < T_OUT + T_PW; t += nb) {
        if (t < T_OUT) transpose_tile(p.w_out, DM, (t >> 4) * 64, (t & 15) * 64, wout, DM, (t & 15) * 64, tile);
        else { const int tt = t - T_OUT; transpose_tile(p.pw_w, 512, (tt >> 3) * 64, (tt & 7) * 64, pw, 512, (tt & 7) * 64, tile); }
    }
    for (int idx = bid * 512 + tid; idx < 512 * 512; idx += nb * 512) { const int n = idx >> 9, k = idx & 511; float v = 0.f;
        if ((n >> 7) == (k >> 7)) v = p.pool_mix[((size_t)(n >> 7) * 128 + (k & 127)) * 128 + (n & 127)] * p.pool_scale[n];
        mix[idx] = (bf16_t)(cvt_pk_bf16(v, 0.f) & 0xffffu); }
    __syncthreads();
}

#define DPP_STEP(v, ctrl) ((v) + __builtin_bit_cast(float, __builtin_amdgcn_update_dpp(0, __builtin_bit_cast(int, (v)), (ctrl), 0xf, 0xf, true)))
__device__ __forceinline__ float wave_sum_hi(float v) {
    v = DPP_STEP(v, 0xB1);
    v = DPP_STEP(v, 0x4E);
    v = DPP_STEP(v, 0x141);
    v = DPP_STEP(v, 0x140);
    v += __builtin_bit_cast(float, __builtin_amdgcn_update_dpp(0, __builtin_bit_cast(int, v), 0x142, 0xa, 0xf, false));
    v += __builtin_bit_cast(float, __builtin_amdgcn_update_dpp(0, __builtin_bit_cast(int, v), 0x143, 0xc, 0xf, false));
    return v;
}
#define RED16_STEP(CTRL) _Pragma("unroll") for (int k = 0; k < 16; ++k) asm volatile("v_add_f32_dpp %0, %0, %0 " CTRL : "+v"(r[k]))
__device__ __forceinline__ void wave_sum16_hi(float (&r)[16]) {
    asm volatile("s_nop 1" ::: "memory");
    RED16_STEP("quad_perm:[1,0,3,2] row_mask:0xf bank_mask:0xf");
    RED16_STEP("quad_perm:[2,3,0,1] row_mask:0xf bank_mask:0xf");
    RED16_STEP("row_half_mirror row_mask:0xf bank_mask:0xf");
    RED16_STEP("row_mirror row_mask:0xf bank_mask:0xf");
    RED16_STEP("row_bcast:15 row_mask:0xa bank_mask:0xf");
    RED16_STEP("row_bcast:31 row_mask:0xc bank_mask:0xf");
}
template <int W, int TH>
__device__ __forceinline__ void pool_regs(const unsigned (&u)[TH + 15], const int pos0, bf16_t* __restrict__ dst  ) {
    f32x2 s = (f32x2){0.f, 0.f};
#pragma unroll
    for (int j = 0; j < W; ++j) s += bf_unpack(u[15 - j]);
#pragma unroll
    for (int i = 0; i < TH; ++i) { const f32x2 cur = bf_unpack(u[15 + i]); const int pos1 = pos0 + i + 1;
        const float inv = pos1 >= W ? (1.0f / W) : __builtin_amdgcn_rcpf((float)pos1);
        const f32x2 o = s * inv - cur;
        *(unsigned*)(dst + (size_t)i * DM) = cvt_pk_bf16(o[0], o[1]);
        if (i + 1 < TH) s += bf_unpack(u[16 + i]) - bf_unpack(u[16 + i - W]); }
}
template <int T>
__device__ __forceinline__ void mixer_chunk(const Params& p, unsigned char* shm, const int r0, const int t0, const int tid, const f32x2 (&w2)[31]) {
    constexpr int TH = T / 2, ROUNDS = T / 16, NV = ((T + 30) * 64 + 511) / 512;
    const int cp = tid & 255, th = tid >> 8, lane = tid & 63, wv = (tid >> 6) & 3;
    const bf16_t* U = (const bf16_t*)(p.ws + WS_U); const bf16_t* V = (const bf16_t*)(p.ws + WS_V); bf16_t* PC = (bf16_t*)(p.ws + WS_PC);
    const unsigned* l32 = (const unsigned*)shm;
    u32x4 val[NV];
    {
        const bf16_t* vb = V + (size_t)(r0 - 30) * DH;
#pragma unroll
        for (int k = 0; k < NV; ++k) { const int idx = tid + k * 512, lr = idx >> 6; val[k] = (u32x4){0u, 0u, 0u, 0u};
            if (idx < (T + 30) * 64 && t0 - 30 + lr >= 0) val[k] = *(const u32x4*)(vb + (size_t)idx * 8); }
    }
    unsigned u[TH + 15];
    {
        const int f0 = th * TH - 15; const bf16_t* ub = U + (size_t)(r0 + f0) * DH + cp * 2;
#pragma unroll
        for (int k = 0; k < TH + 15; ++k) { u[k] = 0u; if (t0 + f0 + k >= 0) u[k] = *(const unsigned*)(ub + (size_t)k * DH); }
    }
#pragma unroll
    for (int k = 0; k < NV; ++k) { const int idx = tid + k * 512; if (idx < (T + 30) * 64) *(u32x4*)(shm + (size_t)idx * 16) = val[k]; }
    const f32x2 bias = *(const f32x2*)(p.dw_b + cp * 2);
    const f32x2 g2 = *(const f32x2*)(p.ln_g + cp * 2), b2 = *(const f32x2*)(p.ln_b + cp * 2);
    __syncthreads();
    {
        bf16_t* dst = PC + (size_t)(r0 + th * TH) * DM + cp * 2; const int pos0 = t0 + th * TH;
        switch (cp >> 6) { case 0: pool_regs<2, TH>(u, pos0, dst); break; case 1: pool_regs<4, TH>(u, pos0, dst); break; case 2: pool_regs<8, TH>(u, pos0, dst); break; default: pool_regs<16, TH>(u, pos0, dst); break; }
    }
    f32x2* stats = (f32x2*)(shm + (T + 30) * 1024);
#pragma unroll 1
    for (int rd = 0; rd < ROUNDS; ++rd) {
        const int tt = rd * 16 + th * 8;
        f32x2 c[8];
#pragma unroll
        for (int i = 0; i < 8; ++i) c[i] = bias;
        unsigned win[38];
#pragma unroll
        for (int q = 0; q < 38; ++q) win[q] = l32[(tt + q) * 256 + cp];
#pragma unroll
        for (int q = 0; q < 38; ++q) { const f32x2 v = bf_unpack(win[q]);
#pragma unroll
            for (int i = 0; i < 8; ++i) if (q - i >= 0 && q - i < 31) c[i] += w2[q - i] * v;
            asm volatile("" : "+v"(c[0]), "+v"(c[1]), "+v"(c[2]), "+v"(c[3]), "+v"(c[4]), "+v"(c[5]), "+v"(c[6]), "+v"(c[7])); }
        { float r[16];
#pragma unroll
          for (int i = 0; i < 8; ++i) { r[2 * i] = c[i][0] + c[i][1]; r[2 * i + 1] = c[i][0] * c[i][0] + c[i][1] * c[i][1]; }
          wave_sum16_hi(r);
#pragma unroll
          for (int i = 0; i < 8; ++i) if (lane == 63) stats[(tt + i) * 4 + wv] = (f32x2){r[2 * i], r[2 * i + 1]}; }
        __syncthreads();
        float mean_l, rs_l;
        { const int ti = tt + (lane & 7);
          const f32x4 sa = *(const f32x4*)(stats + ti * 4), sb = *(const f32x4*)(stats + ti * 4 + 2);
          mean_l = (sa[0] + sa[2] + sb[0] + sb[2]) * (1.0f / 512.0f);
          const float var = (sa[1] + sa[3] + sb[1] + sb[3]) * (1.0f / 512.0f) - mean_l * mean_l;
          rs_l = __builtin_amdgcn_rsqf(var + 1e-5f); }
#pragma unroll
        for (int i = 0; i < 8; ++i) {
            const float mean = __builtin_bit_cast(float, __builtin_amdgcn_readlane(__builtin_bit_cast(int, mean_l), i));
            const float rs = __builtin_bit_cast(float, __builtin_amdgcn_readlane(__builtin_bit_cast(int, rs_l), i));
            const f32x2 y = (c[i] - mean) * rs * g2 + b2;
            *(unsigned*)(PC + (size_t)(r0 + tt + i) * DM + 512 + cp * 2) = cvt_pk_bf16(silu_f(y[0]), silu_f(y[1])); }
    }
    __syncthreads();
}

__device__ __forceinline__ void sample_token(const Params& p, unsigned char* shm, const int s) {
    const int tid = threadIdx.x, wid = tid >> 6, lane = tid & 63, b = s >> 4, t = s & 15, r = NPROMPT + s, ch = tid;
    const bf16_t* U = (const bf16_t*)(p.ws + WS_U); const bf16_t* V = (const bf16_t*)(p.ws + WS_V); bf16_t* PC = (bf16_t*)(p.ws + WS_PC);
    {
        const int w = 2 << (ch >> 7); float sum = 0.f, cur = 0.f;
#pragma unroll
        for (int j = 0; j < 16; ++j) if (j < w) { const int e = t + 15 - j;
            const float v = e < 15 ? p.cache_pool[((size_t)b * 15 + e) * 512 + ch] : __uint_as_float((unsigned)U[(size_t)(NPROMPT + b * 16 + e - 15) * DH + ch] << 16);
            sum += v; if (j == 0) cur = v; }
        const float o = sum / (float)w - cur;
        PC[(size_t)r * DM + ch] = (bf16_t)(cvt_pk_bf16(o, 0.f) & 0xffffu);
    }
    float c = p.dw_b[ch];
#pragma unroll
    for (int j = 0; j < 31; ++j) { const int e = t + j;
        const float v = e < 30 ? p.cache_conv[((size_t)b * 30 + e) * 512 + ch] : __uint_as_float((unsigned)V[(size_t)(NPROMPT + b * 16 + e - 30) * DH + ch] << 16);
        c += p.dw_w[j * 512 + ch] * v; }
    float s1 = wave_sum(c), s2 = wave_sum(c * c);
    f32x2* red = (f32x2*)shm;
    if (lane == 0) red[wid] = (f32x2){s1, s2};
    __syncthreads();
    s1 = 0.f; s2 = 0.f;
#pragma unroll
    for (int w8 = 0; w8 < 8; ++w8) { const f32x2 q = red[w8]; s1 += q[0]; s2 += q[1]; }
    const float mean = s1 * (1.0f / 512.0f), var = s2 * (1.0f / 512.0f) - mean * mean, rs = rsqrtf(var + 1e-5f);
    const float y = (c - mean) * rs * p.ln_g[ch] + p.ln_b[ch];
    PC[(size_t)r * DM + 512 + ch] = (bf16_t)(cvt_pk_bf16(silu_f(y), 0.f) & 0xffffu);
    __syncthreads();
}

__device__ __forceinline__ void wait_counters(unsigned* c0, unsigned t0, unsigned* c1, unsigned t1, unsigned* c2, unsigned t2) {
    if (threadIdx.x == 0) { unsigned sp = 0u;
        while (xb_ld(c0) < t0 || xb_ld(c1) < t1 || xb_ld(c2) < t2) { __builtin_amdgcn_s_sleep(1); if (++sp > (1u << 22)) break; }
        __builtin_amdgcn_fence(__ATOMIC_ACQUIRE, "agent"); asm volatile("s_waitcnt vmcnt(0)" ::: "memory"); }
    __syncthreads();
}
__device__ __forceinline__ void phase_mixer_pre(const Params& p, unsigned char* shm, const int gbase, int off, int len) {
    int tid = threadIdx.x; asm volatile("" : "+v"(tid));
    f32x2 w2[31];
    { const float* wp = p.dw_w + (tid & 255) * 2;
#pragma unroll
      for (int j = 0; j < 31; ++j) w2[j] = *(const f32x2*)(wp + j * 512); }
#pragma unroll 1
    while (len > 0) {
        const int take = (len >= 96 || len == 64) ? 64 : (len == 80 ? 48 : (len > 64 ? 32 : len)), r0 = gbase + off, t0 = r0 & (SEQ - 1);
        int tq = tid; asm volatile("" : "+v"(tq));
        if (take == 64) mixer_chunk<64>(p, shm, r0, t0, tq, w2); else if (take == 48) mixer_chunk<48>(p, shm, r0, t0, tq, w2); else mixer_chunk<32>(p, shm, r0, t0, tq, w2);
        off += take; len -= take;
    }
}

__global__ void __launch_bounds__(512, 2) hymba_fwd(Params p) {
    extern __shared__ __attribute__((aligned(16))) unsigned char shm[];
    LAS unsigned char* lds = (LAS unsigned char*)shm;
    const int G = gridDim.x, c = blockIdx.x;
    volatile LAS unsigned* st = (volatile LAS unsigned*)(lds + pg8::STAGE_BYTES);
    if (threadIdx.x == 0) { st[0] = 0u; st[1] = 0u; st[2] = 0u; st[3] = 0u; }
    __syncthreads();
    const XcdBarrier xb = xcd_barrier_post((unsigned*)(p.ws + WS_BAR), st);
    phase_prep(p, shm);
    xcd_barrier(xb);
    const bool uni = st[3] != 0u;
    const int gx = uni ? (int)xb.x : (c & 7), gl = uni ? (int)st[2] : (c >> 3);
    const int sidx = 32 * gx + gl;
    const int pm = 8 * gx + (gl & 7), pn = gl >> 3;
    const int n3 = gx < 2 ? 18 : 17;
    unsigned* cw = (unsigned*)(p.ws + WS_CNT);
    if (gl >= n3) {
        late_weight_prep(p, shm, (gx < 2 ? 14 * gx : 28 + 15 * (gx - 2)) + (gl - n3), 118);
        asm volatile("s_waitcnt vmcnt(0)" ::: "memory");
        __syncthreads();
        if (threadIdx.x == 0) { __builtin_amdgcn_fence(__ATOMIC_RELEASE, "agent"); asm volatile("s_waitcnt vmcnt(0)" ::: "memory"); (void)xb_add(cw + 64 * CW_LW, 1u); }
    }
    { SchedP1 S{(const char*)(p.ws + WS_XB), (const char*)(p.ws + WS_WIN), cw, gx, gl, uni};
      EpiP1 E{(bf16_t*)(p.ws + WS_U), (bf16_t*)(p.ws + WS_SGP), (bf16_t*)(p.ws + WS_V), (bf16_t*)(p.ws + WS_SGC), p.out};
      f32x4 acc[2][2][4][2]; pg8::gemm_phase(lds, DM, DM, S, E, acc); }
    if (uni) {
        const unsigned n_s8 = gx < 2 ? 16u : 8u;
        if (gl == 31) {
            wait_counters(cw + 64 * (CW_RV + gx), 384u, cw + 64 * (CW_SV + gx), n_s8, cw + 64 * (CW_SV + gx), n_s8);
            if (threadIdx.x == 0) { __builtin_amdgcn_fence(__ATOMIC_RELEASE, "agent"); asm volatile("s_waitcnt vmcnt(0)" ::: "memory"); (void)xb_add(cw + 64 * CW_GV, 1u); }
        }
        const bool halo = (gx & 1) && gl == n3;
        wait_counters(cw + 64 * (CW_RV + gx), 384u, cw + 64 * CW_GV, halo ? 8u : 0u, cw + 64 * CW_GV, 0u);
    } else xcd_barrier(xb);
    {
      const int E2 = 32 - n3; int off, len;
      if (!uni) { off = 64 * gl; len = 64; }
      else if (gl >= n3) { off = 96 * (gl - n3); len = 96; }
      else { const int remu = (2048 - 96 * E2) / 16, base = remu / n3, extra = remu % n3; off = 96 * E2 + 16 * (gl * base + (gl < extra ? gl : extra)); len = 16 * (base + (gl < extra ? 1 : 0)); }
      phase_mixer_pre(p, shm, 2048 * gx, off, len); }
    if (uni) wait_counters(cw + 64 * CW_GV, 8u, cw + 64 * CW_GV, 8u, cw + 64 * CW_GV, 8u);
    sample_token(p, shm, sidx);
    if (uni) { xcc_barrier(xb, [] {}); wait_counters(cw + 64 * CW_LW, 118u, cw + 64 * CW_LW, 118u, cw + 64 * CW_LW, 118u); } else xcd_barrier(xb);
    if (pn < 2) { sample_p3(p, shm, sidx); sample_p3(p, shm, sidx + 16); }
    { SchedP3 S{(const char*)(p.ws + WS_PC), (const char*)(p.ws + WS_MIX), (const char*)(p.ws + WS_PW), pm, pn};
      EpiP3 E{(const bf16_t*)(p.ws + WS_SGP), (const bf16_t*)(p.ws + WS_SGC), p.pw_b, (bf16_t*)(p.ws + WS_Z)};
      f32x4 acc[2][2][4][2]; pg8::gemm_phase(lds, DM, 512, S, E, acc); }
    { SchedP4 S{(const char*)(p.ws + WS_Z), (const char*)(p.ws + WS_WOUT), pm, pn};
      EpiP4 E{p.x_prompt, p.final_g, p.out, (float*)(p.ws + WS_XS), (unsigned*)(p.ws + WS_CNT), (const float*)(p.ws + WS_SS), NPROMPT + sidx, uni};
      f32x4 acc[2][2][4][2]; pg8::Unit u4; const bool has4 = S.next(0, u4);
      int tid4 = threadIdx.x; asm volatile("" : "+v"(tid4));
      const int wid4 = __builtin_amdgcn_readfirstlane(tid4 >> 6), lane4 = tid4 & 63;
      const auto hook = [&] { if (has4) E.init(acc, u4, wid4 >> 2, wid4 & 3, lane4 & 15, lane4 >> 4); };
      if (uni) xcc_barrier(xb, hook); else xcd_barrier(xb, hook);
      sample_p4(p, shm, sidx);
      pg8::gemm_phase(lds, DM, DM, S, E, acc); }
}

extern "C" void kernel_launch(void* const* d_in, const int* in_sizes, int n_in, void* d_out, int out_size, void* d_ws, size_t ws_size, hipStream_t stream) {
    constexpr int LDS_BYTES = pg8::STAGE_BYTES + 16;
    static int grid = 0;
    if (grid == 0) {
        if (n_in != 16 || ws_size < WS_END) { fprintf(stderr, "kernel_launch: unexpected inputs (n_in %d, ws %zu)\n", n_in, ws_size); grid = -1; return; }
        int dev = 0, cus = 0, per_cu = 0;
        (void)hipGetDevice(&dev); (void)hipDeviceGetAttribute(&cus, hipDeviceAttributeMultiprocessorCount, dev);
        if (hipFuncSetAttribute((const void*)hymba_fwd, hipFuncAttributeMaxDynamicSharedMemorySize, LDS_BYTES) != hipSuccess) { fprintf(stderr, "kernel_launch: hipFuncSetAttribute failed\n"); grid = -1; return; }
        if (hipOccupancyMaxActiveBlocksPerMultiprocessor(&per_cu, (const void*)hymba_fwd, 512, LDS_BYTES) != hipSuccess || per_cu < 1) { fprintf(stderr, "kernel_launch: occupancy query says %d\n", per_cu); per_cu = 1; (void)hipGetLastError(); }
        if (cus < 256) { fprintf(stderr, "kernel_launch: built for a 256-CU device (got %d CUs)\n", cus); grid = -1; return; }
        grid = 256;
    }
    if (grid < 0) return;
    if (hipMemsetAsync((char*)d_ws + WS_BAR, 0, WS_CTL_BYTES, stream) != hipSuccess) { fprintf(stderr, "kernel_launch: memset of the barrier words failed\n"); return; }
    Params p{};
    p.x_prompt = (const float*)d_in[0]; p.x_sample = (const float*)d_in[1]; p.cache_pool = (const float*)d_in[2]; p.cache_conv = (const float*)d_in[3];
    p.norm_g = (const float*)d_in[4]; p.w_in = (const float*)d_in[5]; p.pool_mix = (const float*)d_in[6]; p.pool_scale = (const float*)d_in[7];
    p.dw_w = (const float*)d_in[8]; p.dw_b = (const float*)d_in[9]; p.ln_g = (const float*)d_in[10]; p.ln_b = (const float*)d_in[11];
    p.pw_w = (const float*)d_in[12]; p.pw_b = (const float*)d_in[13]; p.w_out = (const float*)d_in[14]; p.final_g = (const float*)d_in[15];
    p.out = (float*)d_out; p.ws = (unsigned char*)d_ws;
    void* args[] = {&p};
    hipError_t e = hipLaunchCooperativeKernel((const void*)hymba_fwd, dim3(grid), dim3(512), args, LDS_BYTES, stream);
    if (e != hipSuccess) fprintf(stderr, "kernel_launch: cooperative launch failed: %s (grid %d)\n", hipGetErrorString(e), grid);
}
```

```cpp
#include <hip/hip_runtime.h>
#include <cstdio>

#define LAS __attribute__((address_space(3)))
typedef unsigned short bf16_t;
typedef short bf16x8 __attribute__((ext_vector_type(8)));
typedef float f32x4 __attribute__((ext_vector_type(4)));
typedef float f32x2 __attribute__((ext_vector_type(2)));
typedef unsigned u32x4 __attribute__((ext_vector_type(4)));
typedef unsigned u32x2 __attribute__((ext_vector_type(2)));

constexpr int DM = 1024, NPROMPT = 16384, NSAMP = 256, MT = NPROMPT + NSAMP, DIN = 2560, DH = 512;
constexpr int SEQ = 4096, DSEQ = 16;
constexpr size_t O_Y = 0;
constexpr size_t O_SPP = (size_t)MT * DM;
constexpr size_t O_SCP = O_SPP + 4 * 15 * 512;
constexpr size_t O_SPS = O_SCP + 4 * 30 * 512;
constexpr size_t O_SCS = O_SPS + 16 * 15 * 512;
constexpr size_t WS_XB = 0;
constexpr size_t WS_WIN = WS_XB + (size_t)MT * DM * 2;
constexpr size_t WS_MIX = WS_WIN + (size_t)DIN * DM * 2;
constexpr size_t WS_PW = WS_MIX + (size_t)512 * 512 * 2;
constexpr size_t WS_WOUT = WS_PW + (size_t)512 * 512 * 2;
constexpr size_t WS_U = WS_WOUT + (size_t)1024 * 1024 * 2;
constexpr size_t WS_SGP = WS_U + (size_t)MT * DH * 2;
constexpr size_t WS_V = WS_SGP + (size_t)MT * DH * 2;
constexpr size_t WS_SGC = WS_V + (size_t)MT * DH * 2;
constexpr size_t WS_PC = WS_SGC + (size_t)MT * DH * 2;
constexpr size_t WS_Z = WS_PC + (size_t)MT * DM * 2;
constexpr size_t WS_SS = WS_Z + (size_t)MT * DM * 2;
constexpr size_t WS_BAR = (WS_SS + (size_t)MT * 4 + 255) / 256 * 256;
constexpr size_t WS_CNT = WS_BAR + 4608 * 4;
constexpr size_t WS_CTL_BYTES = 4608 * 4 + 96 * 256;
constexpr int CW_PIECES = 64, CW_RV = 65  , CW_SV = 73  , CW_GV = 81  , CW_LW = 82  ;
constexpr size_t WS_XS = WS_CNT + 96 * 256;
constexpr size_t WS_END = WS_XS + (size_t)64 * 4 * 256 * 4;

struct Params {
    const float* x_prompt; const float* x_sample; const float* cache_pool; const float* cache_conv; const float* norm_g; const float* w_in;
    const float* pool_mix; const float* pool_scale; const float* dw_w; const float* dw_b; const float* ln_g; const float* ln_b;
    const float* pw_w; const float* pw_b; const float* w_out; const float* final_g;
    float* out; unsigned char* ws;
};

__device__ __forceinline__ unsigned cvt_pk_bf16(float lo, float hi) { unsigned r; asm volatile("v_cvt_pk_bf16_f32 %0, %1, %2" : "=v"(r) : "v"(lo), "v"(hi)); return r; }
__device__ __forceinline__ float bf_lo(unsigned u) { return __uint_as_float(u << 16); }
__device__ __forceinline__ float bf_hi(unsigned u) { return __uint_as_float(u & 0xffff0000u); }
__device__ __forceinline__ f32x2 bf_unpack(unsigned u) { return (f32x2){bf_lo(u), bf_hi(u)}; }
__device__ __forceinline__ float sigmoid_f(float x) { return __builtin_amdgcn_rcpf(1.0f + __expf(-x)); }
__device__ __forceinline__ float silu_f(float x) { return x * sigmoid_f(x); }
__device__ __forceinline__ u32x4 pack8(f32x4 a, f32x4 b) { return (u32x4){cvt_pk_bf16(a[0], a[1]), cvt_pk_bf16(a[2], a[3]), cvt_pk_bf16(b[0], b[1]), cvt_pk_bf16(b[2], b[3])}; }
__device__ __forceinline__ float wave_sum(float v) {
#pragma unroll
    for (int o = 32; o > 0; o >>= 1) v += __shfl_xor(v, o);
    return v;
}


#define XB_TMO      128
#define XB_XCNT(j)  (256  + 64 * (j))
#define XB_XSUB(j)  (1280 + 64 * (j))
#define XB_XGEN(j)  (2304 + 64 * (j))
#define XB_TOP      3328
#define XB_TOPGEN   3392
#define XB_XLOC(j)  (3520 + 64 * (j))
#define XCD_BAR_WORDS 4608
#define XB_SPIN_CAP (1u << 18)
__device__ __forceinline__ unsigned xb_ld(unsigned* p)              { return __hip_atomic_load(p, __ATOMIC_RELAXED, __HIP_MEMORY_SCOPE_AGENT); }
__device__ __forceinline__ unsigned xb_add(unsigned* p, unsigned v) { return __hip_atomic_fetch_add(p, v, __ATOMIC_RELAXED, __HIP_MEMORY_SCOPE_AGENT); }
__device__ __forceinline__ unsigned xb_xcc_id() { return (unsigned)__builtin_amdgcn_s_getreg((3 << 11) | 20) & 0xFu; }
#define XB_SPIN(cond, bar) do { unsigned _sp = 0; while (cond) { __builtin_amdgcn_s_sleep(1); \
    if ((++_sp & 255u) == 0u) { if (xb_ld(&(bar)[XB_TMO])) break; if (_sp > XB_SPIN_CAP) { atomicAdd(&(bar)[XB_TMO], 1u); break; } } } } while (0)
struct XcdBarrier { unsigned* bar; unsigned x; volatile LAS unsigned* st; };
__device__ __forceinline__ XcdBarrier xcd_barrier_post(unsigned* bar, volatile LAS unsigned* st) {
    XcdBarrier b; b.bar = bar; b.x = xb_xcc_id(); b.st = st;
    if (threadIdx.x == 0) st[2] = xb_add(&bar[XB_XCNT(b.x)], 1u);
    return b;
}
__device__ __forceinline__ void xcd_barrier_complete(unsigned* bar, unsigned x, unsigned& nloc, unsigned& nx, unsigned& uni) {
    const unsigned G = gridDim.x * gridDim.y * gridDim.z;
    unsigned sum, cnt, mine, sp = 0u;
    for (;;) {
        sum = 0u; cnt = 0u; mine = 0u; uni = 1u;
#pragma unroll
        for (unsigned j = 0; j < 16; ++j) { const unsigned c = xb_ld(&bar[XB_XCNT(j)]); sum += c; cnt += (c > 0u) ? 1u : 0u; mine = (j == x) ? c : mine; uni = (c == (j < 8 ? 32u : 0u)) ? uni : 0u; }
        if (sum == G) break;
        __builtin_amdgcn_s_sleep(1);
        if ((++sp & 255u) == 0u) { if (xb_ld(&bar[XB_TMO])) break; if (sp > XB_SPIN_CAP) { atomicAdd(&bar[XB_TMO], 1u); break; } }
    }
    nloc = mine > 0u ? mine : 1u; nx = cnt > 0u ? cnt : 1u; uni = (sum == G) ? uni : 0u;
}
template <class Hook>
__device__ __forceinline__ void xcd_barrier(const XcdBarrier& b, const Hook& hook) {
    asm volatile("s_waitcnt vmcnt(0)" ::: "memory");
    __syncthreads();
    if (threadIdx.x >= 64) hook();
    if (threadIdx.x == 0) {
        unsigned* bar = b.bar;
        __builtin_amdgcn_s_waitcnt(0);
        unsigned nloc = b.st[0], nx = b.st[1];
        if (nloc == 0u) { unsigned uni; xcd_barrier_complete(bar, b.x, nloc, nx, uni); b.st[0] = nloc; b.st[1] = nx; b.st[3] = uni; }
        const unsigned old = xb_add(&bar[XB_XSUB(b.x)], 1u);
        const unsigned gen = old / nloc;
        if (old + 1u == (gen + 1u) * nloc) {
            __builtin_amdgcn_fence(__ATOMIC_RELEASE, "agent");
            asm volatile("s_waitcnt vmcnt(0)" ::: "memory");
            const unsigned og = xb_add(&bar[XB_TOP], 1u);
            const unsigned tg = og / nx;
            if (og + 1u == (tg + 1u) * nx) xb_add(&bar[XB_TOPGEN], 1u);
            else XB_SPIN(xb_ld(&bar[XB_TOPGEN]) == tg, bar);
            __builtin_amdgcn_fence(__ATOMIC_ACQUIRE, "agent");
            xb_add(&bar[XB_XGEN(b.x)], 1u);
            asm volatile("s_waitcnt vmcnt(0)" ::: "memory");
        } else {
            XB_SPIN(xb_ld(&bar[XB_XGEN(b.x)]) == gen, bar);
            __builtin_amdgcn_fence(__ATOMIC_ACQUIRE, "agent");
            asm volatile("s_waitcnt vmcnt(0)" ::: "memory");
        }
    }
    if (threadIdx.x < 64) hook();
    __syncthreads();
}
__device__ __forceinline__ void xcd_barrier(const XcdBarrier& b) { xcd_barrier(b, [] {}); }
template <class Hook>
__device__ __forceinline__ void xcc_barrier(const XcdBarrier& b, const Hook& hook) {
    asm volatile("s_waitcnt vmcnt(0)" ::: "memory");
    __syncthreads();
    if (threadIdx.x >= 64) hook();
    if (threadIdx.x == 0) {
        unsigned* w = &b.bar[XB_XLOC(b.x)];
        __builtin_amdgcn_s_waitcnt(0);
        const unsigned old = xb_add(w, 1u), target = (old / 32u + 1u) * 32u;
        XB_SPIN(xb_ld(w) < target, b.bar);
        __builtin_amdgcn_fence(__ATOMIC_ACQUIRE, "agent");
        asm volatile("s_waitcnt vmcnt(0)" ::: "memory");
    }
    if (threadIdx.x < 64) hook();
    __syncthreads();
}

namespace pg8 {
constexpr int BM = 256, BK = 64, HALF = 128, HTB = HALF * BK * 2, STAGE_BYTES = 8 * HTB, NXCD = 8, WGM = 8;
__device__ __forceinline__ int lds_byte(int r, int c) { const int st = (r >> 4) * 2 + (c >> 5), rr = r & 15, cc = c & 31, ob = rr * 64 + cc * 2; return st * 1024 + (ob ^ (((ob >> 9) & 1) << 5)); }
__device__ __forceinline__ void stage_rc(int b, int& R, int& C) { const int st = b / 1024, sb = b % 1024, swz = sb ^ (((sb >> 9) & 1) << 5); R = (st >> 1) * 16 + swz / 64; C = (st & 1) * 32 + (swz % 64) / 2; }
__device__ __forceinline__ int perm32(int rho) { const int n = rho >> 4, i = rho & 15; return 8 * (i >> 2) + 4 * n + (i & 3); }

struct Unit { const char* A; const char* B; int pm, pn, nt, kind; };

__device__ __forceinline__ bool tile_order(int i, int G, int c, int nM, int nN, int& pm, int& pn) {
    const int nwg = nM * nN; const long L = (long)i * G + c; if (L >= nwg) return false;
    int wgid = (int)L; { const int q = nwg / NXCD, r = nwg % NXCD, xcd = wgid % NXCD, off = wgid / NXCD; wgid = (xcd < r ? xcd * (q + 1) : r * (q + 1) + (xcd - r) * q) + off; }
    const int nig = WGM * nN, gid = wgid / nig, fm = gid * WGM, gsz = (nM - fm) < WGM ? (nM - fm) : WGM;
    pm = fm + ((wgid % nig) % gsz); pn = (wgid % nig) / gsz; return true;
}

template <class Epi, class Sched>
__device__ __forceinline__ void gemm_phase(LAS unsigned char* lds, const int lda, const int ldb, const Sched& S, const Epi& E, f32x4 (&acc)[2][2][4][2]) {
    int tid_ = threadIdx.x; asm volatile("" : "+v"(tid_));
    const int tid = tid_, wid = __builtin_amdgcn_readfirstlane(tid >> 6), lane = tid & 63, wr = wid >> 2, wc = wid & 3, fr = lane & 15, fq = lane >> 4;
    unsigned voffA[2], voffB[2];
#pragma unroll
    for (int i = 0; i < 2; ++i) { int R, C; stage_rc(tid * 16 + i * 8192, R, C); const int Rb = Epi::PERM ? ((R & ~31) + perm32(R & 31)) : R;
        voffA[i] = (unsigned)(R * lda + C) * 2u; voffB[i] = (unsigned)(Rb * ldb + C) * 2u; }
    const size_t kstep = (size_t)(BK * 2);
    const size_t hstepA = (size_t)HALF * lda * 2, hstepB = (size_t)HALF * ldb * 2;
    const unsigned ldsw = (unsigned)wid * 1024u;
    const int aoff = lds_byte(wr * 64 + fr, fq * 8), boff = lds_byte(wc * 32 + fr, fq * 8);
#define PG8_SA(b, h) (((b) * 2 + (h)) * HTB)
#define PG8_SB(b, h) ((4 + (b) * 2 + (h)) * HTB)
#define PG8_STAGE(bufoff, gbase, voff) do { _Pragma("unroll") for (int _i = 0; _i < 2; ++_i) \
        __builtin_amdgcn_global_load_lds((const unsigned*)((const char*)(gbase) + (voff)[_i]), (LAS unsigned*)(lds + (bufoff) + ldsw + _i * 8192), 16, 0, 0); } while (0)
#define PG8_LDA(dst, b, h) do { _Pragma("unroll") for (int m = 0; m < 4; ++m) _Pragma("unroll") for (int k = 0; k < 2; ++k) dst[m][k] = *(const LAS bf16x8*)(lds + PG8_SA(b, h) + aoff + m * 2048 + k * 1024); } while (0)
#define PG8_LDB(dst, b, h) do { _Pragma("unroll") for (int n = 0; n < 2; ++n) _Pragma("unroll") for (int k = 0; k < 2; ++k) dst[n][k] = *(const LAS bf16x8*)(lds + PG8_SB(b, h) + boff + n * 2048 + k * 1024); } while (0)
#define PG8_MMA(ai, bj, At, Bt) do { __builtin_amdgcn_s_setprio(1); _Pragma("unroll") for (int m = 0; m < 4; ++m) _Pragma("unroll") for (int n = 0; n < 2; ++n) _Pragma("unroll") for (int k = 0; k < 2; ++k) \
        acc[ai][bj][m][n] = __builtin_amdgcn_mfma_f32_16x16x32_bf16(Bt[n][k], At[m][k], acc[ai][bj][m][n], 0, 0, 0); __builtin_amdgcn_s_setprio(0); } while (0)
#define PG8_WAIT_V(n) asm volatile("s_waitcnt vmcnt(" #n ")" ::: "memory")
#define PG8_WAIT_L(n) asm volatile("s_waitcnt lgkmcnt(" #n ")" ::: "memory")
#define PG8_BAR __builtin_amdgcn_s_barrier()
#define PG8_SCHED __builtin_amdgcn_sched_barrier(0)
    Unit cur, nxt; int ui = 0;
    if (!S.next(0, cur)) return;
    if constexpr (!Epi::EXT_INIT) E.init(acc, cur, wr, wc, fr, fq);
    bf16x8 At[4][2], B0[2][2], B1[2][2];
    const char* cA = cur.A; const char* cB = cur.B;
    PG8_STAGE(PG8_SB(0, 0), cB, voffB); PG8_STAGE(PG8_SA(0, 0), cA, voffA); PG8_STAGE(PG8_SB(0, 1), cB + hstepB, voffB); PG8_STAGE(PG8_SA(0, 1), cA + hstepA, voffA);
    if (wr == 1) PG8_BAR;
    PG8_WAIT_V(4); PG8_BAR;
    PG8_STAGE(PG8_SB(1, 0), cB + kstep, voffB); PG8_STAGE(PG8_SA(1, 0), cA + kstep, voffA); PG8_STAGE(PG8_SB(1, 1), cB + hstepB + kstep, voffB);
    PG8_WAIT_V(6); PG8_BAR;
    for (;;) {
        const bool has_next = S.next(ui + 1, nxt);
        const char* nA = has_next ? nxt.A : cA; const char* nB = has_next ? nxt.B : cB;
        const int nt = cur.nt;
        for (int t = 0; t < nt; t += 2) {
            const bool last = (t == nt - 2);
            const char* a1 = cA + (size_t)(t + 1) * kstep;
            const char* a2 = last ? nA : cA + (size_t)(t + 2) * kstep; const char* b2 = last ? nB : cB + (size_t)(t + 2) * kstep;
            const char* a3 = a2 + kstep; const char* b3 = b2 + kstep;
            PG8_LDB(B0, 0, 0); PG8_SCHED; PG8_LDA(At, 0, 0); PG8_STAGE(PG8_SA(1, 1), a1 + hstepA, voffA);
            PG8_WAIT_L(8); PG8_BAR; PG8_WAIT_L(0); PG8_MMA(0, 0, At, B0); PG8_BAR; PG8_SCHED;
            PG8_LDB(B1, 0, 1); PG8_STAGE(PG8_SB(0, 0), b2, voffB);
            PG8_BAR; PG8_WAIT_L(0); PG8_MMA(0, 1, At, B1); PG8_BAR;
            PG8_LDA(At, 0, 1); PG8_STAGE(PG8_SA(0, 0), a2, voffA);
            PG8_BAR; PG8_WAIT_L(0); PG8_MMA(1, 0, At, B0); PG8_BAR; PG8_SCHED;
            PG8_STAGE(PG8_SB(0, 1), b2 + hstepB, voffB);
            PG8_WAIT_V(6); PG8_BAR; PG8_MMA(1, 1, At, B1); PG8_BAR;
            PG8_LDB(B0, 1, 0); PG8_SCHED; PG8_LDA(At, 1, 0); PG8_STAGE(PG8_SA(0, 1), a2 + hstepA, voffA);
            PG8_WAIT_L(8); PG8_BAR; PG8_WAIT_L(0); PG8_MMA(0, 0, At, B0); PG8_BAR; PG8_SCHED;
            PG8_LDB(B1, 1, 1); PG8_STAGE(PG8_SB(1, 0), b3, voffB);
            PG8_BAR; PG8_WAIT_L(0); PG8_MMA(0, 1, At, B1); PG8_BAR;
            PG8_LDA(At, 1, 1); PG8_STAGE(PG8_SA(1, 0), a3, voffA);
            PG8_BAR; PG8_WAIT_L(0); PG8_MMA(1, 0, At, B0); PG8_BAR; PG8_SCHED;
            PG8_STAGE(PG8_SB(1, 1), b3 + hstepB, voffB);
            PG8_WAIT_V(6); PG8_BAR; PG8_MMA(1, 1, At, B1); PG8_BAR;
        }
        if constexpr (!Epi::AFTER_DRAIN) { E(acc, cur, wr, wc, fr, fq); S.done(cur, ui, lane); }
        if (!has_next) break;
        cur = nxt; cA = nA; cB = nB; ++ui;
        E.init(acc, cur, wr, wc, fr, fq);
    }
    PG8_WAIT_V(0);
    if (wr == 0) PG8_BAR;
    PG8_BAR;
    if constexpr (Epi::AFTER_DRAIN) E.fused(acc, cur, wr, wc, fr, fq, lds, tid);
#undef PG8_SA
#undef PG8_SB
#undef PG8_STAGE
#undef PG8_LDA
#undef PG8_LDB
#undef PG8_MMA
#undef PG8_WAIT_V
#undef PG8_WAIT_L
#undef PG8_BAR
#undef PG8_SCHED
}
}

struct SchedP1 {
    const char* xb; const char* win; unsigned* cnt; int gx, gl; bool uni;
    __device__ __forceinline__ bool next(int i, pg8::Unit& u) const {
        const int n_s = gx < 2 ? 2 : 1, j = gl + 32 * i; if (j >= 80 + n_s) return false;
        int pm, pn, kind;
        if (j < n_s) { pm = NPROMPT / 256; pn = gx + 8 * j; kind = 2; }
        else if (j < n_s + 48) { const int k = j - n_s, q = k >> 3; pm = 8 * gx + (k & 7); pn = q < 2 ? q : q + 2; kind = 1; }
        else { const int k = j - n_s - 48, q = k >> 3; pm = 8 * gx + (k & 7); pn = q < 2 ? q + 2 : q + 6; kind = 0; }
        u.pm = pm; u.pn = pn; u.kind = kind; u.nt = 16; u.A = xb + (size_t)pm * 256 * DM * 2; u.B = win + (size_t)pn * 256 * DM * 2; return true;
    }
    __device__ __forceinline__ void done(const pg8::Unit&, int ui, int lane) const {
        if (!uni) return;
        const int n_s = gx < 2 ? 2 : 1, nuv = gl < n_s + 16 ? 2 : 1;
        if (ui != nuv - 1) return;
        asm volatile("s_waitcnt vmcnt(0)" ::: "memory");
        if (lane == 0) { const int sm = gl < n_s ? 1 : 0, uv = nuv - sm;
            (void)xb_add(cnt + 64 * (CW_RV + gx), (unsigned)uv);
            if (sm) (void)xb_add(cnt + 64 * (CW_SV + gx), 1u); }
    }
};
struct EpiP1 {
    static constexpr bool PERM = true, AFTER_DRAIN = false, EXT_INIT = false;
    bf16_t* U; bf16_t* SGP; bf16_t* V; bf16_t* SGC; float* out;
    __device__ __forceinline__ void init(f32x4 (&acc)[2][2][4][2], const pg8::Unit&, int, int, int, int) const {
#pragma unroll
        for (int a = 0; a < 2; ++a)
#pragma unroll
            for (int b = 0; b < 2; ++b)
#pragma unroll
                for (int m = 0; m < 4; ++m)
#pragma unroll
                    for (int n = 0; n < 2; ++n) acc[a][b][m][n] = (f32x4){0.f, 0.f, 0.f, 0.f};
    }
    __device__ __forceinline__ void operator()(const f32x4 (&acc)[2][2][4][2], const pg8::Unit& u, int wr, int wc, int fr, int fq) const {
        const int pn = u.pn, row0 = u.pm * 256 + wr * 64 + fr, cl = wc * 32 + 8 * fq;
        if (pn < 2) {
#pragma unroll
            for (int ai = 0; ai < 2; ++ai)
#pragma unroll
                for (int m = 0; m < 4; ++m) {
                    const int r = row0 + ai * 128 + m * 16; bool st; size_t so;
                    if (r < NPROMPT) { const int t = r & (SEQ - 1); st = t >= SEQ - 15; so = O_SPP + ((size_t)(r >> 12) * 15 + (t - (SEQ - 15))) * 512; }
                    else { const int s = r - NPROMPT, t = s & 15; st = t >= 1; so = O_SPS + ((size_t)(s >> 4) * 15 + (t - 1)) * 512; }
#pragma unroll
                    for (int bj = 0; bj < 2; ++bj) { const int c = pn * 256 + bj * 128 + cl; const f32x4 v0 = acc[ai][bj][m][0], v1 = acc[ai][bj][m][1];
                        *(u32x4*)(U + (size_t)r * DH + c) = pack8(v0, v1);
                        if (st) { *(f32x4*)(out + so + c) = v0; *(f32x4*)(out + so + c + 4) = v1; } }
                }
        } else if (pn < 4 || pn >= 8) {
            bf16_t* dst = pn < 4 ? SGP : SGC; const int cb = (pn < 4 ? pn - 2 : pn - 8) * 256 + cl;
#pragma unroll
            for (int ai = 0; ai < 2; ++ai)
#pragma unroll
                for (int m = 0; m < 4; ++m) { const int r = row0 + ai * 128 + m * 16;
#pragma unroll
                    for (int bj = 0; bj < 2; ++bj) { f32x4 v0 = acc[ai][bj][m][0], v1 = acc[ai][bj][m][1];
#pragma unroll
                        for (int j = 0; j < 4; ++j) { v0[j] = silu_f(v0[j]); v1[j] = silu_f(v1[j]); }
                        *(u32x4*)(dst + (size_t)r * DH + cb + bj * 128) = pack8(v0, v1); }
                }
        } else {
            const int c = (pn - 4) * 128 + cl;
#pragma unroll
            for (int ai = 0; ai < 2; ++ai)
#pragma unroll
                for (int m = 0; m < 4; ++m) {
                    const int r = row0 + ai * 128 + m * 16; bool st; size_t so;
                    if (r < NPROMPT) { const int t = r & (SEQ - 1); st = t >= SEQ - 30; so = O_SCP + ((size_t)(r >> 12) * 30 + (t - (SEQ - 30))) * 512; }
                    else { const int s = r - NPROMPT, t = s & 15; st = true; so = O_SCS + ((size_t)(s >> 4) * 30 + 14 + t) * 512; }
                    f32x4 v0 = acc[ai][0][m][0], v1 = acc[ai][0][m][1]; const f32x4 g0 = acc[ai][1][m][0], g1 = acc[ai][1][m][1];
#pragma unroll
                    for (int j = 0; j < 4; ++j) { v0[j] *= sigmoid_f(g0[j]); v1[j] *= sigmoid_f(g1[j]); }
                    *(u32x4*)(V + (size_t)r * DH + c) = pack8(v0, v1);
                    if (st) { *(f32x4*)(out + so + c) = v0; *(f32x4*)(out + so + c + 4) = v1; }
                }
        }
    }
};

struct SchedP3 {
    const char* pc; const char* mix; const char* pw; int pm0, pn0;
    __device__ __forceinline__ void done(const pg8::Unit&, int, int) const {}
    __device__ __forceinline__ bool next(int i, pg8::Unit& u) const {
        if (i != 0) return false; const int pm = pm0, pn = pn0;
        u.pm = pm; u.pn = pn; u.kind = 0;
        if (pn < 2) { u.nt = 4; u.A = pc + ((size_t)pm * 256 * DM + 256 * pn) * 2; u.B = mix + ((size_t)pn * 256 * 512 + 256 * pn) * 2; }
        else { u.nt = 8; u.A = pc + ((size_t)pm * 256 * DM + 512) * 2; u.B = pw + (size_t)(pn - 2) * 256 * 512 * 2; }
        return true;
    }
};
struct EpiP3 {
    static constexpr bool PERM = true, AFTER_DRAIN = false, EXT_INIT = false;
    const bf16_t* SGP; const bf16_t* SGC; const float* pw_b; bf16_t* Z;
    __device__ __forceinline__ void init(f32x4 (&acc)[2][2][4][2], const pg8::Unit&, int, int, int, int) const {
#pragma unroll
        for (int a = 0; a < 2; ++a)
#pragma unroll
            for (int b = 0; b < 2; ++b)
#pragma unroll
                for (int m = 0; m < 4; ++m)
#pragma unroll
                    for (int n = 0; n < 2; ++n) acc[a][b][m][n] = (f32x4){0.f, 0.f, 0.f, 0.f};
    }
    __device__ __forceinline__ void operator()(const f32x4 (&acc)[2][2][4][2], const pg8::Unit& u, int wr, int wc, int fr, int fq) const {
        const int pn = u.pn, row0 = u.pm * 256 + wr * 64 + fr, cl = wc * 32 + 8 * fq;
        const bool conv = pn >= 2; const bf16_t* gate = conv ? SGC : SGP; const int cb = (conv ? pn - 2 : pn) * 256 + cl;
        f32x4 bv[2][2];
#pragma unroll
        for (int bj = 0; bj < 2; ++bj)
#pragma unroll
            for (int n = 0; n < 2; ++n) bv[bj][n] = conv ? *(const f32x4*)(pw_b + cb + bj * 128 + 4 * n) : (f32x4){0.f, 0.f, 0.f, 0.f};
#pragma unroll
        for (int ai = 0; ai < 2; ++ai) {
            u32x4 gt[4][2];
#pragma unroll
            for (int m = 0; m < 4; ++m)
#pragma unroll
                for (int bj = 0; bj < 2; ++bj) gt[m][bj] = *(const u32x4*)(gate + (size_t)(row0 + ai * 128 + m * 16) * DH + cb + bj * 128);
#pragma unroll
            for (int m = 0; m < 4; ++m) { const int r = row0 + ai * 128 + m * 16;
#pragma unroll
                for (int bj = 0; bj < 2; ++bj) { const int c = cb + bj * 128; const u32x4 g = gt[m][bj];
                    f32x4 v0 = acc[ai][bj][m][0] + bv[bj][0], v1 = acc[ai][bj][m][1] + bv[bj][1];
                    v0[0] *= bf_lo(g[0]); v0[1] *= bf_hi(g[0]); v0[2] *= bf_lo(g[1]); v0[3] *= bf_hi(g[1]);
                    v1[0] *= bf_lo(g[2]); v1[1] *= bf_hi(g[2]); v1[2] *= bf_lo(g[3]); v1[3] *= bf_hi(g[3]);
                    *(u32x4*)(Z + (size_t)r * DM + (conv ? 512 : 0) + c) = pack8(v0, v1); }
            }
        }
    }
};

struct SchedP4 {
    const char* z; const char* wout; int pm0, pn0;
    __device__ __forceinline__ void done(const pg8::Unit&, int, int) const {}
    __device__ __forceinline__ bool next(int i, pg8::Unit& u) const {
        if (i != 0) return false; const int pm = pm0, pn = pn0;
        u.pm = pm; u.pn = pn; u.kind = 0; u.nt = 16; u.A = z + (size_t)pm * 256 * DM * 2; u.B = wout + (size_t)pn * 256 * DM * 2; return true;
    }
};
struct EpiP4 {
    static constexpr bool PERM = false, AFTER_DRAIN = true, EXT_INIT = true;
    const float* x_prompt; const float* final_g; float* out; float* xs; unsigned* cnt; const float* ss; int srow; bool uni;
    __device__ __forceinline__ void init(f32x4 (&acc)[2][2][4][2], const pg8::Unit& u, int wr, int wc, int fr, int fq) const {
        const int row0 = u.pm * 256 + wr * 64 + fr, col0 = u.pn * 256 + wc * 32 + 4 * fq;
#pragma unroll
        for (int ai = 0; ai < 2; ++ai)
#pragma unroll
            for (int m = 0; m < 4; ++m) { const float* xr = x_prompt + (size_t)(row0 + ai * 128 + m * 16) * DM + col0;
#pragma unroll
                for (int bj = 0; bj < 2; ++bj)
#pragma unroll
                    for (int n = 0; n < 2; ++n) acc[ai][bj][m][n] = *(const f32x4*)(xr + bj * 128 + n * 16); }
    }
    __device__ __forceinline__ void fused(const f32x4 (&acc)[2][2][4][2], const pg8::Unit& u, int wr, int wc, int fr, int fq, LAS unsigned char* lds, int tid) const {
        LAS float* lss = (LAS float*)lds;
#pragma unroll
        for (int ai = 0; ai < 2; ++ai)
#pragma unroll
            for (int m = 0; m < 4; ++m) { float s = 0.f;
#pragma unroll
                for (int bj = 0; bj < 2; ++bj)
#pragma unroll
                    for (int n = 0; n < 2; ++n) { const f32x4 y = acc[ai][bj][m][n]; s += y[0] * y[0] + y[1] * y[1] + y[2] * y[2] + y[3] * y[3]; }
                s += __shfl_xor(s, 16); s += __shfl_xor(s, 32);
                if (fq == 0) lss[(ai * 128 + wr * 64 + m * 16 + fr) * 4 + wc] = s; }
        __syncthreads();
        if (tid < 256) { const f32x4 v = *(const LAS f32x4*)(lss + tid * 4); xs[((size_t)u.pm * 4 + u.pn) * 256 + tid] = v[0] + v[1] + v[2] + v[3]; }
        asm volatile("s_waitcnt vmcnt(0)" ::: "memory");
        __syncthreads();
        if (tid == 0) {
            unsigned* cw = cnt + 64 * u.pm; unsigned* cs = cnt + 64 * CW_PIECES;
            if (!uni) __builtin_amdgcn_fence(__ATOMIC_RELEASE, "agent");
            asm volatile("s_waitcnt vmcnt(0)" ::: "memory");
            (void)xb_add(cw, 1u);
            unsigned sp = 0u;
            while (xb_ld(cw) < 4u || xb_ld(cs) < 256u) { __builtin_amdgcn_s_sleep(1); if (++sp > (1u << 22)) break; }
            __builtin_amdgcn_fence(__ATOMIC_ACQUIRE, "agent");
            asm volatile("s_waitcnt vmcnt(0)" ::: "memory");
        }
        __syncthreads();
        if (tid >= 256) { const int t4 = (tid - 256) * 4; const float rs = rsqrtf(ss[srow] * (1.0f / DM) + 1e-6f); float* yr = out + (size_t)srow * DM + t4;
            *(f32x4*)yr = *(const f32x4*)yr * rs * *(const f32x4*)(final_g + t4); }
        if (tid < 256) { const float* xp = xs + (size_t)u.pm * 4 * 256 + tid; const float tot = xp[0] + xp[256] + xp[512] + xp[768];
            lss[1024 + tid] = rsqrtf(tot * (1.0f / DM) + 1e-6f); }
        __syncthreads();
        const int row0 = u.pm * 256 + wr * 64 + fr, col0 = u.pn * 256 + wc * 32 + 4 * fq;
        f32x4 g4[2][2];
#pragma unroll
        for (int bj = 0; bj < 2; ++bj)
#pragma unroll
            for (int n = 0; n < 2; ++n) g4[bj][n] = *(const f32x4*)(final_g + col0 + bj * 128 + n * 16);
#pragma unroll
        for (int ai = 0; ai < 2; ++ai)
#pragma unroll
            for (int m = 0; m < 4; ++m) { const float rs = lss[1024 + ai * 128 + wr * 64 + m * 16 + fr]; float* yr = out + (size_t)(row0 + ai * 128 + m * 16) * DM + col0;
#pragma unroll
                for (int bj = 0; bj < 2; ++bj)
#pragma unroll
                    for (int n = 0; n < 2; ++n) *(f32x4*)(yr + bj * 128 + n * 16) = acc[ai][bj][m][n] * rs * g4[bj][n]; }
    }
    __device__ __forceinline__ void operator()(const f32x4 (&)[2][2][4][2], const pg8::Unit&, int, int, int, int) const {}
};

template <int NF>
__device__ __forceinline__ f32x4 small_gemm(const bf16_t* __restrict__ A, int lda, const bf16_t* __restrict__ Bt, int ldb, int K, int nw, f32x4* red) {
    const int tid = threadIdx.x, wid = tid >> 6, lane = tid & 63, fr = lane & 15, fq = lane >> 4;
    f32x4 acc[NF];
#pragma unroll
    for (int f = 0; f < NF; ++f) acc[f] = (f32x4){0.f, 0.f, 0.f, 0.f};
    if (wid < nw) { const int ks = K / nw; const bf16_t* ap = A + (size_t)fr * lda + wid * ks + fq * 8; const bf16_t* bp = Bt + (size_t)fr * ldb + wid * ks + fq * 8;
        for (int k = 0; k < ks; k += 32) { const bf16x8 a = *(const bf16x8*)(ap + k);
#pragma unroll
            for (int f = 0; f < NF; ++f) { const bf16x8 b = *(const bf16x8*)(bp + (size_t)f * 16 * ldb + k); acc[f] = __builtin_amdgcn_mfma_f32_16x16x32_bf16(b, a, acc[f], 0, 0, 0); } } }
#pragma unroll
    for (int f = 0; f < NF; ++f) red[(wid * NF + f) * 64 + lane] = acc[f];
    __syncthreads();
    f32x4 r = (f32x4){0.f, 0.f, 0.f, 0.f};
    if (tid < 64 * NF) {
#pragma unroll
        for (int w = 0; w < 8; ++w) r += red[(w * NF + wid) * 64 + lane]; }
    return r;
}
__device__ __forceinline__ void sample_p3(const Params& p, unsigned char* shm, const int i) {
    const int tid = threadIdx.x, wid = tid >> 6, lane = tid & 63, fr = lane & 15, fq = lane >> 4; f32x4* red = (f32x4*)shm;
    const bf16_t* PC = (const bf16_t*)(p.ws + WS_PC); bf16_t* Z = (bf16_t*)(p.ws + WS_Z);
    { const int rb = i >> 4, cb = i & 15, row0 = NPROMPT + rb * 16, row = row0 + fr, c = 32 * cb + 16 * wid + 4 * fq;
        {
            const f32x4 r = small_gemm<2>(PC + (size_t)row0 * DM + 512, DM, (const bf16_t*)(p.ws + WS_PW) + (size_t)32 * cb * 512, 512, 512, 8, red);
            if (tid < 128) { const f32x4 bv = *(const f32x4*)(p.pw_b + c); const u32x2 g = *(const u32x2*)((const bf16_t*)(p.ws + WS_SGC) + (size_t)row * DH + c);
                const f32x4 z = (r + bv) * (f32x4){bf_lo(g[0]), bf_hi(g[0]), bf_lo(g[1]), bf_hi(g[1])};
                *(u32x2*)(Z + (size_t)row * DM + 512 + c) = (u32x2){cvt_pk_bf16(z[0], z[1]), cvt_pk_bf16(z[2], z[3])}; }
            __syncthreads();
        }
        {
            const int g128 = (cb >> 2) * 128;
            const f32x4 r = small_gemm<2>(PC + (size_t)row0 * DM + g128, DM, (const bf16_t*)(p.ws + WS_MIX) + (size_t)32 * cb * 512 + g128, 512, 128, 4, red);
            if (tid < 128) { const u32x2 g = *(const u32x2*)((const bf16_t*)(p.ws + WS_SGP) + (size_t)row * DH + c);
                const f32x4 z = r * (f32x4){bf_lo(g[0]), bf_hi(g[0]), bf_lo(g[1]), bf_hi(g[1])};
                *(u32x2*)(Z + (size_t)row * DM + c) = (u32x2){cvt_pk_bf16(z[0], z[1]), cvt_pk_bf16(z[2], z[3])}; }
            __syncthreads();
        }
    }
}
__device__ __forceinline__ void sample_p4(const Params& p, unsigned char* shm, const int i) {
    const int tid = threadIdx.x, wid = tid >> 6, lane = tid & 63, fr = lane & 15, fq = lane >> 4; f32x4* red = (f32x4*)shm;
    float* ss = (float*)(p.ws + WS_SS);
    { const int rb = i >> 4, cb = i & 15, row0 = NPROMPT + rb * 16, row = row0 + fr, c = 64 * cb + 16 * wid + 4 * fq;
        const f32x4 r = small_gemm<4>((const bf16_t*)(p.ws + WS_Z) + (size_t)row0 * DM, DM, (const bf16_t*)(p.ws + WS_WOUT) + (size_t)64 * cb * DM, DM, DM, 8, red);
        if (tid < 256) { const f32x4 y = r + *(const f32x4*)(p.x_sample + (size_t)(row - NPROMPT) * DM + c);
            *(f32x4*)(p.out + (size_t)row * DM + c) = y;
            float s = y[0] * y[0] + y[1] * y[1] + y[2] * y[2] + y[3] * y[3]; s += __shfl_xor(s, 16); s += __shfl_xor(s, 32);
            if (fq == 0) atomicAdd(ss + row, s); }
        asm volatile("s_waitcnt vmcnt(0)" ::: "memory");
        __syncthreads();
        if (tid == 0) { __builtin_amdgcn_fence(__ATOMIC_RELEASE, "agent"); asm volatile("s_waitcnt vmcnt(0)" ::: "memory"); (void)xb_add((unsigned*)(p.ws + WS_CNT) + 64 * CW_PIECES, 1u); }
    }
}
__device__ __forceinline__ void transpose_load(const float* __restrict__ src, int ldsrc, int k0, int n0s, f32x4 (&v)[2]) {
    const int tid = threadIdx.x, kk = tid >> 4, n4 = (tid & 15) * 4;
#pragma unroll
    for (int i = 0; i < 2; ++i) v[i] = *(const f32x4*)(src + (size_t)(k0 + kk + 32 * i) * ldsrc + n0s + n4);
}
__device__ __forceinline__ void transpose_store(const f32x4 (&v)[2], int k0, bf16_t* __restrict__ dst, int ldd, int n0d, float* tile) {
    const int tid = threadIdx.x;
    {
        const int kk = tid >> 4, n4 = (tid & 15) * 4;
#pragma unroll
        for (int i = 0; i < 2; ++i) { const int k = kk + 32 * i;
            tile[k * 65 + n4 + 0] = v[i][0]; tile[k * 65 + n4 + 1] = v[i][1]; tile[k * 65 + n4 + 2] = v[i][2]; tile[k * 65 + n4 + 3] = v[i][3]; }
    }
    __syncthreads();
    {
        const int n = tid >> 3, k8 = (tid & 7) * 8; float w[8];
#pragma unroll
        for (int j = 0; j < 8; ++j) w[j] = tile[(k8 + j) * 65 + n];
        *(u32x4*)(dst + (size_t)(n0d + n) * ldd + k0 + k8) = (u32x4){cvt_pk_bf16(w[0], w[1]), cvt_pk_bf16(w[2], w[3]), cvt_pk_bf16(w[4], w[5]), cvt_pk_bf16(w[6], w[7])};
    }
    __syncthreads();
}
__device__ __forceinline__ void transpose_tile(const float* __restrict__ src, int ldsrc, int k0, int n0s, bf16_t* __restrict__ dst, int ldd, int n0d, float* tile) {
    f32x4 v[2]; transpose_load(src, ldsrc, k0, n0s, v); transpose_store(v, k0, dst, ldd, n0d, tile);
}
__device__ __forceinline__ int win_src_col(int n0) {
    if (n0 >= 1024 && n0 < 2048) { const int q = n0 - 1024, j = q >> 8, i = q & 255; return i < 128 ? 1024 + 128 * j + i : 1536 + 128 * j + (i - 128); }
    return n0;
}

__device__ __forceinline__ void phase_prep(const Params& p, unsigned char* shm) {
    const int tid = threadIdx.x, wid = tid >> 6, lane = tid & 63, nb = gridDim.x, bid = blockIdx.x;
    bf16_t* xb = (bf16_t*)(p.ws + WS_XB);
    constexpr int T_IN = 16 * 40;
    f32x4 tv[3][2];
#pragma unroll
    for (int q = 0; q < 3; ++q) { const int t = bid + q * nb; if (t < T_IN) transpose_load(p.w_in, DIN, (t / 40) * 64, win_src_col((t % 40) * 64), tv[q]); }
    {
        f32x4 g4[4];
#pragma unroll
        for (int i = 0; i < 4; ++i) g4[i] = *(const f32x4*)(p.norm_g + lane * 4 + 256 * i);
        for (int g = bid * 8 + wid; g < MT / 4; g += nb * 8) {
            f32x4 v[4][4]; float s[4];
#pragma unroll
            for (int q = 0; q < 4; ++q) { const int r = g * 4 + q; const float* xr = r < NPROMPT ? p.x_prompt + (size_t)r * DM : p.x_sample + (size_t)(r - NPROMPT) * DM;
#pragma unroll
                for (int i = 0; i < 4; ++i) v[q][i] = *(const f32x4*)(xr + lane * 4 + 256 * i); }
#pragma unroll
            for (int q = 0; q < 4; ++q) { s[q] = 0.f;
#pragma unroll
                for (int i = 0; i < 4; ++i) s[q] += v[q][i][0] * v[q][i][0] + v[q][i][1] * v[q][i][1] + v[q][i][2] * v[q][i][2] + v[q][i][3] * v[q][i][3];
                s[q] = wave_sum(s[q]); }
#pragma unroll
            for (int q = 0; q < 4; ++q) { const int r = g * 4 + q; const float rs = rsqrtf(s[q] * (1.0f / DM) + 1e-6f);
#pragma unroll
                for (int i = 0; i < 4; ++i) { const f32x4 h = v[q][i] * rs * g4[i];
                    *(u32x2*)(xb + (size_t)r * DM + lane * 4 + 256 * i) = (u32x2){cvt_pk_bf16(h[0], h[1]), cvt_pk_bf16(h[2], h[3])}; } }
        }
    }
    {
        float* tile = (float*)shm; bf16_t* win = (bf16_t*)(p.ws + WS_WIN);
#pragma unroll
        for (int q = 0; q < 3; ++q) { const int t = bid + q * nb; if (t < T_IN) transpose_store(tv[q], (t / 40) * 64, win, DM, (t % 40) * 64, tile); }
        for (int t = bid + 3 * nb; t < T_IN; t += nb) transpose_tile(p.w_in, DIN, (t / 40) * 64, win_src_col((t % 40) * 64), win, DM, (t % 40) * 64, tile);
    }
    float* ss = (float*)(p.ws + WS_SS);
    for (int i = bid * 512 + tid; i < MT; i += nb * 512) ss[i] = 0.f;
    for (int i = bid * 512 + tid; i < 16 * 14 * 128; i += nb * 512) { const int c4 = i & 127, rr = i >> 7, b = rr / 14, j = rr % 14;
        *(f32x4*)(p.out + O_SCS + ((size_t)b * 30 + j) * 512 + c4 * 4) = *(const f32x4*)(p.cache_conv + ((size_t)b * 30 + 16 + j) * 512 + c4 * 4); }
}

__device__ __forceinline__ void late_weight_prep(const Params& p, unsigned char* shm, const int bid, const int nb) {
    const int tid = threadIdx.x; float* tile = (float*)shm;
    bf16_t* pw = (bf16_t*)(p.ws + WS_PW); bf16_t* wout = (bf16_t*)(p.ws + WS_WOUT); bf16_t* mix = (bf16_t*)(p.ws + WS_MIX);
    constexpr int T_OUT = 16 * 16, T_PW = 8 * 8;
    for (int t = bid; t < T_OUT + T_PW; t += nb) {
        if (t < T_OUT) transpose_tile(p.w_out, DM, (t >> 4) * 64, (t & 15) * 64, wout, DM, (t & 15) * 64, tile);
        else { const int tt = t - T_OUT; transpose_tile(p.pw_w, 512, (tt >> 3) * 64, (tt & 7) * 64, pw, 512, (tt & 7) * 64, tile); }
    }
    for (int idx = bid * 512 + tid; idx < 512 * 512; idx += nb * 512) { const int n = idx >> 9, k = idx & 511; float v = 0.f;
        if ((n >> 7) == (k >> 7)) v = p.pool_mix[((size_t)(n >> 7) * 128 + (k & 127)) * 128 + (n & 127)] * p.pool_scale[n];
        mix[idx] = (bf16_t)(cvt_pk_bf16(v, 0.f) & 0xffffu); }
    __syncthreads();
}

#define DPP_STEP(v, ctrl) ((v) + __builtin_bit_cast(float, __builtin_amdgcn_update_dpp(0, __builtin_bit_cast(int, (v)), (ctrl), 0xf, 0xf, true)))
__device__ __forceinline__ float wave_sum_hi(float v) {
    v = DPP_STEP(v, 0xB1);
    v = DPP_STEP(v, 0x4E);
    v = DPP_STEP(v, 0x141);
    v = DPP_STEP(v, 0x140);
    v += __builtin_bit_cast(float, __builtin_amdgcn_update_dpp(0, __builtin_bit_cast(int, v), 0x142, 0xa, 0xf, false));
    v += __builtin_bit_cast(float, __builtin_amdgcn_update_dpp(0, __builtin_bit_cast(int, v), 0x143, 0xc, 0xf, false));
    return v;
}
#define RED16_STEP(CTRL) _Pragma("unroll") for (int k = 0; k < 16; ++k) asm volatile("v_add_f32_dpp %0, %0, %0 " CTRL : "+v"(r[k]))
__device__ __forceinline__ void wave_sum16_hi(float (&r)[16]) {
    asm volatile("s_nop 1" ::: "memory");
    RED16_STEP("quad_perm:[1,0,3,2] row_mask:0xf bank_mask:0xf");
    RED16_STEP("quad_perm:[2,3,0,1] row_mask:0xf bank_mask:0xf");
    RED16_STEP("row_half_mirror row_mask:0xf bank_mask:0xf");
    RED16_STEP("row_mirror row_mask:0xf bank_mask:0xf");
    RED16_STEP("row_bcast:15 row_mask:0xa bank_mask:0xf");
    RED16_STEP("row_bcast:31 row_mask:0xc bank_mask:0xf");
}
template <int W, int TH>
__device__ __forceinline__ void pool_regs(const unsigned (&u)[TH + 15], const int pos0, bf16_t* __restrict__ dst  ) {
    f32x2 s = (f32x2){0.f, 0.f};
#pragma unroll
    for (int j = 0; j < W; ++j) s += bf_unpack(u[15 - j]);
#pragma unroll
    for (int i = 0; i < TH; ++i) { const f32x2 cur = bf_unpack(u[15 + i]); const int pos1 = pos0 + i + 1;
        const float inv = pos1 >= W ? (1.0f / W) : __builtin_amdgcn_rcpf((float)pos1);
        const f32x2 o = s * inv - cur;
        *(unsigned*)(dst + (size_t)i * DM) = cvt_pk_bf16(o[0], o[1]);
        if (i + 1 < TH) s += bf_unpack(u[16 + i]) - bf_unpack(u[16 + i - W]); }
}
template <int T>
__device__ __forceinline__ void mixer_chunk(const Params& p, unsigned char* shm, const int r0, const int t0, const int tid, const f32x2 (&w2)[31]) {
    constexpr int TH = T / 2, ROUNDS = T / 16, NV = ((T + 30) * 64 + 511) / 512;
    const int cp = tid & 255, th = tid >> 8, lane = tid & 63, wv = (tid >> 6) & 3;
    const bf16_t* U = (const bf16_t*)(p.ws + WS_U); const bf16_t* V = (const bf16_t*)(p.ws + WS_V); bf16_t* PC = (bf16_t*)(p.ws + WS_PC);
    const unsigned* l32 = (const unsigned*)shm;
    u32x4 val[NV];
    {
        const bf16_t* vb = V + (size_t)(r0 - 30) * DH;
#pragma unroll
        for (int k = 0; k < NV; ++k) { const int idx = tid + k * 512, lr = idx >> 6; val[k] = (u32x4){0u, 0u, 0u, 0u};
            if (idx < (T + 30) * 64 && t0 - 30 + lr >= 0) val[k] = *(const u32x4*)(vb + (size_t)idx * 8); }
    }
    unsigned u[TH + 15];
    {
        const int f0 = th * TH - 15; const bf16_t* ub = U + (size_t)(r0 + f0) * DH + cp * 2;
#pragma unroll
        for (int k = 0; k < TH + 15; ++k) { u[k] = 0u; if (t0 + f0 + k >= 0) u[k] = *(const unsigned*)(ub + (size_t)k * DH); }
    }
#pragma unroll
    for (int k = 0; k < NV; ++k) { const int idx = tid + k * 512; if (idx < (T + 30) * 64) *(u32x4*)(shm + (size_t)idx * 16) = val[k]; }
    const f32x2 bias = *(const f32x2*)(p.dw_b + cp * 2);
    const f32x2 g2 = *(const f32x2*)(p.ln_g + cp * 2), b2 = *(const f32x2*)(p.ln_b + cp * 2);
    __syncthreads();
    {
        bf16_t* dst = PC + (size_t)(r0 + th * TH) * DM + cp * 2; const int pos0 = t0 + th * TH;
        switch (cp >> 6) { case 0: pool_regs<2, TH>(u, pos0, dst); break; case 1: pool_regs<4, TH>(u, pos0, dst); break; case 2: pool_regs<8, TH>(u, pos0, dst); break; default: pool_regs<16, TH>(u, pos0, dst); break; }
    }
    f32x2* stats = (f32x2*)(shm + (T + 30) * 1024);
#pragma unroll 1
    for (int rd = 0; rd < ROUNDS; ++rd) {
        const int tt = rd * 16 + th * 8;
        f32x2 c[8];
#pragma unroll
        for (int i = 0; i < 8; ++i) c[i] = bias;
        unsigned win[38];
#pragma unroll
        for (int q = 0; q < 38; ++q) win[q] = l32[(tt + q) * 256 + cp];
#pragma unroll
        for (int q = 0; q < 38; ++q) { const f32x2 v = bf_unpack(win[q]);
#pragma unroll
            for (int i = 0; i < 8; ++i) if (q - i >= 0 && q - i < 31) c[i] += w2[q - i] * v;
            asm volatile("" : "+v"(c[0]), "+v"(c[1]), "+v"(c[2]), "+v"(c[3]), "+v"(c[4]), "+v"(c[5]), "+v"(c[6]), "+v"(c[7])); }
        { float r[16];
#pragma unroll
          for (int i = 0; i < 8; ++i) { r[2 * i] = c[i][0] + c[i][1]; r[2 * i + 1] = c[i][0] * c[i][0] + c[i][1] * c[i][1]; }
          wave_sum16_hi(r);
#pragma unroll
          for (int i = 0; i < 8; ++i) if (lane == 63) stats[(tt + i) * 4 + wv] = (f32x2){r[2 * i], r[2 * i + 1]}; }
        __syncthreads();
        float mean_l, rs_l;
        { const int ti = tt + (lane & 7);
          const f32x4 sa = *(const f32x4*)(stats + ti * 4), sb = *(const f32x4*)(stats + ti * 4 + 2);
          mean_l = (sa[0] + sa[2] + sb[0] + sb[2]) * (1.0f / 512.0f);
          const float var = (sa[1] + sa[3] + sb[1] + sb[3]) * (1.0f / 512.0f) - mean_l * mean_l;
          rs_l = __builtin_amdgcn_rsqf(var + 1e-5f); }
#pragma unroll
        for (int i = 0; i < 8; ++i) {
            const float mean = __builtin_bit_cast(float, __builtin_amdgcn_readlane(__builtin_bit_cast(int, mean_l), i));
            const float rs = __builtin_bit_cast(float, __builtin_amdgcn_readlane(__builtin_bit_cast(int, rs_l), i));
            const f32x2 y = (c[i] - mean) * rs * g2 + b2;
            *(unsigned*)(PC + (size_t)(r0 + tt + i) * DM + 512 + cp * 2) = cvt_pk_bf16(silu_f(y[0]), silu_f(y[1])); }
    }
    __syncthreads();
}

__device__ __forceinline__ void sample_token(const Params& p, unsigned char* shm, const int s) {
    const int tid = threadIdx.x, wid = tid >> 6, lane = tid & 63, b = s >> 4, t = s & 15, r = NPROMPT + s, ch = tid;
    const bf16_t* U = (const bf16_t*)(p.ws + WS_U); const bf16_t* V = (const bf16_t*)(p.ws + WS_V); bf16_t* PC = (bf16_t*)(p.ws + WS_PC);
    {
        const int w = 2 << (ch >> 7); float sum = 0.f, cur = 0.f;
#pragma unroll
        for (int j = 0; j < 16; ++j) if (j < w) { const int e = t + 15 - j;
            const float v = e < 15 ? p.cache_pool[((size_t)b * 15 + e) * 512 + ch] : __uint_as_float((unsigned)U[(size_t)(NPROMPT + b * 16 + e - 15) * DH + ch] << 16);
            sum += v; if (j == 0) cur = v; }
        const float o = sum / (float)w - cur;
        PC[(size_t)r * DM + ch] = (bf16_t)(cvt_pk_bf16(o, 0.f) & 0xffffu);
    }
    float c = p.dw_b[ch];
#pragma unroll
    for (int j = 0; j < 31; ++j) { const int e = t + j;
        const float v = e < 30 ? p.cache_conv[((size_t)b * 30 + e) * 512 + ch] : __uint_as_float((unsigned)V[(size_t)(NPROMPT + b * 16 + e - 30) * DH + ch] << 16);
        c += p.dw_w[j * 512 + ch] * v; }
    float s1 = wave_sum(c), s2 = wave_sum(c * c);
    f32x2* red = (f32x2*)shm;
    if (lane == 0) red[wid] = (f32x2){s1, s2};
    __syncthreads();
    s1 = 0.f; s2 = 0.f;
#pragma unroll
    for (int w8 = 0; w8 < 8; ++w8) { const f32x2 q = red[w8]; s1 += q[0]; s2 += q[1]; }
    const float mean = s1 * (1.0f / 512.0f), var = s2 * (1.0f / 512.0f) - mean * mean, rs = rsqrtf(var + 1e-5f);
    const float y = (c - mean) * rs * p.ln_g[ch] + p.ln_b[ch];
    PC[(size_t)r * DM + 512 + ch] = (bf16_t)(cvt_pk_bf16(silu_f(y), 0.f) & 0xffffu);
    __syncthreads();
}

__device__ __forceinline__ void wait_counters(unsigned* c0, unsigned t0, unsigned* c1, unsigned t1, unsigned* c2, unsigned t2) {
    if (threadIdx.x == 0) { unsigned sp = 0u;
        while (xb_ld(c0) < t0 || xb_ld(c1) < t1 || xb_ld(c2) < t2) { __builtin_amdgcn_s_sleep(1); if (++sp > (1u << 22)) break; }
        __builtin_amdgcn_fence(__ATOMIC_ACQUIRE, "agent"); asm volatile("s_waitcnt vmcnt(0)" ::: "memory"); }
    __syncthreads();
}
__device__ __forceinline__ void phase_mixer_pre(const Params& p, unsigned char* shm, const int gbase, int off, int len) {
    int tid = threadIdx.x; asm volatile("" : "+v"(tid));
    f32x2 w2[31];
    { const float* wp = p.dw_w + (tid & 255) * 2;
#pragma unroll
      for (int j = 0; j < 31; ++j) w2[j] = *(const f32x2*)(wp + j * 512); }
#pragma unroll 1
    while (len > 0) {
        const int take = (len >= 96 || len == 64) ? 64 : (len == 80 ? 48 : (len > 64 ? 32 : len)), r0 = gbase + off, t0 = r0 & (SEQ - 1);
        int tq = tid; asm volatile("" : "+v"(tq));
        if (take == 64) mixer_chunk<64>(p, shm, r0, t0, tq, w2); else if (take == 48) mixer_chunk<48>(p, shm, r0, t0, tq, w2); else mixer_chunk<32>(p, shm, r0, t0, tq, w2);
        off += take; len -= take;
    }
}

__global__ void __launch_bounds__(512, 2) hymba_fwd(Params p) {
    extern __shared__ __attribute__((aligned(16))) unsigned char shm[];
    LAS unsigned char* lds = (LAS unsigned char*)shm;
    const int G = gridDim.x, c = blockIdx.x;
    volatile LAS unsigned* st = (volatile LAS unsigned*)(lds + pg8::STAGE_BYTES);
    if (threadIdx.x == 0) { st[0] = 0u; st[1] = 0u; st[2] = 0u; st[3] = 0u; }
    __syncthreads();
    const XcdBarrier xb = xcd_barrier_post((unsigned*)(p.ws + WS_BAR), st);
    phase_prep(p, shm);
    xcd_barrier(xb);
    const bool uni = st[3] != 0u;
    const int gx = uni ? (int)xb.x : (c & 7), gl = uni ? (int)st[2] : (c >> 3);
    const int sidx = 32 * gx + gl;
    const int pm = 8 * gx + (gl & 7), pn = gl >> 3;
    const int n3 = gx < 2 ? 18 : 17;
    unsigned* cw = (unsigned*)(p.ws + WS_CNT);
    if (gl >= n3) {
        late_weight_prep(p, shm, (gx < 2 ? 14 * gx : 28 + 15 * (gx - 2)) + (gl - n3), 118);
        asm volatile("s_waitcnt vmcnt(0)" ::: "memory");
        __syncthreads();
        if (threadIdx.x == 0) { __builtin_amdgcn_fence(__ATOMIC_RELEASE, "agent"); asm volatile("s_waitcnt vmcnt(0)" ::: "memory"); (void)xb_add(cw + 64 * CW_LW, 1u); }
    }
    { SchedP1 S{(const char*)(p.ws + WS_XB), (const char*)(p.ws + WS_WIN), cw, gx, gl, uni};
      EpiP1 E{(bf16_t*)(p.ws + WS_U), (bf16_t*)(p.ws + WS_SGP), (bf16_t*)(p.ws + WS_V), (bf16_t*)(p.ws + WS_SGC), p.out};
      f32x4 acc[2][2][4][2]; pg8::gemm_phase(lds, DM, DM, S, E, acc); }
    if (uni) {
        const unsigned n_s8 = gx < 2 ? 16u : 8u;
        if (gl == 31) {
            wait_counters(cw + 64 * (CW_RV + gx), 384u, cw + 64 * (CW_SV + gx), n_s8, cw + 64 * (CW_SV + gx), n_s8);
            if (threadIdx.x == 0) { __builtin_amdgcn_fence(__ATOMIC_RELEASE, "agent"); asm volatile("s_waitcnt vmcnt(0)" ::: "memory"); (void)xb_add(cw + 64 * CW_GV, 1u); }
        }
        const bool halo = (gx & 1) && gl == n3;
        wait_counters(cw + 64 * (CW_RV + gx), 384u, cw + 64 * CW_GV, halo ? 8u : 0u, cw + 64 * CW_GV, 0u);
    } else xcd_barrier(xb);
    {
      const int E2 = 32 - n3; int off, len;
      if (!uni) { off = 64 * gl; len = 64; }
      else if (gl >= n3) { off = 96 * (gl - n3); len = 96; }
      else { const int remu = (2048 - 96 * E2) / 16, base = remu / n3, extra = remu % n3; off = 96 * E2 + 16 * (gl * base + (gl < extra ? gl : extra)); len = 16 * (base + (gl < extra ? 1 : 0)); }
      phase_mixer_pre(p, shm, 2048 * gx, off, len); }
    if (uni) wait_counters(cw + 64 * CW_GV, 8u, cw + 64 * CW_GV, 8u, cw + 64 * CW_GV, 8u);
    sample_token(p, shm, sidx);
    if (uni) { xcc_barrier(xb, [] {}); wait_counters(cw + 64 * CW_LW, 118u, cw + 64 * CW_LW, 118u, cw + 64 * CW_LW, 118u); } else xcd_barrier(xb);
    { SchedP3 S{(const char*)(p.ws + WS_PC), (const char*)(p.ws + WS_MIX), (const char*)(p.ws + WS_PW), pm, pn};
      EpiP3 E{(const bf16_t*)(p.ws + WS_SGP), (const bf16_t*)(p.ws + WS_SGC), p.pw_b, (bf16_t*)(p.ws + WS_Z)};
      f32x4 acc[2][2][4][2]; pg8::gemm_phase(lds, DM, 512, S, E, acc); }
    if (pn < 2) { sample_p3(p, shm, sidx); sample_p3(p, shm, sidx + 16); }
    { SchedP4 S{(const char*)(p.ws + WS_Z), (const char*)(p.ws + WS_WOUT), pm, pn};
      EpiP4 E{p.x_prompt, p.final_g, p.out, (float*)(p.ws + WS_XS), (unsigned*)(p.ws + WS_CNT), (const float*)(p.ws + WS_SS), NPROMPT + sidx, uni};
      f32x4 acc[2][2][4][2]; pg8::Unit u4; const bool has4 = S.next(0, u4);
      int tid4 = threadIdx.x; asm volatile("" : "+v"(tid4));
      const int wid4 = __builtin_amdgcn_readfirstlane(tid4 >> 6), lane4 = tid4 & 63;
      const auto hook = [&] { if (has4) E.init(acc, u4, wid4 >> 2, wid4 & 3, lane4 & 15, lane4 >> 4); };
      if (uni) xcc_barrier(xb, hook); else xcd_barrier(xb, hook);
      sample_p4(p, shm, sidx);
      pg8::gemm_phase(lds, DM, DM, S, E, acc); }
}

extern "C" void kernel_launch(void* const* d_in, const int* in_sizes, int n_in, void* d_out, int out_size, void* d_ws, size_t ws_size, hipStream_t stream) {
    constexpr int LDS_BYTES = pg8::STAGE_BYTES + 16;
    static int grid = 0;
    if (grid == 0) {
        if (n_in != 16 || ws_size < WS_END) { fprintf(stderr, "kernel_launch: unexpected inputs (n_in %d, ws %zu)\n", n_in, ws_size); grid = -1; return; }
        int dev = 0, cus = 0, per_cu = 0;
        (void)hipGetDevice(&dev); (void)hipDeviceGetAttribute(&cus, hipDeviceAttributeMultiprocessorCount, dev);
        if (hipFuncSetAttribute((const void*)hymba_fwd, hipFuncAttributeMaxDynamicSharedMemorySize, LDS_BYTES) != hipSuccess) { fprintf(stderr, "kernel_launch: hipFuncSetAttribute failed\n"); grid = -1; return; }
        if (hipOccupancyMaxActiveBlocksPerMultiprocessor(&per_cu, (const void*)hymba_fwd, 512, LDS_BYTES) != hipSuccess || per_cu < 1) { fprintf(stderr, "kernel_launch: occupancy query says %d\n", per_cu); per_cu = 1; (void)hipGetLastError(); }
        if (cus < 256) { fprintf(stderr, "kernel_launch: built for a 256-CU device (got %d CUs)\n", cus); grid = -1; return; }
        grid = 256;
    }
    if (grid < 0) return;
    if (hipMemsetAsync((char*)d_ws + WS_BAR, 0, WS_CTL_BYTES, stream) != hipSuccess) { fprintf(stderr, "kernel_launch: memset of the barrier words failed\n"); return; }
    Params p{};
    p.x_prompt = (const float*)d_in[0]; p.x_sample = (const float*)d_in[1]; p.cache_pool = (const float*)d_in[2]; p.cache_conv = (const float*)d_in[3];
    p.norm_g = (const float*)d_in[4]; p.w_in = (const float*)d_in[5]; p.pool_mix = (const float*)d_in[6]; p.pool_scale = (const float*)d_in[7];
    p.dw_w = (const float*)d_in[8]; p.dw_b = (const float*)d_in[9]; p.ln_g = (const float*)d_in[10]; p.ln_b = (const float*)d_in[11];
    p.pw_w = (const float*)d_in[12]; p.pw_b = (const float*)d_in[13]; p.w_out = (const float*)d_in[14]; p.final_g = (const float*)d_in[15];
    p.out = (float*)d_out; p.ws = (unsigned char*)d_ws;
    void* args[] = {&p};
    hipError_t e = hipLaunchCooperativeKernel((const void*)hymba_fwd, dim3(grid), dim3(512), args, LDS_BYTES, stream);
    if (e != hipSuccess) fprintf(stderr, "kernel_launch: cooperative launch failed: %s (grid %d)\n", hipGetErrorString(e), grid);
}
```

```cpp
#include <hip/hip_runtime.h>
#include <cstdio>

#define LAS __attribute__((address_space(3)))
typedef unsigned short bf16_t;
typedef short bf16x8 __attribute__((ext_vector_type(8)));
typedef float f32x4 __attribute__((ext_vector_type(4)));
typedef float f32x2 __attribute__((ext_vector_type(2)));
typedef unsigned u32x4 __attribute__((ext_vector_type(4)));
typedef unsigned u32x2 __attribute__((ext_vector_type(2)));

constexpr int DM = 1024, NPROMPT = 16384, NSAMP = 256, MT = NPROMPT + NSAMP, DIN = 2560, DH = 512;
constexpr int SEQ = 4096, DSEQ = 16;
constexpr size_t O_Y = 0;
constexpr size_t O_SPP = (size_t)MT * DM;
constexpr size_t O_SCP = O_SPP + 4 * 15 * 512;
constexpr size_t O_SPS = O_SCP + 4 * 30 * 512;
constexpr size_t O_SCS = O_SPS + 16 * 15 * 512;
constexpr size_t WS_XB = 0;
constexpr size_t WS_WIN = WS_XB + (size_t)MT * DM * 2;
constexpr size_t WS_MIX = WS_WIN + (size_t)DIN * DM * 2;
constexpr size_t WS_PW = WS_MIX + (size_t)512 * 512 * 2;
constexpr size_t WS_WOUT = WS_PW + (size_t)512 * 512 * 2;
constexpr size_t WS_U = WS_WOUT + (size_t)1024 * 1024 * 2;
constexpr size_t WS_SGP = WS_U + (size_t)MT * DH * 2;
constexpr size_t WS_V = WS_SGP + (size_t)MT * DH * 2;
constexpr size_t WS_SGC = WS_V + (size_t)MT * DH * 2;
constexpr size_t WS_PC = WS_SGC + (size_t)MT * DH * 2;
constexpr size_t WS_Z = WS_PC + (size_t)MT * DM * 2;
constexpr size_t WS_SS = WS_Z + (size_t)MT * DM * 2;
constexpr size_t WS_BAR = (WS_SS + (size_t)MT * 4 + 255) / 256 * 256;
constexpr size_t WS_CNT = WS_BAR + 4608 * 4;
constexpr size_t WS_CTL_BYTES = 4608 * 4 + 96 * 256;
constexpr int CW_PIECES = 64, CW_RV = 65  , CW_SV = 73  , CW_GV = 81  , CW_LW = 82  ;
constexpr size_t WS_XS = WS_CNT + 96 * 256;
constexpr size_t WS_END = WS_XS + (size_t)64 * 4 * 256 * 4;

struct Params {
    const float* x_prompt; const float* x_sample; const float* cache_pool; const float* cache_conv; const float* norm_g; const float* w_in;
    const float* pool_mix; const float* pool_scale; const float* dw_w; const float* dw_b; const float* ln_g; const float* ln_b;
    const float* pw_w; const float* pw_b; const float* w_out; const float* final_g;
    float* out; unsigned char* ws;
};

__device__ __forceinline__ unsigned cvt_pk_bf16(float lo, float hi) { unsigned r; asm volatile("v_cvt_pk_bf16_f32 %0, %1, %2" : "=v"(r) : "v"(lo), "v"(hi)); return r; }
__device__ __forceinline__ float bf_lo(unsigned u) { return __uint_as_float(u << 16); }
__device__ __forceinline__ float bf_hi(unsigned u) { return __uint_as_float(u & 0xffff0000u); }
__device__ __forceinline__ f32x2 bf_unpack(unsigned u) { return (f32x2){bf_lo(u), bf_hi(u)}; }
__device__ __forceinline__ float sigmoid_f(float x) { return __builtin_amdgcn_rcpf(1.0f + __expf(-x)); }
__device__ __forceinline__ float silu_f(float x) { return x * sigmoid_f(x); }
__device__ __forceinline__ u32x4 pack8(f32x4 a, f32x4 b) { return (u32x4){cvt_pk_bf16(a[0], a[1]), cvt_pk_bf16(a[2], a[3]), cvt_pk_bf16(b[0], b[1]), cvt_pk_bf16(b[2], b[3])}; }
__device__ __forceinline__ float wave_sum(float v) {
#pragma unroll
    for (int o = 32; o > 0; o >>= 1) v += __shfl_xor(v, o);
    return v;
}


#define XB_TMO      128
#define XB_XCNT(j)  (256  + 64 * (j))
#define XB_XSUB(j)  (1280 + 64 * (j))
#define XB_XGEN(j)  (2304 + 64 * (j))
#define XB_TOP      3328
#define XB_TOPGEN   3392
#define XB_XLOC(j)  (3520 + 64 * (j))
#define XCD_BAR_WORDS 4608
#define XB_SPIN_CAP (1u << 18)
__device__ __forceinline__ unsigned xb_ld(unsigned* p)              { return __hip_atomic_load(p, __ATOMIC_RELAXED, __HIP_MEMORY_SCOPE_AGENT); }
__device__ __forceinline__ unsigned xb_add(unsigned* p, unsigned v) { return __hip_atomic_fetch_add(p, v, __ATOMIC_RELAXED, __HIP_MEMORY_SCOPE_AGENT); }
__device__ __forceinline__ unsigned xb_xcc_id() { return (unsigned)__builtin_amdgcn_s_getreg((3 << 11) | 20) & 0xFu; }
#define XB_SPIN(cond, bar) do { unsigned _sp = 0; while (cond) { __builtin_amdgcn_s_sleep(1); \
    if ((++_sp & 255u) == 0u) { if (xb_ld(&(bar)[XB_TMO])) break; if (_sp > XB_SPIN_CAP) { atomicAdd(&(bar)[XB_TMO], 1u); break; } } } } while (0)
struct XcdBarrier { unsigned* bar; unsigned x; volatile LAS unsigned* st; };
__device__ __forceinline__ XcdBarrier xcd_barrier_post(unsigned* bar, volatile LAS unsigned* st) {
    XcdBarrier b; b.bar = bar; b.x = xb_xcc_id(); b.st = st;
    if (threadIdx.x == 0) st[2] = xb_add(&bar[XB_XCNT(b.x)], 1u);
    return b;
}
__device__ __forceinline__ void xcd_barrier_complete(unsigned* bar, unsigned x, unsigned& nloc, unsigned& nx, unsigned& uni) {
    const unsigned G = gridDim.x * gridDim.y * gridDim.z;
    unsigned sum, cnt, mine, sp = 0u;
    for (;;) {
        sum = 0u; cnt = 0u; mine = 0u; uni = 1u;
#pragma unroll
        for (unsigned j = 0; j < 16; ++j) { const unsigned c = xb_ld(&bar[XB_XCNT(j)]); sum += c; cnt += (c > 0u) ? 1u : 0u; mine = (j == x) ? c : mine; uni = (c == (j < 8 ? 32u : 0u)) ? uni : 0u; }
        if (sum == G) break;
        __builtin_amdgcn_s_sleep(1);
        if ((++sp & 255u) == 0u) { if (xb_ld(&bar[XB_TMO])) break; if (sp > XB_SPIN_CAP) { atomicAdd(&bar[XB_TMO], 1u); break; } }
    }
    nloc = mine > 0u ? mine : 1u; nx = cnt > 0u ? cnt : 1u; uni = (sum == G) ? uni : 0u;
}
template <class Hook>
__device__ __forceinline__ void xcd_barrier(const XcdBarrier& b, const Hook& hook) {
    asm volatile("s_waitcnt vmcnt(0)" ::: "memory");
    __syncthreads();
    if (threadIdx.x >= 64) hook();
    if (threadIdx.x == 0) {
        unsigned* bar = b.bar;
        __builtin_amdgcn_s_waitcnt(0);
        unsigned nloc = b.st[0], nx = b.st[1];
        if (nloc == 0u) { unsigned uni; xcd_barrier_complete(bar, b.x, nloc, nx, uni); b.st[0] = nloc; b.st[1] = nx; b.st[3] = uni; }
        const unsigned old = xb_add(&bar[XB_XSUB(b.x)], 1u);
        const unsigned gen = old / nloc;
        if (old + 1u == (gen + 1u) * nloc) {
            __builtin_amdgcn_fence(__ATOMIC_RELEASE, "agent");
            asm volatile("s_waitcnt vmcnt(0)" ::: "memory");
            const unsigned og = xb_add(&bar[XB_TOP], 1u);
            const unsigned tg = og / nx;
            if (og + 1u == (tg + 1u) * nx) xb_add(&bar[XB_TOPGEN], 1u);
            else XB_SPIN(xb_ld(&bar[XB_TOPGEN]) == tg, bar);
            __builtin_amdgcn_fence(__ATOMIC_ACQUIRE, "agent");
            xb_add(&bar[XB_XGEN(b.x)], 1u);
            asm volatile("s_waitcnt vmcnt(0)" ::: "memory");
        } else {
            XB_SPIN(xb_ld(&bar[XB_XGEN(b.x)]) == gen, bar);
            __builtin_amdgcn_fence(__ATOMIC_ACQUIRE, "agent");
            asm volatile("s_waitcnt vmcnt(0)" ::: "memory");
        }
    }
    if (threadIdx.x < 64) hook();
    __syncthreads();
}
__device__ __forceinline__ void xcd_barrier(const XcdBarrier& b) { xcd_barrier(b, [] {}); }
template <class Hook>
__device__ __forceinline__ void xcc_barrier(const XcdBarrier& b, const Hook& hook) {
    asm volatile("s_waitcnt vmcnt(0)" ::: "memory");
    __syncthreads();
    if (threadIdx.x >= 64) hook();
    if (threadIdx.x == 0) {
        unsigned* w = &b.bar[XB_XLOC(b.x)];
        __builtin_amdgcn_s_waitcnt(0);
        const unsigned old = xb_add(w, 1u), target = (old / 32u + 1u) * 32u;
        XB_SPIN(xb_ld(w) < target, b.bar);
        __builtin_amdgcn_fence(__ATOMIC_ACQUIRE, "agent");
        asm volatile("s_waitcnt vmcnt(0)" ::: "memory");
    }
    if (threadIdx.x < 64) hook();
    __syncthreads();
}

namespace pg8 {
constexpr int BM = 256, BK = 64, HALF = 128, HTB = HALF * BK * 2, STAGE_BYTES = 8 * HTB, NXCD = 8, WGM = 8;
__device__ __forceinline__ int lds_byte(int r, int c) { const int st = (r >> 4) * 2 + (c >> 5), rr = r & 15, cc = c & 31, ob = rr * 64 + cc * 2; return st * 1024 + (ob ^ (((ob >> 9) & 1) << 5)); }
__device__ __forceinline__ void stage_rc(int b, int& R, int& C) { const int st = b / 1024, sb = b % 1024, swz = sb ^ (((sb >> 9) & 1) << 5); R = (st >> 1) * 16 + swz / 64; C = (st & 1) * 32 + (swz % 64) / 2; }
__device__ __forceinline__ int perm32(int rho) { const int n = rho >> 4, i = rho & 15; return 8 * (i >> 2) + 4 * n + (i & 3); }

struct Unit { const char* A; const char* B; int pm, pn, nt, kind; };

__device__ __forceinline__ bool tile_order(int i, int G, int c, int nM, int nN, int& pm, int& pn) {
    const int nwg = nM * nN; const long L = (long)i * G + c; if (L >= nwg) return false;
    int wgid = (int)L; { const int q = nwg / NXCD, r = nwg % NXCD, xcd = wgid % NXCD, off = wgid / NXCD; wgid = (xcd < r ? xcd * (q + 1) : r * (q + 1) + (xcd - r) * q) + off; }
    const int nig = WGM * nN, gid = wgid / nig, fm = gid * WGM, gsz = (nM - fm) < WGM ? (nM - fm) : WGM;
    pm = fm + ((wgid % nig) % gsz); pn = (wgid % nig) / gsz; return true;
}

template <class Epi, class Sched>
__device__ __forceinline__ void gemm_phase(LAS unsigned char* lds, const int lda, const int ldb, const Sched& S, const Epi& E, f32x4 (&acc)[2][2][4][2]) {
    int tid_ = threadIdx.x; asm volatile("" : "+v"(tid_));
    const int tid = tid_, wid = __builtin_amdgcn_readfirstlane(tid >> 6), lane = tid & 63, wr = wid >> 2, wc = wid & 3, fr = lane & 15, fq = lane >> 4;
    unsigned voffA[2], voffB[2];
#pragma unroll
    for (int i = 0; i < 2; ++i) { int R, C; stage_rc(tid * 16 + i * 8192, R, C); const int Rb = Epi::PERM ? ((R & ~31) + perm32(R & 31)) : R;
        voffA[i] = (unsigned)(R * lda + C) * 2u; voffB[i] = (unsigned)(Rb * ldb + C) * 2u; }
    const size_t kstep = (size_t)(BK * 2);
    const size_t hstepA = (size_t)HALF * lda * 2, hstepB = (size_t)HALF * ldb * 2;
    const unsigned ldsw = (unsigned)wid * 1024u;
    const int aoff = lds_byte(wr * 64 + fr, fq * 8), boff = lds_byte(wc * 32 + fr, fq * 8);
#define PG8_SA(b, h) (((b) * 2 + (h)) * HTB)
#define PG8_SB(b, h) ((4 + (b) * 2 + (h)) * HTB)
#define PG8_STAGE(bufoff, gbase, voff) do { _Pragma("unroll") for (int _i = 0; _i < 2; ++_i) \
        __builtin_amdgcn_global_load_lds((const unsigned*)((const char*)(gbase) + (voff)[_i]), (LAS unsigned*)(lds + (bufoff) + ldsw + _i * 8192), 16, 0, 0); } while (0)
#define PG8_LDA(dst, b, h) do { _Pragma("unroll") for (int m = 0; m < 4; ++m) _Pragma("unroll") for (int k = 0; k < 2; ++k) dst[m][k] = *(const LAS bf16x8*)(lds + PG8_SA(b, h) + aoff + m * 2048 + k * 1024); } while (0)
#define PG8_LDB(dst, b, h) do { _Pragma("unroll") for (int n = 0; n < 2; ++n) _Pragma("unroll") for (int k = 0; k < 2; ++k) dst[n][k] = *(const LAS bf16x8*)(lds + PG8_SB(b, h) + boff + n * 2048 + k * 1024); } while (0)
#define PG8_MMA(ai, bj, At, Bt) do { __builtin_amdgcn_s_setprio(1); _Pragma("unroll") for (int m = 0; m < 4; ++m) _Pragma("unroll") for (int n = 0; n < 2; ++n) _Pragma("unroll") for (int k = 0; k < 2; ++k) \
        acc[ai][bj][m][n] = __builtin_amdgcn_mfma_f32_16x16x32_bf16(Bt[n][k], At[m][k], acc[ai][bj][m][n], 0, 0, 0); __builtin_amdgcn_s_setprio(0); } while (0)
#define PG8_WAIT_V(n) asm volatile("s_waitcnt vmcnt(" #n ")" ::: "memory")
#define PG8_WAIT_L(n) asm volatile("s_waitcnt lgkmcnt(" #n ")" ::: "memory")
#define PG8_BAR __builtin_amdgcn_s_barrier()
#define PG8_SCHED __builtin_amdgcn_sched_barrier(0)
    Unit cur, nxt; int ui = 0;
    if (!S.next(0, cur)) return;
    if constexpr (!Epi::EXT_INIT) E.init(acc, cur, wr, wc, fr, fq);
    bf16x8 At[4][2], B0[2][2], B1[2][2];
    const char* cA = cur.A; const char* cB = cur.B;
    PG8_STAGE(PG8_SB(0, 0), cB, voffB); PG8_STAGE(PG8_SA(0, 0), cA, voffA); PG8_STAGE(PG8_SB(0, 1), cB + hstepB, voffB); PG8_STAGE(PG8_SA(0, 1), cA + hstepA, voffA);
    if (wr == 1) PG8_BAR;
    PG8_WAIT_V(4); PG8_BAR;
    PG8_STAGE(PG8_SB(1, 0), cB + kstep, voffB); PG8_STAGE(PG8_SA(1, 0), cA + kstep, voffA); PG8_STAGE(PG8_SB(1, 1), cB + hstepB + kstep, voffB);
    PG8_WAIT_V(6); PG8_BAR;
    for (;;) {
        const bool has_next = S.next(ui + 1, nxt);
        const char* nA = has_next ? nxt.A : cA; const char* nB = has_next ? nxt.B : cB;
        const int nt = cur.nt;
        for (int t = 0; t < nt; t += 2) {
            const bool last = (t == nt - 2);
            const char* a1 = cA + (size_t)(t + 1) * kstep;
            const char* a2 = last ? nA : cA + (size_t)(t + 2) * kstep; const char* b2 = last ? nB : cB + (size_t)(t + 2) * kstep;
            const char* a3 = a2 + kstep; const char* b3 = b2 + kstep;
            bool m0 = true, m1 = true;
            if constexpr (Epi::ZSKIP) { if (cur.kind == 3) { m0 = t < 2; m1 = t >= 2; } }
            PG8_LDB(B0, 0, 0); PG8_SCHED; PG8_LDA(At, 0, 0); PG8_STAGE(PG8_SA(1, 1), a1 + hstepA, voffA);
            PG8_WAIT_L(8); PG8_BAR; PG8_WAIT_L(0); if (m0) PG8_MMA(0, 0, At, B0); PG8_BAR; PG8_SCHED;
            PG8_LDB(B1, 0, 1); PG8_STAGE(PG8_SB(0, 0), b2, voffB);
            PG8_BAR; PG8_WAIT_L(0); if (m1) PG8_MMA(0, 1, At, B1); PG8_BAR;
            PG8_LDA(At, 0, 1); PG8_STAGE(PG8_SA(0, 0), a2, voffA);
            PG8_BAR; PG8_WAIT_L(0); if (m0) PG8_MMA(1, 0, At, B0); PG8_BAR; PG8_SCHED;
            PG8_STAGE(PG8_SB(0, 1), b2 + hstepB, voffB);
            PG8_WAIT_V(6); PG8_BAR; if (m1) PG8_MMA(1, 1, At, B1); PG8_BAR;
            PG8_LDB(B0, 1, 0); PG8_SCHED; PG8_LDA(At, 1, 0); PG8_STAGE(PG8_SA(0, 1), a2 + hstepA, voffA);
            PG8_WAIT_L(8); PG8_BAR; PG8_WAIT_L(0); if (m0) PG8_MMA(0, 0, At, B0); PG8_BAR; PG8_SCHED;
            PG8_LDB(B1, 1, 1); PG8_STAGE(PG8_SB(1, 0), b3, voffB);
            PG8_BAR; PG8_WAIT_L(0); if (m1) PG8_MMA(0, 1, At, B1); PG8_BAR;
            PG8_LDA(At, 1, 1); PG8_STAGE(PG8_SA(1, 0), a3, voffA);
            PG8_BAR; PG8_WAIT_L(0); if (m0) PG8_MMA(1, 0, At, B0); PG8_BAR; PG8_SCHED;
            PG8_STAGE(PG8_SB(1, 1), b3 + hstepB, voffB);
            PG8_WAIT_V(6); PG8_BAR; if (m1) PG8_MMA(1, 1, At, B1); PG8_BAR;
        }
        if constexpr (!Epi::AFTER_DRAIN) { E(acc, cur, wr, wc, fr, fq); S.done(cur, ui, lane); }
        if (!has_next) break;
        cur = nxt; cA = nA; cB = nB; ++ui;
        E.init(acc, cur, wr, wc, fr, fq);
    }
    PG8_WAIT_V(0);
    if (wr == 0) PG8_BAR;
    PG8_BAR;
    if constexpr (Epi::AFTER_DRAIN) E.fused(acc, cur, wr, wc, fr, fq, lds, tid);
#undef PG8_SA
#undef PG8_SB
#undef PG8_STAGE
#undef PG8_LDA
#undef PG8_LDB
#undef PG8_MMA
#undef PG8_WAIT_V
#undef PG8_WAIT_L
#undef PG8_BAR
#undef PG8_SCHED
}
}

struct SchedP1 {
    const char* xb; const char* win; unsigned* cnt; int gx, gl; bool uni;
    __device__ __forceinline__ bool next(int i, pg8::Unit& u) const {
        const int n_s = gx < 2 ? 2 : 1, j = gl + 32 * i; if (j >= 80 + n_s) return false;
        int pm, pn, kind;
        if (j < n_s) { pm = NPROMPT / 256; pn = gx + 8 * j; kind = 2; }
        else if (j < n_s + 48) { const int k = j - n_s, q = k >> 3; pm = 8 * gx + (k & 7); pn = q < 2 ? q : q + 2; kind = 1; }
        else { const int k = j - n_s - 48, q = k >> 3; pm = 8 * gx + (k & 7); pn = q < 2 ? q + 2 : q + 6; kind = 0; }
        u.pm = pm; u.pn = pn; u.kind = kind; u.nt = 16; u.A = xb + (size_t)pm * 256 * DM * 2; u.B = win + (size_t)pn * 256 * DM * 2; return true;
    }
    __device__ __forceinline__ void done(const pg8::Unit&, int ui, int lane) const {
        if (!uni) return;
        const int n_s = gx < 2 ? 2 : 1, nuv = gl < n_s + 16 ? 2 : 1;
        if (ui != nuv - 1) return;
        asm volatile("s_waitcnt vmcnt(0)" ::: "memory");
        if (lane == 0) { const int sm = gl < n_s ? 1 : 0, uv = nuv - sm;
            (void)xb_add(cnt + 64 * (CW_RV + gx), (unsigned)uv);
            if (sm) (void)xb_add(cnt + 64 * (CW_SV + gx), 1u); }
    }
};
struct EpiP1 {
    static constexpr bool PERM = true, AFTER_DRAIN = false, EXT_INIT = false, ZSKIP = false;
    bf16_t* U; bf16_t* SGP; bf16_t* V; bf16_t* SGC; float* out;
    __device__ __forceinline__ void init(f32x4 (&acc)[2][2][4][2], const pg8::Unit&, int, int, int, int) const {
#pragma unroll
        for (int a = 0; a < 2; ++a)
#pragma unroll
            for (int b = 0; b < 2; ++b)
#pragma unroll
                for (int m = 0; m < 4; ++m)
#pragma unroll
                    for (int n = 0; n < 2; ++n) acc[a][b][m][n] = (f32x4){0.f, 0.f, 0.f, 0.f};
    }
    __device__ __forceinline__ void operator()(const f32x4 (&acc)[2][2][4][2], const pg8::Unit& u, int wr, int wc, int fr, int fq) const {
        const int pn = u.pn, row0 = u.pm * 256 + wr * 64 + fr, cl = wc * 32 + 8 * fq;
        if (pn < 2) {
#pragma unroll
            for (int ai = 0; ai < 2; ++ai)
#pragma unroll
                for (int m = 0; m < 4; ++m) {
                    const int r = row0 + ai * 128 + m * 16; bool st; size_t so;
                    if (r < NPROMPT) { const int t = r & (SEQ - 1); st = t >= SEQ - 15; so = O_SPP + ((size_t)(r >> 12) * 15 + (t - (SEQ - 15))) * 512; }
                    else { const int s = r - NPROMPT, t = s & 15; st = t >= 1; so = O_SPS + ((size_t)(s >> 4) * 15 + (t - 1)) * 512; }
#pragma unroll
                    for (int bj = 0; bj < 2; ++bj) { const int c = pn * 256 + bj * 128 + cl; const f32x4 v0 = acc[ai][bj][m][0], v1 = acc[ai][bj][m][1];
                        *(u32x4*)(U + (size_t)r * DH + c) = pack8(v0, v1);
                        if (st) { *(f32x4*)(out + so + c) = v0; *(f32x4*)(out + so + c + 4) = v1; } }
                }
        } else if (pn < 4 || pn >= 8) {
            bf16_t* dst = pn < 4 ? SGP : SGC; const int cb = (pn < 4 ? pn - 2 : pn - 8) * 256 + cl;
#pragma unroll
            for (int ai = 0; ai < 2; ++ai)
#pragma unroll
                for (int m = 0; m < 4; ++m) { const int r = row0 + ai * 128 + m * 16;
#pragma unroll
                    for (int bj = 0; bj < 2; ++bj) { f32x4 v0 = acc[ai][bj][m][0], v1 = acc[ai][bj][m][1];
#pragma unroll
                        for (int j = 0; j < 4; ++j) { v0[j] = silu_f(v0[j]); v1[j] = silu_f(v1[j]); }
                        *(u32x4*)(dst + (size_t)r * DH + cb + bj * 128) = pack8(v0, v1); }
                }
        } else {
            const int c = (pn - 4) * 128 + cl;
#pragma unroll
            for (int ai = 0; ai < 2; ++ai)
#pragma unroll
                for (int m = 0; m < 4; ++m) {
                    const int r = row0 + ai * 128 + m * 16; bool st; size_t so;
                    if (r < NPROMPT) { const int t = r & (SEQ - 1); st = t >= SEQ - 30; so = O_SCP + ((size_t)(r >> 12) * 30 + (t - (SEQ - 30))) * 512; }
                    else { const int s = r - NPROMPT, t = s & 15; st = true; so = O_SCS + ((size_t)(s >> 4) * 30 + 14 + t) * 512; }
                    f32x4 v0 = acc[ai][0][m][0], v1 = acc[ai][0][m][1]; const f32x4 g0 = acc[ai][1][m][0], g1 = acc[ai][1][m][1];
#pragma unroll
                    for (int j = 0; j < 4; ++j) { v0[j] *= sigmoid_f(g0[j]); v1[j] *= sigmoid_f(g1[j]); }
                    *(u32x4*)(V + (size_t)r * DH + c) = pack8(v0, v1);
                    if (st) { *(f32x4*)(out + so + c) = v0; *(f32x4*)(out + so + c + 4) = v1; }
                }
        }
    }
};

struct SchedP3 {
    const char* pc; const char* mix; const char* pw; int pm0, pn0;
    __device__ __forceinline__ void done(const pg8::Unit&, int, int) const {}
    __device__ __forceinline__ bool next(int i, pg8::Unit& u) const {
        if (i != 0) return false; const int pm = pm0, pn = pn0;
        u.pm = pm; u.pn = pn; u.kind = 0;
        if (pn < 2) { u.kind = 3; u.nt = 4; u.A = pc + ((size_t)pm * 256 * DM + 256 * pn) * 2; u.B = mix + ((size_t)pn * 256 * 512 + 256 * pn) * 2; }
        else { u.nt = 8; u.A = pc + ((size_t)pm * 256 * DM + 512) * 2; u.B = pw + (size_t)(pn - 2) * 256 * 512 * 2; }
        return true;
    }
};
struct EpiP3 {
    static constexpr bool PERM = true, AFTER_DRAIN = false, EXT_INIT = false, ZSKIP = true;
    const bf16_t* SGP; const bf16_t* SGC; const float* pw_b; bf16_t* Z;
    __device__ __forceinline__ void init(f32x4 (&acc)[2][2][4][2], const pg8::Unit&, int, int, int, int) const {
#pragma unroll
        for (int a = 0; a < 2; ++a)
#pragma unroll
            for (int b = 0; b < 2; ++b)
#pragma unroll
                for (int m = 0; m < 4; ++m)
#pragma unroll
                    for (int n = 0; n < 2; ++n) acc[a][b][m][n] = (f32x4){0.f, 0.f, 0.f, 0.f};
    }
    __device__ __forceinline__ void operator()(const f32x4 (&acc)[2][2][4][2], const pg8::Unit& u, int wr, int wc, int fr, int fq) const {
        const int pn = u.pn, row0 = u.pm * 256 + wr * 64 + fr, cl = wc * 32 + 8 * fq;
        const bool conv = pn >= 2; const bf16_t* gate = conv ? SGC : SGP; const int cb = (conv ? pn - 2 : pn) * 256 + cl;
        f32x4 bv[2][2];
#pragma unroll
        for (int bj = 0; bj < 2; ++bj)
#pragma unroll
            for (int n = 0; n < 2; ++n) bv[bj][n] = conv ? *(const f32x4*)(pw_b + cb + bj * 128 + 4 * n) : (f32x4){0.f, 0.f, 0.f, 0.f};
#pragma unroll
        for (int ai = 0; ai < 2; ++ai) {
            u32x4 gt[4][2];
#pragma unroll
            for (int m = 0; m < 4; ++m)
#pragma unroll
                for (int bj = 0; bj < 2; ++bj) gt[m][bj] = *(const u32x4*)(gate + (size_t)(row0 + ai * 128 + m * 16) * DH + cb + bj * 128);
#pragma unroll
            for (int m = 0; m < 4; ++m) { const int r = row0 + ai * 128 + m * 16;
#pragma unroll
                for (int bj = 0; bj < 2; ++bj) { const int c = cb + bj * 128; const u32x4 g = gt[m][bj];
                    f32x4 v0 = acc[ai][bj][m][0] + bv[bj][0], v1 = acc[ai][bj][m][1] + bv[bj][1];
                    v0[0] *= bf_lo(g[0]); v0[1] *= bf_hi(g[0]); v0[2] *= bf_lo(g[1]); v0[3] *= bf_hi(g[1]);
                    v1[0] *= bf_lo(g[2]); v1[1] *= bf_hi(g[2]); v1[2] *= bf_lo(g[3]); v1[3] *= bf_hi(g[3]);
                    *(u32x4*)(Z + (size_t)r * DM + (conv ? 512 : 0) + c) = pack8(v0, v1); }
            }
        }
    }
};

struct SchedP4 {
    const char* z; const char* wout; int pm0, pn0;
    __device__ __forceinline__ void done(const pg8::Unit&, int, int) const {}
    __device__ __forceinline__ bool next(int i, pg8::Unit& u) const {
        if (i != 0) return false; const int pm = pm0, pn = pn0;
        u.pm = pm; u.pn = pn; u.kind = 0; u.nt = 16; u.A = z + (size_t)pm * 256 * DM * 2; u.B = wout + (size_t)pn * 256 * DM * 2; return true;
    }
};
struct EpiP4 {
    static constexpr bool PERM = false, AFTER_DRAIN = true, EXT_INIT = true, ZSKIP = false;
    const float* x_prompt; const float* final_g; float* out; float* xs; unsigned* cnt; const float* ss; int srow; bool uni;
    __device__ __forceinline__ void init(f32x4 (&acc)[2][2][4][2], const pg8::Unit& u, int wr, int wc, int fr, int fq) const {
        const int row0 = u.pm * 256 + wr * 64 + fr, col0 = u.pn * 256 + wc * 32 + 4 * fq;
#pragma unroll
        for (int ai = 0; ai < 2; ++ai)
#pragma unroll
            for (int m = 0; m < 4; ++m) { const float* xr = x_prompt + (size_t)(row0 + ai * 128 + m * 16) * DM + col0;
#pragma unroll
                for (int bj = 0; bj < 2; ++bj)
#pragma unroll
                    for (int n = 0; n < 2; ++n) acc[ai][bj][m][n] = *(const f32x4*)(xr + bj * 128 + n * 16); }
    }
    __device__ __forceinline__ void fused(const f32x4 (&acc)[2][2][4][2], const pg8::Unit& u, int wr, int wc, int fr, int fq, LAS unsigned char* lds, int tid) const {
        LAS float* lss = (LAS float*)lds;
#pragma unroll
        for (int ai = 0; ai < 2; ++ai)
#pragma unroll
            for (int m = 0; m < 4; ++m) { float s = 0.f;
#pragma unroll
                for (int bj = 0; bj < 2; ++bj)
#pragma unroll
                    for (int n = 0; n < 2; ++n) { const f32x4 y = acc[ai][bj][m][n]; s += y[0] * y[0] + y[1] * y[1] + y[2] * y[2] + y[3] * y[3]; }
                s += __shfl_xor(s, 16); s += __shfl_xor(s, 32);
                if (fq == 0) lss[(ai * 128 + wr * 64 + m * 16 + fr) * 4 + wc] = s; }
        __syncthreads();
        if (tid < 256) { const f32x4 v = *(const LAS f32x4*)(lss + tid * 4); xs[((size_t)u.pm * 4 + u.pn) * 256 + tid] = v[0] + v[1] + v[2] + v[3]; }
        asm volatile("s_waitcnt vmcnt(0)" ::: "memory");
        __syncthreads();
        if (tid == 0) {
            unsigned* cw = cnt + 64 * u.pm; unsigned* cs = cnt + 64 * CW_PIECES;
            if (!uni) __builtin_amdgcn_fence(__ATOMIC_RELEASE, "agent");
            asm volatile("s_waitcnt vmcnt(0)" ::: "memory");
            (void)xb_add(cw, 1u);
            unsigned sp = 0u;
            while (xb_ld(cw) < 4u || xb_ld(cs) < 256u) { __builtin_amdgcn_s_sleep(1); if (++sp > (1u << 22)) break; }
            __builtin_amdgcn_fence(__ATOMIC_ACQUIRE, "agent");
            asm volatile("s_waitcnt vmcnt(0)" ::: "memory");
        }
        __syncthreads();
        if (tid >= 256) { const int t4 = (tid - 256) * 4; const float rs = rsqrtf(ss[srow] * (1.0f / DM) + 1e-6f); float* yr = out + (size_t)srow * DM + t4;
            *(f32x4*)yr = *(const f32x4*)yr * rs * *(const f32x4*)(final_g + t4); }
        if (tid < 256) { const float* xp = xs + (size_t)u.pm * 4 * 256 + tid; const float tot = xp[0] + xp[256] + xp[512] + xp[768];
            lss[1024 + tid] = rsqrtf(tot * (1.0f / DM) + 1e-6f); }
        __syncthreads();
        const int row0 = u.pm * 256 + wr * 64 + fr, col0 = u.pn * 256 + wc * 32 + 4 * fq;
        f32x4 g4[2][2];
#pragma unroll
        for (int bj = 0; bj < 2; ++bj)
#pragma unroll
            for (int n = 0; n < 2; ++n) g4[bj][n] = *(const f32x4*)(final_g + col0 + bj * 128 + n * 16);
#pragma unroll
        for (int ai = 0; ai < 2; ++ai)
#pragma unroll
            for (int m = 0; m < 4; ++m) { const float rs = lss[1024 + ai * 128 + wr * 64 + m * 16 + fr]; float* yr = out + (size_t)(row0 + ai * 128 + m * 16) * DM + col0;
#pragma unroll
                for (int bj = 0; bj < 2; ++bj)
#pragma unroll
                    for (int n = 0; n < 2; ++n) *(f32x4*)(yr + bj * 128 + n * 16) = acc[ai][bj][m][n] * rs * g4[bj][n]; }
    }
    __device__ __forceinline__ void operator()(const f32x4 (&)[2][2][4][2], const pg8::Unit&, int, int, int, int) const {}
};

template <int NF>
__device__ __forceinline__ f32x4 small_gemm(const bf16_t* __restrict__ A, int lda, const bf16_t* __restrict__ Bt, int ldb, int K, int nw, f32x4* red) {
    const int tid = threadIdx.x, wid = tid >> 6, lane = tid & 63, fr = lane & 15, fq = lane >> 4;
    f32x4 acc[NF];
#pragma unroll
    for (int f = 0; f < NF; ++f) acc[f] = (f32x4){0.f, 0.f, 0.f, 0.f};
    if (wid < nw) { const int ks = K / nw; const bf16_t* ap = A + (size_t)fr * lda + wid * ks + fq * 8; const bf16_t* bp = Bt + (size_t)fr * ldb + wid * ks + fq * 8;
        for (int k = 0; k < ks; k += 32) { const bf16x8 a = *(const bf16x8*)(ap + k);
#pragma unroll
            for (int f = 0; f < NF; ++f) { const bf16x8 b = *(const bf16x8*)(bp + (size_t)f * 16 * ldb + k); acc[f] = __builtin_amdgcn_mfma_f32_16x16x32_bf16(b, a, acc[f], 0, 0, 0); } } }
#pragma unroll
    for (int f = 0; f < NF; ++f) red[(wid * NF + f) * 64 + lane] = acc[f];
    __syncthreads();
    f32x4 r = (f32x4){0.f, 0.f, 0.f, 0.f};
    if (tid < 64 * NF) {
#pragma unroll
        for (int w = 0; w < 8; ++w) r += red[(w * NF + wid) * 64 + lane]; }
    return r;
}
__device__ __forceinline__ void sample_p3(const Params& p, unsigned char* shm, const int i) {
    const int tid = threadIdx.x, wid = tid >> 6, lane = tid & 63, fr = lane & 15, fq = lane >> 4; f32x4* red = (f32x4*)shm;
    const bf16_t* PC = (const bf16_t*)(p.ws + WS_PC); bf16_t* Z = (bf16_t*)(p.ws + WS_Z);
    { const int rb = i >> 4, cb = i & 15, row0 = NPROMPT + rb * 16, row = row0 + fr, c = 32 * cb + 16 * wid + 4 * fq;
        {
            const f32x4 r = small_gemm<2>(PC + (size_t)row0 * DM + 512, DM, (const bf16_t*)(p.ws + WS_PW) + (size_t)32 * cb * 512, 512, 512, 8, red);
            if (tid < 128) { const f32x4 bv = *(const f32x4*)(p.pw_b + c); const u32x2 g = *(const u32x2*)((const bf16_t*)(p.ws + WS_SGC) + (size_t)row * DH + c);
                const f32x4 z = (r + bv) * (f32x4){bf_lo(g[0]), bf_hi(g[0]), bf_lo(g[1]), bf_hi(g[1])};
                *(u32x2*)(Z + (size_t)row * DM + 512 + c) = (u32x2){cvt_pk_bf16(z[0], z[1]), cvt_pk_bf16(z[2], z[3])}; }
            __syncthreads();
        }
        {
            const int g128 = (cb >> 2) * 128;
            const f32x4 r = small_gemm<2>(PC + (size_t)row0 * DM + g128, DM, (const bf16_t*)(p.ws + WS_MIX) + (size_t)32 * cb * 512 + g128, 512, 128, 4, red);
            if (tid < 128) { const u32x2 g = *(const u32x2*)((const bf16_t*)(p.ws + WS_SGP) + (size_t)row * DH + c);
                const f32x4 z = r * (f32x4){bf_lo(g[0]), bf_hi(g[0]), bf_lo(g[1]), bf_hi(g[1])};
                *(u32x2*)(Z + (size_t)row * DM + c) = (u32x2){cvt_pk_bf16(z[0], z[1]), cvt_pk_bf16(z[2], z[3])}; }
            __syncthreads();
        }
    }
}
__device__ __forceinline__ void sample_p4(const Params& p, unsigned char* shm, const int i) {
    const int tid = threadIdx.x, wid = tid >> 6, lane = tid & 63, fr = lane & 15, fq = lane >> 4; f32x4* red = (f32x4*)shm;
    float* ss = (float*)(p.ws + WS_SS);
    { const int rb = i >> 4, cb = i & 15, row0 = NPROMPT + rb * 16, row = row0 + fr, c = 64 * cb + 16 * wid + 4 * fq;
        const f32x4 r = small_gemm<4>((const bf16_t*)(p.ws + WS_Z) + (size_t)row0 * DM, DM, (const bf16_t*)(p.ws + WS_WOUT) + (size_t)64 * cb * DM, DM, DM, 8, red);
        if (tid < 256) { const f32x4 y = r + *(const f32x4*)(p.x_sample + (size_t)(row - NPROMPT) * DM + c);
            *(f32x4*)(p.out + (size_t)row * DM + c) = y;
            float s = y[0] * y[0] + y[1] * y[1] + y[2] * y[2] + y[3] * y[3]; s += __shfl_xor(s, 16); s += __shfl_xor(s, 32);
            if (fq == 0) atomicAdd(ss + row, s); }
        asm volatile("s_waitcnt vmcnt(0)" ::: "memory");
        __syncthreads();
        if (tid == 0) { __builtin_amdgcn_fence(__ATOMIC_RELEASE, "agent"); asm volatile("s_waitcnt vmcnt(0)" ::: "memory"); (void)xb_add((unsigned*)(p.ws + WS_CNT) + 64 * CW_PIECES, 1u); }
    }
}
__device__ __forceinline__ void transpose_load(const float* __restrict__ src, int ldsrc, int k0, int n0s, f32x4 (&v)[2]) {
    const int tid = threadIdx.x, kk = tid >> 4, n4 = (tid & 15) * 4;
#pragma unroll
    for (int i = 0; i < 2; ++i) v[i] = *(const f32x4*)(src + (size_t)(k0 + kk + 32 * i) * ldsrc + n0s + n4);
}
__device__ __forceinline__ void transpose_store(const f32x4 (&v)[2], int k0, bf16_t* __restrict__ dst, int ldd, int n0d, float* tile) {
    const int tid = threadIdx.x;
    {
        const int kk = tid >> 4, n4 = (tid & 15) * 4;
#pragma unroll
        for (int i = 0; i < 2; ++i) { const int k = kk + 32 * i;
            tile[k * 65 + n4 + 0] = v[i][0]; tile[k * 65 + n4 + 1] = v[i][1]; tile[k * 65 + n4 + 2] = v[i][2]; tile[k * 65 + n4 + 3] = v[i][3]; }
    }
    __syncthreads();
    {
        const int n = tid >> 3, k8 = (tid & 7) * 8; float w[8];
#pragma unroll
        for (int j = 0; j < 8; ++j) w[j] = tile[(k8 + j) * 65 + n];
        *(u32x4*)(dst + (size_t)(n0d + n) * ldd + k0 + k8) = (u32x4){cvt_pk_bf16(w[0], w[1]), cvt_pk_bf16(w[2], w[3]), cvt_pk_bf16(w[4], w[5]), cvt_pk_bf16(w[6], w[7])};
    }
    __syncthreads();
}
__device__ __forceinline__ void transpose_tile(const float* __restrict__ src, int ldsrc, int k0, int n0s, bf16_t* __restrict__ dst, int ldd, int n0d, float* tile) {
    f32x4 v[2]; transpose_load(src, ldsrc, k0, n0s, v); transpose_store(v, k0, dst, ldd, n0d, tile);
}
__device__ __forceinline__ int win_src_col(int n0) {
    if (n0 >= 1024 && n0 < 2048) { const int q = n0 - 1024, j = q >> 8, i = q & 255; return i < 128 ? 1024 + 128 * j + i : 1536 + 128 * j + (i - 128); }
    return n0;
}

__device__ __forceinline__ void phase_prep(const Params& p, unsigned char* shm) {
    const int tid = threadIdx.x, wid = tid >> 6, lane = tid & 63, nb = gridDim.x, bid = blockIdx.x;
    bf16_t* xb = (bf16_t*)(p.ws + WS_XB);
    constexpr int T_IN = 16 * 40;
    f32x4 tv[3][2];
#pragma unroll
    for (int q = 0; q < 3; ++q) { const int t = bid + q * nb; if (t < T_IN) transpose_load(p.w_in, DIN, (t / 40) * 64, win_src_col((t % 40) * 64), tv[q]); }
    {
        f32x4 g4[4];
#pragma unroll
        for (int i = 0; i < 4; ++i) g4[i] = *(const f32x4*)(p.norm_g + lane * 4 + 256 * i);
        for (int g = bid * 8 + wid; g < MT / 4; g += nb * 8) {
            f32x4 v[4][4]; float s[4];
#pragma unroll
            for (int q = 0; q < 4; ++q) { const int r = g * 4 + q; const float* xr = r < NPROMPT ? p.x_prompt + (size_t)r * DM : p.x_sample + (size_t)(r - NPROMPT) * DM;
#pragma unroll
                for (int i = 0; i < 4; ++i) v[q][i] = *(const f32x4*)(xr + lane * 4 + 256 * i); }
#pragma unroll
            for (int q = 0; q < 4; ++q) { s[q] = 0.f;
#pragma unroll
                for (int i = 0; i < 4; ++i) s[q] += v[q][i][0] * v[q][i][0] + v[q][i][1] * v[q][i][1] + v[q][i][2] * v[q][i][2] + v[q][i][3] * v[q][i][3];
                s[q] = wave_sum(s[q]); }
#pragma unroll
            for (int q = 0; q < 4; ++q) { const int r = g * 4 + q; const float rs = rsqrtf(s[q] * (1.0f / DM) + 1e-6f);
#pragma unroll
                for (int i = 0; i < 4; ++i) { const f32x4 h = v[q][i] * rs * g4[i];
                    *(u32x2*)(xb + (size_t)r * DM + lane * 4 + 256 * i) = (u32x2){cvt_pk_bf16(h[0], h[1]), cvt_pk_bf16(h[2], h[3])}; } }
        }
    }
    {
        float* tile = (float*)shm; bf16_t* win = (bf16_t*)(p.ws + WS_WIN);
#pragma unroll
        for (int q = 0; q < 3; ++q) { const int t = bid + q * nb; if (t < T_IN) transpose_store(tv[q], (t / 40) * 64, win, DM, (t % 40) * 64, tile); }
        for (int t = bid + 3 * nb; t < T_IN; t += nb) transpose_tile(p.w_in, DIN, (t / 40) * 64, win_src_col((t % 40) * 64), win, DM, (t % 40) * 64, tile);
    }
    float* ss = (float*)(p.ws + WS_SS);
    for (int i = bid * 512 + tid; i < MT; i += nb * 512) ss[i] = 0.f;
    for (int i = bid * 512 + tid; i < 16 * 14 * 128; i += nb * 512) { const int c4 = i & 127, rr = i >> 7, b = rr / 14, j = rr % 14;
        *(f32x4*)(p.out + O_SCS + ((size_t)b * 30 + j) * 512 + c4 * 4) = *(const f32x4*)(p.cache_conv + ((size_t)b * 30 + 16 + j) * 512 + c4 * 4); }
}

__device__ __forceinline__ void late_weight_prep(const Params& p, unsigned char* shm, const int bid, const int nb) {
    const int tid = threadIdx.x; float* tile = (float*)shm;
    bf16_t* pw = (bf16_t*)(p.ws + WS_PW); bf16_t* wout = (bf16_t*)(p.ws + WS_WOUT); bf16_t* mix = (bf16_t*)(p.ws + WS_MIX);
    constexpr int T_OUT = 16 * 16, T_PW = 8 * 8;
    for (int t = bid; t < T_OUT + T_PW; t += nb) {
        if (t < T_OUT) transpose_tile(p.w_out, DM, (t >> 4) * 64, (t & 15) * 64, wout, DM, (t & 15) * 64, tile);
        else { const int tt = t - T_OUT; transpose_tile(p.pw_w, 512, (tt >> 3) * 64, (tt & 7) * 64, pw, 512, (tt & 7) * 64, tile); }
    }
    for (int idx = bid * 512 + tid; idx < 512 * 512; idx += nb * 512) { const int n = idx >> 9, k = idx & 511; float v = 0.f;
        if ((n >> 7) == (k >> 7)) v = p.pool_mix[((size_t)(n >> 7) * 128 + (k & 127)) * 128 + (n & 127)] * p.pool_scale[n];
        mix[idx] = (bf16_t)(cvt_pk_bf16(v, 0.f) & 0xffffu); }
    __syncthreads();
}

#define DPP_STEP(v, ctrl) ((v) + __builtin_bit_cast(float, __builtin_amdgcn_update_dpp(0, __builtin_bit_cast(int, (v)), (ctrl), 0xf, 0xf, true)))
__device__ __forceinline__ float wave_sum_hi(float v) {
    v = DPP_STEP(v, 0xB1);
    v = DPP_STEP(v, 0x4E);
    v = DPP_STEP(v, 0x141);
    v = DPP_STEP(v, 0x140);
    v += __builtin_bit_cast(float, __builtin_amdgcn_update_dpp(0, __builtin_bit_cast(int, v), 0x142, 0xa, 0xf, false));
    v += __builtin_bit_cast(float, __builtin_amdgcn_update_dpp(0, __builtin_bit_cast(int, v), 0x143, 0xc, 0xf, false));
    return v;
}
#define RED16_STEP(CTRL) _Pragma("unroll") for (int k = 0; k < 16; ++k) asm volatile("v_add_f32_dpp %0, %0, %0 " CTRL : "+v"(r[k]))
__device__ __forceinline__ void wave_sum16_hi(float (&r)[16]) {
    asm volatile("s_nop 1" ::: "memory");
    RED16_STEP("quad_perm:[1,0,3,2] row_mask:0xf bank_mask:0xf");
    RED16_STEP("quad_perm:[2,3,0,1] row_mask:0xf bank_mask:0xf");
    RED16_STEP("row_half_mirror row_mask:0xf bank_mask:0xf");
    RED16_STEP("row_mirror row_mask:0xf bank_mask:0xf");
    RED16_STEP("row_bcast:15 row_mask:0xa bank_mask:0xf");
    RED16_STEP("row_bcast:31 row_mask:0xc bank_mask:0xf");
}
template <int W, int TH>
__device__ __forceinline__ void pool_regs(const unsigned (&u)[TH + 15], const int pos0, bf16_t* __restrict__ dst  ) {
    f32x2 s = (f32x2){0.f, 0.f};
#pragma unroll
    for (int j = 0; j < W; ++j) s += bf_unpack(u[15 - j]);
#pragma unroll
    for (int i = 0; i < TH; ++i) { const f32x2 cur = bf_unpack(u[15 + i]); const int pos1 = pos0 + i + 1;
        const float inv = pos1 >= W ? (1.0f / W) : __builtin_amdgcn_rcpf((float)pos1);
        const f32x2 o = s * inv - cur;
        *(unsigned*)(dst + (size_t)i * DM) = cvt_pk_bf16(o[0], o[1]);
        if (i + 1 < TH) s += bf_unpack(u[16 + i]) - bf_unpack(u[16 + i - W]); }
}
template <int T>
__device__ __forceinline__ void mixer_chunk(const Params& p, unsigned char* shm, const int r0, const int t0, const int tid, const f32x2 (&w2)[31]) {
    constexpr int TH = T / 2, ROUNDS = T / 16, NV = ((T + 30) * 64 + 511) / 512;
    const int cp = tid & 255, th = tid >> 8, lane = tid & 63, wv = (tid >> 6) & 3;
    const bf16_t* U = (const bf16_t*)(p.ws + WS_U); const bf16_t* V = (const bf16_t*)(p.ws + WS_V); bf16_t* PC = (bf16_t*)(p.ws + WS_PC);
    const unsigned* l32 = (const unsigned*)shm;
    u32x4 val[NV];
    {
        const bf16_t* vb = V + (size_t)(r0 - 30) * DH;
#pragma unroll
        for (int k = 0; k < NV; ++k) { const int idx = tid + k * 512, lr = idx >> 6; val[k] = (u32x4){0u, 0u, 0u, 0u};
            if (idx < (T + 30) * 64 && t0 - 30 + lr >= 0) val[k] = *(const u32x4*)(vb + (size_t)idx * 8); }
    }
    unsigned u[TH + 15];
    {
        const int f0 = th * TH - 15; const bf16_t* ub = U + (size_t)(r0 + f0) * DH + cp * 2;
#pragma unroll
        for (int k = 0; k < TH + 15; ++k) { u[k] = 0u; if (t0 + f0 + k >= 0) u[k] = *(const unsigned*)(ub + (size_t)k * DH); }
    }
#pragma unroll
    for (int k = 0; k < NV; ++k) { const int idx = tid + k * 512; if (idx < (T + 30) * 64) *(u32x4*)(shm + (size_t)idx * 16) = val[k]; }
    const f32x2 bias = *(const f32x2*)(p.dw_b + cp * 2);
    const f32x2 g2 = *(const f32x2*)(p.ln_g + cp * 2), b2 = *(const f32x2*)(p.ln_b + cp * 2);
    __syncthreads();
    {
        bf16_t* dst = PC + (size_t)(r0 + th * TH) * DM + cp * 2; const int pos0 = t0 + th * TH;
        switch (cp >> 6) { case 0: pool_regs<2, TH>(u, pos0, dst); break; case 1: pool_regs<4, TH>(u, pos0, dst); break; case 2: pool_regs<8, TH>(u, pos0, dst); break; default: pool_regs<16, TH>(u, pos0, dst); break; }
    }
    f32x2* stats = (f32x2*)(shm + (T + 30) * 1024);
#pragma unroll 1
    for (int rd = 0; rd < ROUNDS; ++rd) {
        const int tt = rd * 16 + th * 8;
        f32x2 c[8];
#pragma unroll
        for (int i = 0; i < 8; ++i) c[i] = bias;
        unsigned win[38];
#pragma unroll
        for (int q = 0; q < 38; ++q) win[q] = l32[(tt + q) * 256 + cp];
#pragma unroll
        for (int q = 0; q < 38; ++q) { const f32x2 v = bf_unpack(win[q]);
#pragma unroll
            for (int i = 0; i < 8; ++i) if (q - i >= 0 && q - i < 31) c[i] += w2[q - i] * v;
            asm volatile("" : "+v"(c[0]), "+v"(c[1]), "+v"(c[2]), "+v"(c[3]), "+v"(c[4]), "+v"(c[5]), "+v"(c[6]), "+v"(c[7])); }
        { float r[16];
#pragma unroll
          for (int i = 0; i < 8; ++i) { r[2 * i] = c[i][0] + c[i][1]; r[2 * i + 1] = c[i][0] * c[i][0] + c[i][1] * c[i][1]; }
          wave_sum16_hi(r);
#pragma unroll
          for (int i = 0; i < 8; ++i) if (lane == 63) stats[(tt + i) * 4 + wv] = (f32x2){r[2 * i], r[2 * i + 1]}; }
        __syncthreads();
        float mean_l, rs_l;
        { const int ti = tt + (lane & 7);
          const f32x4 sa = *(const f32x4*)(stats + ti * 4), sb = *(const f32x4*)(stats + ti * 4 + 2);
          mean_l = (sa[0] + sa[2] + sb[0] + sb[2]) * (1.0f / 512.0f);
          const float var = (sa[1] + sa[3] + sb[1] + sb[3]) * (1.0f / 512.0f) - mean_l * mean_l;
          rs_l = __builtin_amdgcn_rsqf(var + 1e-5f); }
#pragma unroll
        for (int i = 0; i < 8; ++i) {
            const float mean = __builtin_bit_cast(float, __builtin_amdgcn_readlane(__builtin_bit_cast(int, mean_l), i));
            const float rs = __builtin_bit_cast(float, __builtin_amdgcn_readlane(__builtin_bit_cast(int, rs_l), i));
            const f32x2 y = (c[i] - mean) * rs * g2 + b2;
            *(unsigned*)(PC + (size_t)(r0 + tt + i) * DM + 512 + cp * 2) = cvt_pk_bf16(silu_f(y[0]), silu_f(y[1])); }
    }
    __syncthreads();
}

__device__ __forceinline__ void sample_token(const Params& p, unsigned char* shm, const int s) {
    const int tid = threadIdx.x, wid = tid >> 6, lane = tid & 63, b = s >> 4, t = s & 15, r = NPROMPT + s, ch = tid;
    const bf16_t* U = (const bf16_t*)(p.ws + WS_U); const bf16_t* V = (const bf16_t*)(p.ws + WS_V); bf16_t* PC = (bf16_t*)(p.ws + WS_PC);
    {
        const int w = 2 << (ch >> 7); float sum = 0.f, cur = 0.f;
#pragma unroll
        for (int j = 0; j < 16; ++j) if (j < w) { const int e = t + 15 - j;
            const float v = e < 15 ? p.cache_pool[((size_t)b * 15 + e) * 512 + ch] : __uint_as_float((unsigned)U[(size_t)(NPROMPT + b * 16 + e - 15) * DH + ch] << 16);
            sum += v; if (j == 0) cur = v; }
        const float o = sum / (float)w - cur;
        PC[(size_t)r * DM + ch] = (bf16_t)(cvt_pk_bf16(o, 0.f) & 0xffffu);
    }
    float c = p.dw_b[ch];
#pragma unroll
    for (int j = 0; j < 31; ++j) { const int e = t + j;
        const float v = e < 30 ? p.cache_conv[((size_t)b * 30 + e) * 512 + ch] : __uint_as_float((unsigned)V[(size_t)(NPROMPT + b * 16 + e - 30) * DH + ch] << 16);
        c += p.dw_w[j * 512 + ch] * v; }
    float s1 = wave_sum(c), s2 = wave_sum(c * c);
    f32x2* red = (f32x2*)shm;
    if (lane == 0) red[wid] = (f32x2){s1, s2};
    __syncthreads();
    s1 = 0.f; s2 = 0.f;
#pragma unroll
    for (int w8 = 0; w8 < 8; ++w8) { const f32x2 q = red[w8]; s1 += q[0]; s2 += q[1]; }
    const float mean = s1 * (1.0f / 512.0f), var = s2 * (1.0f / 512.0f) - mean * mean, rs = rsqrtf(var + 1e-5f);
    const float y = (c - mean) * rs * p.ln_g[ch] + p.ln_b[ch];
    PC[(size_t)r * DM + 512 + ch] = (bf16_t)(cvt_pk_bf16(silu_f(y), 0.f) & 0xffffu);
    __syncthreads();
}

__device__ __forceinline__ void wait_counters(unsigned* c0, unsigned t0, unsigned* c1, unsigned t1, unsigned* c2, unsigned t2) {
    if (threadIdx.x == 0) { unsigned sp = 0u;
        while (xb_ld(c0) < t0 || xb_ld(c1) < t1 || xb_ld(c2) < t2) { __builtin_amdgcn_s_sleep(1); if (++sp > (1u << 22)) break; }
        __builtin_amdgcn_fence(__ATOMIC_ACQUIRE, "agent"); asm volatile("s_waitcnt vmcnt(0)" ::: "memory"); }
    __syncthreads();
}
__device__ __forceinline__ void phase_mixer_pre(const Params& p, unsigned char* shm, const int gbase, int off, int len) {
    int tid = threadIdx.x; asm volatile("" : "+v"(tid));
    f32x2 w2[31];
    { const float* wp = p.dw_w + (tid & 255) * 2;
#pragma unroll
      for (int j = 0; j < 31; ++j) w2[j] = *(const f32x2*)(wp + j * 512); }
#pragma unroll 1
    while (len > 0) {
        const int take = (len >= 96 || len == 64) ? 64 : (len == 80 ? 48 : (len > 64 ? 32 : len)), r0 = gbase + off, t0 = r0 & (SEQ - 1);
        int tq = tid; asm volatile("" : "+v"(tq));
        if (take == 64) mixer_chunk<64>(p, shm, r0, t0, tq, w2); else if (take == 48) mixer_chunk<48>(p, shm, r0, t0, tq, w2); else mixer_chunk<32>(p, shm, r0, t0, tq, w2);
        off += take; len -= take;
    }
}

__global__ void __launch_bounds__(512, 2) hymba_fwd(Params p) {
    extern __shared__ __attribute__((aligned(16))) unsigned char shm[];
    LAS unsigned char* lds = (LAS unsigned char*)shm;
    const int G = gridDim.x, c = blockIdx.x;
    volatile LAS unsigned* st = (volatile LAS unsigned*)(lds + pg8::STAGE_BYTES);
    if (threadIdx.x == 0) { st[0] = 0u; st[1] = 0u; st[2] = 0u; st[3] = 0u; }
    __syncthreads();
    const XcdBarrier xb = xcd_barrier_post((unsigned*)(p.ws + WS_BAR), st);
    phase_prep(p, shm);
    xcd_barrier(xb);
    const bool uni = st[3] != 0u;
    const int gx = uni ? (int)xb.x : (c & 7), gl = uni ? (int)st[2] : (c >> 3);
    const int sidx = 32 * gx + gl;
    const int pm = 8 * gx + (gl & 7), pn = gl >> 3;
    const int n3 = gx < 2 ? 18 : 17;
    unsigned* cw = (unsigned*)(p.ws + WS_CNT);
    if (gl >= n3) {
        late_weight_prep(p, shm, (gx < 2 ? 14 * gx : 28 + 15 * (gx - 2)) + (gl - n3), 118);
        asm volatile("s_waitcnt vmcnt(0)" ::: "memory");
        __syncthreads();
        if (threadIdx.x == 0) { __builtin_amdgcn_fence(__ATOMIC_RELEASE, "agent"); asm volatile("s_waitcnt vmcnt(0)" ::: "memory"); (void)xb_add(cw + 64 * CW_LW, 1u); }
    }
    { SchedP1 S{(const char*)(p.ws + WS_XB), (const char*)(p.ws + WS_WIN), cw, gx, gl, uni};
      EpiP1 E{(bf16_t*)(p.ws + WS_U), (bf16_t*)(p.ws + WS_SGP), (bf16_t*)(p.ws + WS_V), (bf16_t*)(p.ws + WS_SGC), p.out};
      f32x4 acc[2][2][4][2]; pg8::gemm_phase(lds, DM, DM, S, E, acc); }
    if (uni) {
        const unsigned n_s8 = gx < 2 ? 16u : 8u;
        if (gl == 31) {
            wait_counters(cw + 64 * (CW_RV + gx), 384u, cw + 64 * (CW_SV + gx), n_s8, cw + 64 * (CW_SV + gx), n_s8);
            if (threadIdx.x == 0) { __builtin_amdgcn_fence(__ATOMIC_RELEASE, "agent"); asm volatile("s_waitcnt vmcnt(0)" ::: "memory"); (void)xb_add(cw + 64 * CW_GV, 1u); }
        }
        const bool halo = (gx & 1) && gl == n3;
        wait_counters(cw + 64 * (CW_RV + gx), 384u, cw + 64 * CW_GV, halo ? 8u : 0u, cw + 64 * CW_GV, 0u);
    } else xcd_barrier(xb);
    {
      const int E2 = 32 - n3; int off, len;
      if (!uni) { off = 64 * gl; len = 64; }
      else if (gl >= n3) { off = 96 * (gl - n3); len = 96; }
      else { const int remu = (2048 - 96 * E2) / 16, base = remu / n3, extra = remu % n3; off = 96 * E2 + 16 * (gl * base + (gl < extra ? gl : extra)); len = 16 * (base + (gl < extra ? 1 : 0)); }
      phase_mixer_pre(p, shm, 2048 * gx, off, len); }
    if (uni) wait_counters(cw + 64 * CW_GV, 8u, cw + 64 * CW_GV, 8u, cw + 64 * CW_GV, 8u);
    sample_token(p, shm, sidx);
    if (uni) { xcc_barrier(xb, [] {}); wait_counters(cw + 64 * CW_LW, 118u, cw + 64 * CW_LW, 118u, cw + 64 * CW_LW, 118u); } else xcd_barrier(xb);
    { SchedP3 S{(const char*)(p.ws + WS_PC), (const char*)(p.ws + WS_MIX), (const char*)(p.ws + WS_PW), pm, pn};
      EpiP3 E{(const bf16_t*)(p.ws + WS_SGP), (const bf16_t*)(p.ws + WS_SGC), p.pw_b, (bf16_t*)(p.ws + WS_Z)};
      f32x4 acc[2][2][4][2]; pg8::gemm_phase(lds, DM, 512, S, E, acc); }
    if (pn < 2) { sample_p3(p, shm, sidx); sample_p3(p, shm, sidx + 16); }
    { SchedP4 S{(const char*)(p.ws + WS_Z), (const char*)(p.ws + WS_WOUT), pm, pn};
      EpiP4 E{p.x_prompt, p.final_g, p.out, (float*)(p.ws + WS_XS), (unsigned*)(p.ws + WS_CNT), (const float*)(p.ws + WS_SS), NPROMPT + sidx, uni};
      f32x4 acc[2][2][4][2]; pg8::Unit u4; const bool has4 = S.next(0, u4);
      int tid4 = threadIdx.x; asm volatile("" : "+v"(tid4));
      const int wid4 = __builtin_amdgcn_readfirstlane(tid4 >> 6), lane4 = tid4 & 63;
      const auto hook = [&] { if (has4) E.init(acc, u4, wid4 >> 2, wid4 & 3, lane4 & 15, lane4 >> 4); };
      if (uni) xcc_barrier(xb, hook); else xcd_barrier(xb, hook);
      sample_p4(p, shm, sidx);
      pg8::gemm_phase(lds, DM, DM, S, E, acc); }
}

extern "C" void kernel_launch(void* const* d_in, const int* in_sizes, int n_in, void* d_out, int out_size, void* d_ws, size_t ws_size, hipStream_t stream) {
    constexpr int LDS_BYTES = pg8::STAGE_BYTES + 16;
    static int grid = 0;
    if (grid == 0) {
        if (n_in != 16 || ws_size < WS_END) { fprintf(stderr, "kernel_launch: unexpected inputs (n_in %d, ws %zu)\n", n_in, ws_size); grid = -1; return; }
        int dev = 0, cus = 0, per_cu = 0;
        (void)hipGetDevice(&dev); (void)hipDeviceGetAttribute(&cus, hipDeviceAttributeMultiprocessorCount, dev);
        if (hipFuncSetAttribute((const void*)hymba_fwd, hipFuncAttributeMaxDynamicSharedMemorySize, LDS_BYTES) != hipSuccess) { fprintf(stderr, "kernel_launch: hipFuncSetAttribute failed\n"); grid = -1; return; }
        if (hipOccupancyMaxActiveBlocksPerMultiprocessor(&per_cu, (const void*)hymba_fwd, 512, LDS_BYTES) != hipSuccess || per_cu < 1) { fprintf(stderr, "kernel_launch: occupancy query says %d\n", per_cu); per_cu = 1; (void)hipGetLastError(); }
        if (cus < 256) { fprintf(stderr, "kernel_launch: built for a 256-CU device (got %d CUs)\n", cus); grid = -1; return; }
        grid = 256;
    }
    if (grid < 0) return;
    if (hipMemsetAsync((char*)d_ws + WS_BAR, 0, WS_CTL_BYTES, stream) != hipSuccess) { fprintf(stderr, "kernel_launch: memset of the barrier words failed\n"); return; }
    Params p{};
    p.x_prompt = (const float*)d_in[0]; p.x_sample = (const float*)d_in[1]; p.cache_pool = (const float*)d_in[2]; p.cache_conv = (const float*)d_in[3];
    p.norm_g = (const float*)d_in[4]; p.w_in = (const float*)d_in[5]; p.pool_mix = (const float*)d_in[6]; p.pool_scale = (const float*)d_in[7];
    p.dw_w = (const float*)d_in[8]; p.dw_b = (const float*)d_in[9]; p.ln_g = (const float*)d_in[10]; p.ln_b = (const float*)d_in[11];
    p.pw_w = (const float*)d_in[12]; p.pw_b = (const float*)d_in[13]; p.w_out = (const float*)d_in[14]; p.final_g = (const float*)d_in[15];
    p.out = (float*)d_out; p.ws = (unsigned char*)d_ws;
    void* args[] = {&p};
    hipError_t e = hipLaunchCooperativeKernel((const void*)hymba_fwd, dim3(grid), dim3(512), args, LDS_BYTES, stream);
    if (e != hipSuccess) fprintf(stderr, "kernel_launch: cooperative launch failed: %s (grid %d)\n", hipGetErrorString(e), grid);
}
```

```cpp
#include <hip/hip_runtime.h>
#include <cstdio>

#define LAS __attribute__((address_space(3)))
typedef unsigned short bf16_t;
typedef short bf16x8 __attribute__((ext_vector_type(8)));
typedef float f32x4 __attribute__((ext_vector_type(4)));
typedef float f32x2 __attribute__((ext_vector_type(2)));
typedef unsigned u32x4 __attribute__((ext_vector_type(4)));
typedef unsigned u32x2 __attribute__((ext_vector_type(2)));

constexpr int DM = 1024, NPROMPT = 16384, NSAMP = 256, MT = NPROMPT + NSAMP, DIN = 2560, DH = 512;
constexpr int SEQ = 4096, DSEQ = 16;
constexpr size_t O_Y = 0;
constexpr size_t O_SPP = (size_t)MT * DM;
constexpr size_t O_SCP = O_SPP + 4 * 15 * 512;
constexpr size_t O_SPS = O_SCP + 4 * 30 * 512;
constexpr size_t O_SCS = O_SPS + 16 * 15 * 512;
constexpr size_t WS_XB = 0;
constexpr size_t WS_WIN = WS_XB + (size_t)MT * DM * 2;
constexpr size_t WS_MIX = WS_WIN + (size_t)DIN * DM * 2;
constexpr size_t WS_PW = WS_MIX + (size_t)512 * 512 * 2;
constexpr size_t WS_WOUT = WS_PW + (size_t)512 * 512 * 2;
constexpr size_t WS_U = WS_WOUT + (size_t)1024 * 1024 * 2;
constexpr size_t WS_SGP = WS_U + (size_t)MT * DH * 2;
constexpr size_t WS_V = WS_SGP + (size_t)MT * DH * 2;
constexpr size_t WS_SGC = WS_V + (size_t)MT * DH * 2;
constexpr size_t WS_PC = WS_SGC + (size_t)MT * DH * 2;
constexpr size_t WS_Z = WS_PC + (size_t)MT * DM * 2;
constexpr size_t WS_SS = WS_Z + (size_t)MT * DM * 2;
constexpr size_t WS_BAR = (WS_SS + (size_t)MT * 4 + 255) / 256 * 256;
constexpr size_t WS_CNT = WS_BAR + 4608 * 4;
constexpr size_t WS_CTL_BYTES = 4608 * 4 + 96 * 256;
constexpr int CW_PIECES = 64, CW_RV = 65  , CW_SV = 73  , CW_GV = 81  , CW_LW = 82  ;
constexpr size_t WS_XS = WS_CNT + 96 * 256;
constexpr size_t WS_END = WS_XS + (size_t)64 * 4 * 256 * 4;

struct Params {
    const float* x_prompt; const float* x_sample; const float* cache_pool; const float* cache_conv; const float* norm_g; const float* w_in;
    const float* pool_mix; const float* pool_scale; const float* dw_w; const float* dw_b; const float* ln_g; const float* ln_b;
    const float* pw_w; const float* pw_b; const float* w_out; const float* final_g;
    float* out; unsigned char* ws;
};

__device__ __forceinline__ unsigned cvt_pk_bf16(float lo, float hi) { unsigned r; asm volatile("v_cvt_pk_bf16_f32 %0, %1, %2" : "=v"(r) : "v"(lo), "v"(hi)); return r; }
__device__ __forceinline__ float bf_lo(unsigned u) { return __uint_as_float(u << 16); }
__device__ __forceinline__ float bf_hi(unsigned u) { return __uint_as_float(u & 0xffff0000u); }
__device__ __forceinline__ f32x2 bf_unpack(unsigned u) { return (f32x2){bf_lo(u), bf_hi(u)}; }
__device__ __forceinline__ float sigmoid_f(float x) { return __builtin_amdgcn_rcpf(1.0f + __expf(-x)); }
__device__ __forceinline__ float silu_f(float x) { return x * sigmoid_f(x); }
__device__ __forceinline__ u32x4 pack8(f32x4 a, f32x4 b) { return (u32x4){cvt_pk_bf16(a[0], a[1]), cvt_pk_bf16(a[2], a[3]), cvt_pk_bf16(b[0], b[1]), cvt_pk_bf16(b[2], b[3])}; }
__device__ __forceinline__ float wave_sum(float v) {
#pragma unroll
    for (int o = 32; o > 0; o >>= 1) v += __shfl_xor(v, o);
    return v;
}


#define XB_TMO      128
#define XB_XCNT(j)  (256  + 64 * (j))
#define XB_XSUB(j)  (1280 + 64 * (j))
#define XB_XGEN(j)  (2304 + 64 * (j))
#define XB_TOP      3328
#define XB_TOPGEN   3392
#define XB_XLOC(j)  (3520 + 64 * (j))
#define XCD_BAR_WORDS 4608
#define XB_SPIN_CAP (1u << 18)
__device__ __forceinline__ unsigned xb_ld(unsigned* p)              { return __hip_atomic_load(p, __ATOMIC_RELAXED, __HIP_MEMORY_SCOPE_AGENT); }
__device__ __forceinline__ unsigned xb_add(unsigned* p, unsigned v) { return __hip_atomic_fetch_add(p, v, __ATOMIC_RELAXED, __HIP_MEMORY_SCOPE_AGENT); }
__device__ __forceinline__ unsigned xb_xcc_id() { return (unsigned)__builtin_amdgcn_s_getreg((3 << 11) | 20) & 0xFu; }
#define XB_SPIN(cond, bar) do { unsigned _sp = 0; while (cond) { __builtin_amdgcn_s_sleep(1); \
    if ((++_sp & 255u) == 0u) { if (xb_ld(&(bar)[XB_TMO])) break; if (_sp > XB_SPIN_CAP) { atomicAdd(&(bar)[XB_TMO], 1u); break; } } } } while (0)
struct XcdBarrier { unsigned* bar; unsigned x; volatile LAS unsigned* st; };
__device__ __forceinline__ XcdBarrier xcd_barrier_post(unsigned* bar, volatile LAS unsigned* st) {
    XcdBarrier b; b.bar = bar; b.x = xb_xcc_id(); b.st = st;
    if (threadIdx.x == 0) st[2] = xb_add(&bar[XB_XCNT(b.x)], 1u);
    return b;
}
__device__ __forceinline__ void xcd_barrier_complete(unsigned* bar, unsigned x, unsigned& nloc, unsigned& nx, unsigned& uni) {
    const unsigned G = gridDim.x * gridDim.y * gridDim.z;
    unsigned sum, cnt, mine, sp = 0u;
    for (;;) {
        sum = 0u; cnt = 0u; mine = 0u; uni = 1u;
#pragma unroll
        for (unsigned j = 0; j < 16; ++j) { const unsigned c = xb_ld(&bar[XB_XCNT(j)]); sum += c; cnt += (c > 0u) ? 1u : 0u; mine = (j == x) ? c : mine; uni = (c == (j < 8 ? 32u : 0u)) ? uni : 0u; }
        if (sum == G) break;
        __builtin_amdgcn_s_sleep(1);
        if ((++sp & 255u) == 0u) { if (xb_ld(&bar[XB_TMO])) break; if (sp > XB_SPIN_CAP) { atomicAdd(&bar[XB_TMO], 1u); break; } }
    }
    nloc = mine > 0u ? mine : 1u; nx = cnt > 0u ? cnt : 1u; uni = (sum == G) ? uni : 0u;
}
template <class Hook>
__device__ __forceinline__ void xcd_barrier(const XcdBarrier& b, const Hook& hook) {
    asm volatile("s_waitcnt vmcnt(0)" ::: "memory");
    __syncthreads();
    if (threadIdx.x >= 64) hook();
    if (threadIdx.x == 0) {
        unsigned* bar = b.bar;
        __builtin_amdgcn_s_waitcnt(0);
        unsigned nloc = b.st[0], nx = b.st[1];
        if (nloc == 0u) { unsigned uni; xcd_barrier_complete(bar, b.x, nloc, nx, uni); b.st[0] = nloc; b.st[1] = nx; b.st[3] = uni; }
        const unsigned old = xb_add(&bar[XB_XSUB(b.x)], 1u);
        const unsigned gen = old / nloc;
        if (old + 1u == (gen + 1u) * nloc) {
            __builtin_amdgcn_fence(__ATOMIC_RELEASE, "agent");
            asm volatile("s_waitcnt vmcnt(0)" ::: "memory");
            const unsigned og = xb_add(&bar[XB_TOP], 1u);
            const unsigned tg = og / nx;
            if (og + 1u == (tg + 1u) * nx) xb_add(&bar[XB_TOPGEN], 1u);
            else XB_SPIN(xb_ld(&bar[XB_TOPGEN]) == tg, bar);
            __builtin_amdgcn_fence(__ATOMIC_ACQUIRE, "agent");
            xb_add(&bar[XB_XGEN(b.x)], 1u);
            asm volatile("s_waitcnt vmcnt(0)" ::: "memory");
        } else {
            XB_SPIN(xb_ld(&bar[XB_XGEN(b.x)]) == gen, bar);
            __builtin_amdgcn_fence(__ATOMIC_ACQUIRE, "agent");
            asm volatile("s_waitcnt vmcnt(0)" ::: "memory");
        }
    }
    if (threadIdx.x < 64) hook();
    __syncthreads();
}
__device__ __forceinline__ void xcd_barrier(const XcdBarrier& b) { xcd_barrier(b, [] {}); }
template <class Hook>
__device__ __forceinline__ void xcc_barrier(const XcdBarrier& b, const Hook& hook) {
    asm volatile("s_waitcnt vmcnt(0)" ::: "memory");
    __syncthreads();
    if (threadIdx.x >= 64) hook();
    if (threadIdx.x == 0) {
        unsigned* w = &b.bar[XB_XLOC(b.x)];
        __builtin_amdgcn_s_waitcnt(0);
        const unsigned old = xb_add(w, 1u), target = (old / 32u + 1u) * 32u;
        XB_SPIN(xb_ld(w) < target, b.bar);
        __builtin_amdgcn_fence(__ATOMIC_ACQUIRE, "agent");
        asm volatile("s_waitcnt vmcnt(0)" ::: "memory");
    }
    if (threadIdx.x < 64) hook();
    __syncthreads();
}

namespace pg8 {
constexpr int BM = 256, BK = 64, HALF = 128, HTB = HALF * BK * 2, STAGE_BYTES = 8 * HTB, NXCD = 8, WGM = 8;
__device__ __forceinline__ int lds_byte(int r, int c) { const int st = (r >> 4) * 2 + (c >> 5), rr = r & 15, cc = c & 31, ob = rr * 64 + cc * 2; return st * 1024 + (ob ^ (((ob >> 9) & 1) << 5)); }
__device__ __forceinline__ void stage_rc(int b, int& R, int& C) { const int st = b / 1024, sb = b % 1024, swz = sb ^ (((sb >> 9) & 1) << 5); R = (st >> 1) * 16 + swz / 64; C = (st & 1) * 32 + (swz % 64) / 2; }
__device__ __forceinline__ int perm32(int rho) { const int n = rho >> 4, i = rho & 15; return 8 * (i >> 2) + 4 * n + (i & 3); }

struct Unit { const char* A; const char* B; int pm, pn, nt, kind; };

__device__ __forceinline__ bool tile_order(int i, int G, int c, int nM, int nN, int& pm, int& pn) {
    const int nwg = nM * nN; const long L = (long)i * G + c; if (L >= nwg) return false;
    int wgid = (int)L; { const int q = nwg / NXCD, r = nwg % NXCD, xcd = wgid % NXCD, off = wgid / NXCD; wgid = (xcd < r ? xcd * (q + 1) : r * (q + 1) + (xcd - r) * q) + off; }
    const int nig = WGM * nN, gid = wgid / nig, fm = gid * WGM, gsz = (nM - fm) < WGM ? (nM - fm) : WGM;
    pm = fm + ((wgid % nig) % gsz); pn = (wgid % nig) / gsz; return true;
}

template <class Epi, class Sched>
__device__ __forceinline__ void gemm_phase(LAS unsigned char* lds, const int lda, const int ldb, const Sched& S, const Epi& E, f32x4 (&acc)[2][2][4][2]) {
    int tid_ = threadIdx.x; asm volatile("" : "+v"(tid_));
    const int tid = tid_, wid = __builtin_amdgcn_readfirstlane(tid >> 6), lane = tid & 63, wr = wid >> 2, wc = wid & 3, fr = lane & 15, fq = lane >> 4;
    unsigned voffA[2], voffB[2];
#pragma unroll
    for (int i = 0; i < 2; ++i) { int R, C; stage_rc(tid * 16 + i * 8192, R, C); const int Rb = Epi::PERM ? ((R & ~31) + perm32(R & 31)) : R;
        voffA[i] = (unsigned)(R * lda + C) * 2u; voffB[i] = (unsigned)(Rb * ldb + C) * 2u; }
    const size_t kstep = (size_t)(BK * 2);
    const size_t hstepA = (size_t)HALF * lda * 2, hstepB = (size_t)HALF * ldb * 2;
    const unsigned ldsw = (unsigned)wid * 1024u;
    const int aoff = lds_byte(wr * 64 + fr, fq * 8), boff = lds_byte(wc * 32 + fr, fq * 8);
#define PG8_SA(b, h) (((b) * 2 + (h)) * HTB)
#define PG8_SB(b, h) ((4 + (b) * 2 + (h)) * HTB)
#define PG8_STAGE(bufoff, gbase, voff) do { _Pragma("unroll") for (int _i = 0; _i < 2; ++_i) \
        __builtin_amdgcn_global_load_lds((const unsigned*)((const char*)(gbase) + (voff)[_i]), (LAS unsigned*)(lds + (bufoff) + ldsw + _i * 8192), 16, 0, 0); } while (0)
#define PG8_LDA(dst, b, h) do { _Pragma("unroll") for (int m = 0; m < 4; ++m) _Pragma("unroll") for (int k = 0; k < 2; ++k) dst[m][k] = *(const LAS bf16x8*)(lds + PG8_SA(b, h) + aoff + m * 2048 + k * 1024); } while (0)
#define PG8_LDB(dst, b, h) do { _Pragma("unroll") for (int n = 0; n < 2; ++n) _Pragma("unroll") for (int k = 0; k < 2; ++k) dst[n][k] = *(const LAS bf16x8*)(lds + PG8_SB(b, h) + boff + n * 2048 + k * 1024); } while (0)
#define PG8_MMA(ai, bj, At, Bt) do { __builtin_amdgcn_s_setprio(1); _Pragma("unroll") for (int m = 0; m < 4; ++m) _Pragma("unroll") for (int n = 0; n < 2; ++n) _Pragma("unroll") for (int k = 0; k < 2; ++k) \
        acc[ai][bj][m][n] = __builtin_amdgcn_mfma_f32_16x16x32_bf16(Bt[n][k], At[m][k], acc[ai][bj][m][n], 0, 0, 0); __builtin_amdgcn_s_setprio(0); } while (0)
#define PG8_WAIT_V(n) asm volatile("s_waitcnt vmcnt(" #n ")" ::: "memory")
#define PG8_WAIT_L(n) asm volatile("s_waitcnt lgkmcnt(" #n ")" ::: "memory")
#define PG8_BAR __builtin_amdgcn_s_barrier()
#define PG8_SCHED __builtin_amdgcn_sched_barrier(0)
    Unit cur, nxt; int ui = 0;
    if (!S.next(0, cur)) return;
    if constexpr (!Epi::EXT_INIT) E.init(acc, cur, wr, wc, fr, fq);
    bf16x8 At[4][2], B0[2][2], B1[2][2];
    const char* cA = cur.A; const char* cB = cur.B;
    PG8_STAGE(PG8_SB(0, 0), cB, voffB); PG8_STAGE(PG8_SA(0, 0), cA, voffA); PG8_STAGE(PG8_SB(0, 1), cB + hstepB, voffB); PG8_STAGE(PG8_SA(0, 1), cA + hstepA, voffA);
    if (wr == 1) PG8_BAR;
    PG8_WAIT_V(4); PG8_BAR;
    PG8_STAGE(PG8_SB(1, 0), cB + kstep, voffB); PG8_STAGE(PG8_SA(1, 0), cA + kstep, voffA); PG8_STAGE(PG8_SB(1, 1), cB + hstepB + kstep, voffB);
    PG8_WAIT_V(6); PG8_BAR;
    for (;;) {
        const bool has_next = S.next(ui + 1, nxt);
        const char* nA = has_next ? nxt.A : cA; const char* nB = has_next ? nxt.B : cB;
        const int nt = cur.nt;
        for (int t = 0; t < nt; t += 2) {
            const bool last = (t == nt - 2);
            const char* a1 = cA + (size_t)(t + 1) * kstep;
            const char* a2 = last ? nA : cA + (size_t)(t + 2) * kstep; const char* b2 = last ? nB : cB + (size_t)(t + 2) * kstep;
            const char* a3 = a2 + kstep; const char* b3 = b2 + kstep;
            bool m0 = true, m1 = true;
            if constexpr (Epi::ZSKIP) { if (cur.kind == 3) { m0 = t < 2; m1 = t >= 2; } }
            PG8_LDB(B0, 0, 0); PG8_SCHED; PG8_LDA(At, 0, 0); PG8_STAGE(PG8_SA(1, 1), a1 + hstepA, voffA);
            PG8_WAIT_L(8); PG8_BAR; PG8_WAIT_L(0); if (m0) PG8_MMA(0, 0, At, B0); PG8_BAR; PG8_SCHED;
            PG8_LDB(B1, 0, 1); PG8_STAGE(PG8_SB(0, 0), b2, voffB);
            PG8_BAR; PG8_WAIT_L(0); if (m1) PG8_MMA(0, 1, At, B1); PG8_BAR;
            PG8_LDA(At, 0, 1); PG8_STAGE(PG8_SA(0, 0), a2, voffA);
            PG8_BAR; PG8_WAIT_L(0); if (m0) PG8_MMA(1, 0, At, B0); PG8_BAR; PG8_SCHED;
            PG8_STAGE(PG8_SB(0, 1), b2 + hstepB, voffB);
            PG8_WAIT_V(6); PG8_BAR; if (m1) PG8_MMA(1, 1, At, B1); PG8_BAR;
            PG8_LDB(B0, 1, 0); PG8_SCHED; PG8_LDA(At, 1, 0); PG8_STAGE(PG8_SA(0, 1), a2 + hstepA, voffA);
            PG8_WAIT_L(8); PG8_BAR; PG8_WAIT_L(0); if (m0) PG8_MMA(0, 0, At, B0); PG8_BAR; PG8_SCHED;
            PG8_LDB(B1, 1, 1); PG8_STAGE(PG8_SB(1, 0), b3, voffB);
            PG8_BAR; PG8_WAIT_L(0); if (m1) PG8_MMA(0, 1, At, B1); PG8_BAR;
            PG8_LDA(At, 1, 1); PG8_STAGE(PG8_SA(1, 0), a3, voffA);
            PG8_BAR; PG8_WAIT_L(0); if (m0) PG8_MMA(1, 0, At, B0); PG8_BAR; PG8_SCHED;
            PG8_STAGE(PG8_SB(1, 1), b3 + hstepB, voffB);
            PG8_WAIT_V(6); PG8_BAR; if (m1) PG8_MMA(1, 1, At, B1); PG8_BAR;
        }
        if constexpr (!Epi::AFTER_DRAIN) { E(acc, cur, wr, wc, fr, fq); S.done(cur, ui, lane); }
        if (!has_next) break;
        cur = nxt; cA = nA; cB = nB; ++ui;
        E.init(acc, cur, wr, wc, fr, fq);
    }
    PG8_WAIT_V(0);
    if (wr == 0) PG8_BAR;
    PG8_BAR;
    if constexpr (Epi::AFTER_DRAIN) E.fused(acc, cur, wr, wc, fr, fq, lds, tid);
#undef PG8_SA
#undef PG8_SB
#undef PG8_STAGE
#undef PG8_LDA
#undef PG8_LDB
#undef PG8_MMA
#undef PG8_WAIT_V
#undef PG8_WAIT_L
#undef PG8_BAR
#undef PG8_SCHED
}
}

struct SchedP1 {
    const char* xb; const char* win; unsigned* cnt; int gx, gl; bool uni;
    __device__ __forceinline__ bool next(int i, pg8::Unit& u) const {
        const int n_s = gx < 2 ? 2 : 1, j = gl + 32 * i; if (j >= 80 + n_s) return false;
        int pm, pn, kind;
        if (j < n_s) { pm = NPROMPT / 256; pn = gx + 8 * j; kind = 2; }
        else if (j < n_s + 48) { const int k = j - n_s, q = k >> 3; pm = 8 * gx + (k & 7); pn = q < 2 ? q : q + 2; kind = 1; }
        else { const int k = j - n_s - 48, q = k >> 3; pm = 8 * gx + (k & 7); pn = q < 2 ? q + 2 : q + 6; kind = 0; }
        u.pm = pm; u.pn = pn; u.kind = kind; u.nt = 16; u.A = xb + (size_t)pm * 256 * DM * 2; u.B = win + (size_t)pn * 256 * DM * 2; return true;
    }
    __device__ __forceinline__ void done(const pg8::Unit&, int ui, int lane) const {
        if (!uni) return;
        const int n_s = gx < 2 ? 2 : 1, nuv = gl < n_s + 16 ? 2 : 1;
        if (ui != nuv - 1) return;
        asm volatile("s_waitcnt vmcnt(0)" ::: "memory");
        if (lane == 0) { const int sm = gl < n_s ? 1 : 0, uv = nuv - sm;
            (void)xb_add(cnt + 64 * (CW_RV + gx), (unsigned)uv);
            if (sm) (void)xb_add(cnt + 64 * (CW_SV + gx), 1u); }
    }
};
struct EpiP1 {
    static constexpr bool PERM = true, AFTER_DRAIN = false, EXT_INIT = false, ZSKIP = false;
    bf16_t* U; bf16_t* SGP; bf16_t* V; bf16_t* SGC; float* out;
    __device__ __forceinline__ void init(f32x4 (&acc)[2][2][4][2], const pg8::Unit&, int, int, int, int) const {
#pragma unroll
        for (int a = 0; a < 2; ++a)
#pragma unroll
            for (int b = 0; b < 2; ++b)
#pragma unroll
                for (int m = 0; m < 4; ++m)
#pragma unroll
                    for (int n = 0; n < 2; ++n) acc[a][b][m][n] = (f32x4){0.f, 0.f, 0.f, 0.f};
    }
    __device__ __forceinline__ void operator()(const f32x4 (&acc)[2][2][4][2], const pg8::Unit& u, int wr, int wc, int fr, int fq) const {
        const int pn = u.pn, row0 = u.pm * 256 + wr * 64 + fr, cl = wc * 32 + 8 * fq;
        if (pn < 2) {
#pragma unroll
            for (int ai = 0; ai < 2; ++ai)
#pragma unroll
                for (int m = 0; m < 4; ++m) {
                    const int r = row0 + ai * 128 + m * 16; bool st; size_t so;
                    if (r < NPROMPT) { const int t = r & (SEQ - 1); st = t >= SEQ - 15; so = O_SPP + ((size_t)(r >> 12) * 15 + (t - (SEQ - 15))) * 512; }
                    else { const int s = r - NPROMPT, t = s & 15; st = t >= 1; so = O_SPS + ((size_t)(s >> 4) * 15 + (t - 1)) * 512; }
#pragma unroll
                    for (int bj = 0; bj < 2; ++bj) { const int c = pn * 256 + bj * 128 + cl; const f32x4 v0 = acc[ai][bj][m][0], v1 = acc[ai][bj][m][1];
                        *(u32x4*)(U + (size_t)r * DH + c) = pack8(v0, v1);
                        if (st) { *(f32x4*)(out + so + c) = v0; *(f32x4*)(out + so + c + 4) = v1; } }
                }
        } else if (pn < 4 || pn >= 8) {
            bf16_t* dst = pn < 4 ? SGP : SGC; const int cb = (pn < 4 ? pn - 2 : pn - 8) * 256 + cl;
#pragma unroll
            for (int ai = 0; ai < 2; ++ai)
#pragma unroll
                for (int m = 0; m < 4; ++m) { const int r = row0 + ai * 128 + m * 16;
#pragma unroll
                    for (int bj = 0; bj < 2; ++bj) { f32x4 v0 = acc[ai][bj][m][0], v1 = acc[ai][bj][m][1];
#pragma unroll
                        for (int j = 0; j < 4; ++j) { v0[j] = silu_f(v0[j]); v1[j] = silu_f(v1[j]); }
                        *(u32x4*)(dst + (size_t)r * DH + cb + bj * 128) = pack8(v0, v1); }
                }
        } else {
            const int c = (pn - 4) * 128 + cl;
#pragma unroll
            for (int ai = 0; ai < 2; ++ai)
#pragma unroll
                for (int m = 0; m < 4; ++m) {
                    const int r = row0 + ai * 128 + m * 16; bool st; size_t so;
                    if (r < NPROMPT) { const int t = r & (SEQ - 1); st = t >= SEQ - 30; so = O_SCP + ((size_t)(r >> 12) * 30 + (t - (SEQ - 30))) * 512; }
                    else { const int s = r - NPROMPT, t = s & 15; st = true; so = O_SCS + ((size_t)(s >> 4) * 30 + 14 + t) * 512; }
                    f32x4 v0 = acc[ai][0][m][0], v1 = acc[ai][0][m][1]; const f32x4 g0 = acc[ai][1][m][0], g1 = acc[ai][1][m][1];
#pragma unroll
                    for (int j = 0; j < 4; ++j) { v0[j] *= sigmoid_f(g0[j]); v1[j] *= sigmoid_f(g1[j]); }
                    *(u32x4*)(V + (size_t)r * DH + c) = pack8(v0, v1);
                    if (st) { *(f32x4*)(out + so + c) = v0; *(f32x4*)(out + so + c + 4) = v1; }
                }
        }
    }
};

struct SchedP3 {
    const char* pc; const char* mix; const char* pw; int pm0, pn0;
    __device__ __forceinline__ void done(const pg8::Unit&, int, int) const {}
    __device__ __forceinline__ bool next(int i, pg8::Unit& u) const {
        if (i != 0) return false; const int pm = pm0, pn = pn0;
        u.pm = pm; u.pn = pn; u.kind = 0;
        if (pn < 2) { u.kind = 3; u.nt = 4; u.A = pc + ((size_t)pm * 256 * DM + 256 * pn) * 2; u.B = mix + ((size_t)pn * 256 * 512 + 256 * pn) * 2; }
        else { u.nt = 8; u.A = pc + ((size_t)pm * 256 * DM + 512) * 2; u.B = pw + (size_t)(pn - 2) * 256 * 512 * 2; }
        return true;
    }
};
struct EpiP3 {
    static constexpr bool PERM = true, AFTER_DRAIN = false, EXT_INIT = false, ZSKIP = true;
    const bf16_t* SGP; const bf16_t* SGC; const float* pw_b; bf16_t* Z;
    __device__ __forceinline__ void init(f32x4 (&acc)[2][2][4][2], const pg8::Unit&, int, int, int, int) const {
#pragma unroll
        for (int a = 0; a < 2; ++a)
#pragma unroll
            for (int b = 0; b < 2; ++b)
#pragma unroll
                for (int m = 0; m < 4; ++m)
#pragma unroll
                    for (int n = 0; n < 2; ++n) acc[a][b][m][n] = (f32x4){0.f, 0.f, 0.f, 0.f};
    }
    __device__ __forceinline__ void operator()(const f32x4 (&acc)[2][2][4][2], const pg8::Unit& u, int wr, int wc, int fr, int fq) const {
        const int pn = u.pn, row0 = u.pm * 256 + wr * 64 + fr, cl = wc * 32 + 8 * fq;
        const bool conv = pn >= 2; const bf16_t* gate = conv ? SGC : SGP; const int cb = (conv ? pn - 2 : pn) * 256 + cl;
        f32x4 bv[2][2];
#pragma unroll
        for (int bj = 0; bj < 2; ++bj)
#pragma unroll
            for (int n = 0; n < 2; ++n) bv[bj][n] = conv ? *(const f32x4*)(pw_b + cb + bj * 128 + 4 * n) : (f32x4){0.f, 0.f, 0.f, 0.f};
#pragma unroll
        for (int ai = 0; ai < 2; ++ai) {
            u32x4 gt[4][2];
#pragma unroll
            for (int m = 0; m < 4; ++m)
#pragma unroll
                for (int bj = 0; bj < 2; ++bj) gt[m][bj] = *(const u32x4*)(gate + (size_t)(row0 + ai * 128 + m * 16) * DH + cb + bj * 128);
#pragma unroll
            for (int m = 0; m < 4; ++m) { const int r = row0 + ai * 128 + m * 16;
#pragma unroll
                for (int bj = 0; bj < 2; ++bj) { const int c = cb + bj * 128; const u32x4 g = gt[m][bj];
                    f32x4 v0 = acc[ai][bj][m][0] + bv[bj][0], v1 = acc[ai][bj][m][1] + bv[bj][1];
                    v0[0] *= bf_lo(g[0]); v0[1] *= bf_hi(g[0]); v0[2] *= bf_lo(g[1]); v0[3] *= bf_hi(g[1]);
                    v1[0] *= bf_lo(g[2]); v1[1] *= bf_hi(g[2]); v1[2] *= bf_lo(g[3]); v1[3] *= bf_hi(g[3]);
                    *(u32x4*)(Z + (size_t)r * DM + (conv ? 512 : 0) + c) = pack8(v0, v1); }
            }
        }
    }
};

struct SchedP4 {
    const char* z; const char* wout; int pm0, pn0;
    __device__ __forceinline__ void done(const pg8::Unit&, int, int) const {}
    __device__ __forceinline__ bool next(int i, pg8::Unit& u) const {
        if (i != 0) return false; const int pm = pm0, pn = pn0;
        u.pm = pm; u.pn = pn; u.kind = 0; u.nt = 16; u.A = z + (size_t)pm * 256 * DM * 2; u.B = wout + (size_t)pn * 256 * DM * 2; return true;
    }
};
struct EpiP4 {
    static constexpr bool PERM = false, AFTER_DRAIN = true, EXT_INIT = true, ZSKIP = false;
    const float* x_prompt; const float* final_g; float* out; float* xs; unsigned* cnt; const float* ss; int srow; bool uni;
    __device__ __forceinline__ void init(f32x4 (&acc)[2][2][4][2], const pg8::Unit& u, int wr, int wc, int fr, int fq) const {
        const int row0 = u.pm * 256 + wr * 64 + fr, col0 = u.pn * 256 + wc * 32 + 4 * fq;
#pragma unroll
        for (int ai = 0; ai < 2; ++ai)
#pragma unroll
            for (int m = 0; m < 4; ++m) { const float* xr = x_prompt + (size_t)(row0 + ai * 128 + m * 16) * DM + col0;
#pragma unroll
                for (int bj = 0; bj < 2; ++bj)
#pragma unroll
                    for (int n = 0; n < 2; ++n) acc[ai][bj][m][n] = *(const f32x4*)(xr + bj * 128 + n * 16); }
    }
    __device__ __forceinline__ void fused(const f32x4 (&acc)[2][2][4][2], const pg8::Unit& u, int wr, int wc, int fr, int fq, LAS unsigned char* lds, int tid) const {
        LAS float* lss = (LAS float*)lds;
#pragma unroll
        for (int ai = 0; ai < 2; ++ai)
#pragma unroll
            for (int m = 0; m < 4; ++m) { float s = 0.f;
#pragma unroll
                for (int bj = 0; bj < 2; ++bj)
#pragma unroll
                    for (int n = 0; n < 2; ++n) { const f32x4 y = acc[ai][bj][m][n]; s += y[0] * y[0] + y[1] * y[1] + y[2] * y[2] + y[3] * y[3]; }
                s += __shfl_xor(s, 16); s += __shfl_xor(s, 32);
                if (fq == 0) lss[(ai * 128 + wr * 64 + m * 16 + fr) * 4 + wc] = s; }
        __syncthreads();
        if (tid < 256) { const f32x4 v = *(const LAS f32x4*)(lss + tid * 4); xs[((size_t)u.pm * 4 + u.pn) * 256 + tid] = v[0] + v[1] + v[2] + v[3]; }
        asm volatile("s_waitcnt vmcnt(0)" ::: "memory");
        __syncthreads();
        if (tid == 0) {
            unsigned* cw = cnt + 64 * u.pm; unsigned* cs = cnt + 64 * CW_PIECES;
            if (!uni) __builtin_amdgcn_fence(__ATOMIC_RELEASE, "agent");
            asm volatile("s_waitcnt vmcnt(0)" ::: "memory");
            (void)xb_add(cw, 1u);
            unsigned sp = 0u;
            while (xb_ld(cw) < 4u || xb_ld(cs) < 256u) { __builtin_amdgcn_s_sleep(1); if (++sp > (1u << 22)) break; }
            __builtin_amdgcn_fence(__ATOMIC_ACQUIRE, "agent");
            asm volatile("s_waitcnt vmcnt(0)" ::: "memory");
        }
        __syncthreads();
        if (tid >= 256) { const int t4 = (tid - 256) * 4; const float rs = rsqrtf(ss[srow] * (1.0f / DM) + 1e-6f); float* yr = out + (size_t)srow * DM + t4;
            *(f32x4*)yr = *(const f32x4*)yr * rs * *(const f32x4*)(final_g + t4); }
        if (tid < 256) { const float* xp = xs + (size_t)u.pm * 4 * 256 + tid; const float tot = xp[0] + xp[256] + xp[512] + xp[768];
            lss[1024 + tid] = rsqrtf(tot * (1.0f / DM) + 1e-6f); }
        __syncthreads();
        const int row0 = u.pm * 256 + wr * 64 + fr, col0 = u.pn * 256 + wc * 32 + 4 * fq;
        f32x4 g4[2][2];
#pragma unroll
        for (int bj = 0; bj < 2; ++bj)
#pragma unroll
            for (int n = 0; n < 2; ++n) g4[bj][n] = *(const f32x4*)(final_g + col0 + bj * 128 + n * 16);
#pragma unroll
        for (int ai = 0; ai < 2; ++ai)
#pragma unroll
            for (int m = 0; m < 4; ++m) { const float rs = lss[1024 + ai * 128 + wr * 64 + m * 16 + fr]; float* yr = out + (size_t)(row0 + ai * 128 + m * 16) * DM + col0;
#pragma unroll
                for (int bj = 0; bj < 2; ++bj)
#pragma unroll
                    for (int n = 0; n < 2; ++n) *(f32x4*)(yr + bj * 128 + n * 16) = acc[ai][bj][m][n] * rs * g4[bj][n]; }
    }
    __device__ __forceinline__ void operator()(const f32x4 (&)[2][2][4][2], const pg8::Unit&, int, int, int, int) const {}
};

template <int NF>
__device__ __forceinline__ f32x4 small_gemm(const bf16_t* __restrict__ A, int lda, const bf16_t* __restrict__ Bt, int ldb, int K, int nw, f32x4* red) {
    const int tid = threadIdx.x, wid = tid >> 6, lane = tid & 63, fr = lane & 15, fq = lane >> 4;
    f32x4 acc[NF];
#pragma unroll
    for (int f = 0; f < NF; ++f) acc[f] = (f32x4){0.f, 0.f, 0.f, 0.f};
    if (wid < nw) { const int ks = K / nw; const bf16_t* ap = A + (size_t)fr * lda + wid * ks + fq * 8; const bf16_t* bp = Bt + (size_t)fr * ldb + wid * ks + fq * 8;
        for (int k = 0; k < ks; k += 32) { const bf16x8 a = *(const bf16x8*)(ap + k);
#pragma unroll
            for (int f = 0; f < NF; ++f) { const bf16x8 b = *(const bf16x8*)(bp + (size_t)f * 16 * ldb + k); acc[f] = __builtin_amdgcn_mfma_f32_16x16x32_bf16(b, a, acc[f], 0, 0, 0); } } }
#pragma unroll
    for (int f = 0; f < NF; ++f) red[(wid * NF + f) * 64 + lane] = acc[f];
    __syncthreads();
    f32x4 r = (f32x4){0.f, 0.f, 0.f, 0.f};
    if (tid < 64 * NF) {
#pragma unroll
        for (int w = 0; w < 8; ++w) r += red[(w * NF + wid) * 64 + lane]; }
    return r;
}
__device__ __forceinline__ void sample_p3(const Params& p, unsigned char* shm, const int i) {
    const int tid = threadIdx.x, wid = tid >> 6, lane = tid & 63, fr = lane & 15, fq = lane >> 4; f32x4* red = (f32x4*)shm;
    const bf16_t* PC = (const bf16_t*)(p.ws + WS_PC); bf16_t* Z = (bf16_t*)(p.ws + WS_Z);
    { const int rb = i >> 4, cb = i & 15, row0 = NPROMPT + rb * 16, row = row0 + fr, c = 32 * cb + 16 * wid + 4 * fq;
        {
            const f32x4 r = small_gemm<2>(PC + (size_t)row0 * DM + 512, DM, (const bf16_t*)(p.ws + WS_PW) + (size_t)32 * cb * 512, 512, 512, 8, red);
            if (tid < 128) { const f32x4 bv = *(const f32x4*)(p.pw_b + c); const u32x2 g = *(const u32x2*)((const bf16_t*)(p.ws + WS_SGC) + (size_t)row * DH + c);
                const f32x4 z = (r + bv) * (f32x4){bf_lo(g[0]), bf_hi(g[0]), bf_lo(g[1]), bf_hi(g[1])};
                *(u32x2*)(Z + (size_t)row * DM + 512 + c) = (u32x2){cvt_pk_bf16(z[0], z[1]), cvt_pk_bf16(z[2], z[3])}; }
            __syncthreads();
        }
        {
            const int g128 = (cb >> 2) * 128;
            const f32x4 r = small_gemm<2>(PC + (size_t)row0 * DM + g128, DM, (const bf16_t*)(p.ws + WS_MIX) + (size_t)32 * cb * 512 + g128, 512, 128, 4, red);
            if (tid < 128) { const u32x2 g = *(const u32x2*)((const bf16_t*)(p.ws + WS_SGP) + (size_t)row * DH + c);
                const f32x4 z = r * (f32x4){bf_lo(g[0]), bf_hi(g[0]), bf_lo(g[1]), bf_hi(g[1])};
                *(u32x2*)(Z + (size_t)row * DM + c) = (u32x2){cvt_pk_bf16(z[0], z[1]), cvt_pk_bf16(z[2], z[3])}; }
            __syncthreads();
        }
    }
}
__device__ __forceinline__ void sample_p4(const Params& p, unsigned char* shm, const int i) {
    const int tid = threadIdx.x, wid = tid >> 6, lane = tid & 63, fr = lane & 15, fq = lane >> 4; f32x4* red = (f32x4*)shm;
    float* ss = (float*)(p.ws + WS_SS);
    { const int rb = i >> 4, cb = i & 15, row0 = NPROMPT + rb * 16, row = row0 + fr, c = 64 * cb + 16 * wid + 4 * fq;
        const f32x4 r = small_gemm<4>((const bf16_t*)(p.ws + WS_Z) + (size_t)row0 * DM, DM, (const bf16_t*)(p.ws + WS_WOUT) + (size_t)64 * cb * DM, DM, DM, 8, red);
        if (tid < 256) { const f32x4 y = r + *(const f32x4*)(p.x_sample + (size_t)(row - NPROMPT) * DM + c);
            *(f32x4*)(p.out + (size_t)row * DM + c) = y;
            float s = y[0] * y[0] + y[1] * y[1] + y[2] * y[2] + y[3] * y[3]; s += __shfl_xor(s, 16); s += __shfl_xor(s, 32);
            if (fq == 0) atomicAdd(ss + row, s); }
        asm volatile("s_waitcnt vmcnt(0)" ::: "memory");
        __syncthreads();
        if (tid == 0) { __builtin_amdgcn_fence(__ATOMIC_RELEASE, "agent"); asm volatile("s_waitcnt vmcnt(0)" ::: "memory"); (void)xb_add((unsigned*)(p.ws + WS_CNT) + 64 * CW_PIECES, 1u); }
    }
}
__device__ __forceinline__ void transpose_load(const float* __restrict__ src, int ldsrc, int k0, int n0s, f32x4 (&v)[2]) {
    const int tid = threadIdx.x, kk = tid >> 4, n4 = (tid & 15) * 4;
#pragma unroll
    for (int i = 0; i < 2; ++i) v[i] = *(const f32x4*)(src + (size_t)(k0 + kk + 32 * i) * ldsrc + n0s + n4);
}
__device__ __forceinline__ void transpose_store(const f32x4 (&v)[2], int k0, bf16_t* __restrict__ dst, int ldd, int n0d, float* tile) {
    const int tid = threadIdx.x;
    {
        const int kk = tid >> 4, n4 = (tid & 15) * 4;
#pragma unroll
        for (int i = 0; i < 2; ++i) { const int k = kk + 32 * i;
            tile[k * 65 + n4 + 0] = v[i][0]; tile[k * 65 + n4 + 1] = v[i][1]; tile[k * 65 + n4 + 2] = v[i][2]; tile[k * 65 + n4 + 3] = v[i][3]; }
    }
    __syncthreads();
    {
        const int n = tid >> 3, k8 = (tid & 7) * 8; float w[8];
#pragma unroll
        for (int j = 0; j < 8; ++j) w[j] = tile[(k8 + j) * 65 + n];
        *(u32x4*)(dst + (size_t)(n0d + n) * ldd + k0 + k8) = (u32x4){cvt_pk_bf16(w[0], w[1]), cvt_pk_bf16(w[2], w[3]), cvt_pk_bf16(w[4], w[5]), cvt_pk_bf16(w[6], w[7])};
    }
    __syncthreads();
}
__device__ __forceinline__ void transpose_tile(const float* __restrict__ src, int ldsrc, int k0, int n0s, bf16_t* __restrict__ dst, int ldd, int n0d, float* tile) {
    f32x4 v[2]; transpose_load(src, ldsrc, k0, n0s, v); transpose_store(v, k0, dst, ldd, n0d, tile);
}
__device__ __forceinline__ int win_src_col(int n0) {
    if (n0 >= 1024 && n0 < 2048) { const int q = n0 - 1024, j = q >> 8, i = q & 255; return i < 128 ? 1024 + 128 * j + i : 1536 + 128 * j + (i - 128); }
    return n0;
}

__device__ __forceinline__ void phase_prep(const Params& p, unsigned char* shm) {
    const int tid = threadIdx.x, wid = tid >> 6, lane = tid & 63, nb = gridDim.x, bid = blockIdx.x;
    bf16_t* xb = (bf16_t*)(p.ws + WS_XB);
    constexpr int T_IN = 16 * 40;
    f32x4 tv[3][2];
#pragma unroll
    for (int q = 0; q < 3; ++q) { const int t = bid + q * nb; if (t < T_IN) transpose_load(p.w_in, DIN, (t / 40) * 64, win_src_col((t % 40) * 64), tv[q]); }
    {
        f32x4 g4[4];
#pragma unroll
        for (int i = 0; i < 4; ++i) g4[i] = *(const f32x4*)(p.norm_g + lane * 4 + 256 * i);
        for (int g = bid * 8 + wid; g < MT / 4; g += nb * 8) {
            f32x4 v[4][4]; float s[4];
#pragma unroll
            for (int q = 0; q < 4; ++q) { const int r = g * 4 + q; const float* xr = r < NPROMPT ? p.x_prompt + (size_t)r * DM : p.x_sample + (size_t)(r - NPROMPT) * DM;
#pragma unroll
                for (int i = 0; i < 4; ++i) v[q][i] = *(const f32x4*)(xr + lane * 4 + 256 * i); }
#pragma unroll
            for (int q = 0; q < 4; ++q) { s[q] = 0.f;
#pragma unroll
                for (int i = 0; i < 4; ++i) s[q] += v[q][i][0] * v[q][i][0] + v[q][i][1] * v[q][i][1] + v[q][i][2] * v[q][i][2] + v[q][i][3] * v[q][i][3];
                s[q] = wave_sum(s[q]); }
#pragma unroll
            for (int q = 0; q < 4; ++q) { const int r = g * 4 + q; const float rs = rsqrtf(s[q] * (1.0f / DM) + 1e-6f);
#pragma unroll
                for (int i = 0; i < 4; ++i) { const f32x4 h = v[q][i] * rs * g4[i];
                    *(u32x2*)(xb + (size_t)r * DM + lane * 4 + 256 * i) = (u32x2){cvt_pk_bf16(h[0], h[1]), cvt_pk_bf16(h[2], h[3])}; } }
        }
    }
    {
        float* tile = (float*)shm; bf16_t* win = (bf16_t*)(p.ws + WS_WIN);
#pragma unroll
        for (int q = 0; q < 3; ++q) { const int t = bid + q * nb; if (t < T_IN) transpose_store(tv[q], (t / 40) * 64, win, DM, (t % 40) * 64, tile); }
        for (int t = bid + 3 * nb; t < T_IN; t += nb) transpose_tile(p.w_in, DIN, (t / 40) * 64, win_src_col((t % 40) * 64), win, DM, (t % 40) * 64, tile);
    }
    float* ss = (float*)(p.ws + WS_SS);
    for (int i = bid * 512 + tid; i < MT; i += nb * 512) ss[i] = 0.f;
    for (int i = bid * 512 + tid; i < 16 * 14 * 128; i += nb * 512) { const int c4 = i & 127, rr = i >> 7, b = rr / 14, j = rr % 14;
        *(f32x4*)(p.out + O_SCS + ((size_t)b * 30 + j) * 512 + c4 * 4) = *(const f32x4*)(p.cache_conv + ((size_t)b * 30 + 16 + j) * 512 + c4 * 4); }
}

__device__ __forceinline__ void late_weight_prep(const Params& p, unsigned char* shm, const int bid, const int nb) {
    const int tid = threadIdx.x; float* tile = (float*)shm;
    bf16_t* pw = (bf16_t*)(p.ws + WS_PW); bf16_t* wout = (bf16_t*)(p.ws + WS_WOUT); bf16_t* mix = (bf16_t*)(p.ws + WS_MIX);
    constexpr int T_OUT = 16 * 16, T_PW = 8 * 8;
    for (int t = bid; t < T_OUT + T_PW; t += nb) {
        if (t < T_OUT) transpose_tile(p.w_out, DM, (t >> 4) * 64, (t & 15) * 64, wout, DM, (t & 15) * 64, tile);
        else { const int tt = t - T_OUT; transpose_tile(p.pw_w, 512, (tt >> 3) * 64, (tt & 7) * 64, pw, 512, (tt & 7) * 64, tile); }
    }
    for (int idx = bid * 512 + tid; idx < 512 * 512; idx += nb * 512) { const int n = idx >> 9, k = idx & 511; float v = 0.f;
        if ((n >> 7) == (k >> 7)) v = p.pool_mix[((size_t)(n >> 7) * 128 + (k & 127)) * 128 + (n & 127)] * p.pool_scale[n];
        mix[idx] = (bf16_t)(cvt_pk_bf16(v, 0.f) & 0xffffu); }
    __syncthreads();
}

#define DPP_STEP(v, ctrl) ((v) + __builtin_bit_cast(float, __builtin_amdgcn_update_dpp(0, __builtin_bit_cast(int, (v)), (ctrl), 0xf, 0xf, true)))
__device__ __forceinline__ float wave_sum_hi(float v) {
    v = DPP_STEP(v, 0xB1);
    v = DPP_STEP(v, 0x4E);
    v = DPP_STEP(v, 0x141);
    v = DPP_STEP(v, 0x140);
    v += __builtin_bit_cast(float, __builtin_amdgcn_update_dpp(0, __builtin_bit_cast(int, v), 0x142, 0xa, 0xf, false));
    v += __builtin_bit_cast(float, __builtin_amdgcn_update_dpp(0, __builtin_bit_cast(int, v), 0x143, 0xc, 0xf, false));
    return v;
}
#define RED16_STEP(CTRL) _Pragma("unroll") for (int k = 0; k < 16; ++k) asm volatile("v_add_f32_dpp %0, %0, %0 " CTRL : "+v"(r[k]))
__device__ __forceinline__ void wave_sum16_hi(float (&r)[16]) {
    asm volatile("s_nop 1" ::: "memory");
    RED16_STEP("quad_perm:[1,0,3,2] row_mask:0xf bank_mask:0xf");
    RED16_STEP("quad_perm:[2,3,0,1] row_mask:0xf bank_mask:0xf");
    RED16_STEP("row_half_mirror row_mask:0xf bank_mask:0xf");
    RED16_STEP("row_mirror row_mask:0xf bank_mask:0xf");
    RED16_STEP("row_bcast:15 row_mask:0xa bank_mask:0xf");
    RED16_STEP("row_bcast:31 row_mask:0xc bank_mask:0xf");
}
template <int W, int TH>
__device__ __forceinline__ void pool_regs(const unsigned (&u)[TH + 15], const int pos0, bf16_t* __restrict__ dst  ) {
    f32x2 s = (f32x2){0.f, 0.f};
#pragma unroll
    for (int j = 0; j < W; ++j) s += bf_unpack(u[15 - j]);
#pragma unroll
    for (int i = 0; i < TH; ++i) { const f32x2 cur = bf_unpack(u[15 + i]); const int pos1 = pos0 + i + 1;
        const float inv = pos1 >= W ? (1.0f / W) : __builtin_amdgcn_rcpf((float)pos1);
        const f32x2 o = s * inv - cur;
        *(unsigned*)(dst + (size_t)i * DM) = cvt_pk_bf16(o[0], o[1]);
        if (i + 1 < TH) s += bf_unpack(u[16 + i]) - bf_unpack(u[16 + i - W]); }
}
template <int T>
__device__ __forceinline__ void mixer_chunk(const Params& p, unsigned char* shm, const int r0, const int t0, const int tid, const f32x2 (&w2)[31]) {
    constexpr int TH = T / 2, ROUNDS = T / 16, NV = ((T + 30) * 64 + 511) / 512;
    const int cp = tid & 255, th = tid >> 8, lane = tid & 63, wv = (tid >> 6) & 3;
    const bf16_t* U = (const bf16_t*)(p.ws + WS_U); const bf16_t* V = (const bf16_t*)(p.ws + WS_V); bf16_t* PC = (bf16_t*)(p.ws + WS_PC);
    const unsigned* l32 = (const unsigned*)shm;
    u32x4 val[NV];
    {
        const bf16_t* vb = V + (size_t)(r0 - 30) * DH;
#pragma unroll
        for (int k = 0; k < NV; ++k) { const int idx = tid + k * 512, lr = idx >> 6; val[k] = (u32x4){0u, 0u, 0u, 0u};
            if (idx < (T + 30) * 64 && t0 - 30 + lr >= 0) val[k] = *(const u32x4*)(vb + (size_t)idx * 8); }
    }
    unsigned u[TH + 15];
    {
        const int f0 = th * TH - 15; const bf16_t* ub = U + (size_t)(r0 + f0) * DH + cp * 2;
#pragma unroll
        for (int k = 0; k < TH + 15; ++k) { u[k] = 0u; if (t0 + f0 + k >= 0) u[k] = *(const unsigned*)(ub + (size_t)k * DH); }
    }
#pragma unroll
    for (int k = 0; k < NV; ++k) { const int idx = tid + k * 512; if (idx < (T + 30) * 64) *(u32x4*)(shm + (size_t)idx * 16) = val[k]; }
    const f32x2 bias = *(const f32x2*)(p.dw_b + cp * 2);
    const f32x2 g2 = *(const f32x2*)(p.ln_g + cp * 2), b2 = *(const f32x2*)(p.ln_b + cp * 2);
    __syncthreads();
    {
        bf16_t* dst = PC + (size_t)(r0 + th * TH) * DM + cp * 2; const int pos0 = t0 + th * TH;
        switch (cp >> 6) { case 0: pool_regs<2, TH>(u, pos0, dst); break; case 1: pool_regs<4, TH>(u, pos0, dst); break; case 2: pool_regs<8, TH>(u, pos0, dst); break; default: pool_regs<16, TH>(u, pos0, dst); break; }
    }
    f32x2* stats = (f32x2*)(shm + (T + 30) * 1024);
#pragma unroll 1
    for (int rd = 0; rd < ROUNDS; ++rd) {
        const int tt = rd * 16 + th * 8;
        f32x2 c[8];
#pragma unroll
        for (int i = 0; i < 8; ++i) c[i] = bias;
        unsigned win[38];
#pragma unroll
        for (int q = 0; q < 38; ++q) win[q] = l32[(tt + q) * 256 + cp];
#pragma unroll
        for (int q = 0; q < 38; ++q) { const f32x2 v = bf_unpack(win[q]);
#pragma unroll
            for (int i = 0; i < 8; ++i) if (q - i >= 0 && q - i < 31) c[i] += w2[q - i] * v;
            asm volatile("" : "+v"(c[0]), "+v"(c[1]), "+v"(c[2]), "+v"(c[3]), "+v"(c[4]), "+v"(c[5]), "+v"(c[6]), "+v"(c[7])); }
        { float r[16];
#pragma unroll
          for (int i = 0; i < 8; ++i) { r[2 * i] = c[i][0] + c[i][1]; r[2 * i + 1] = c[i][0] * c[i][0] + c[i][1] * c[i][1]; }
          wave_sum16_hi(r);
#pragma unroll
          for (int i = 0; i < 8; ++i) if (lane == 63) stats[(tt + i) * 4 + wv] = (f32x2){r[2 * i], r[2 * i + 1]}; }
        __syncthreads();
        float mean_l, rs_l;
        { const int ti = tt + (lane & 7);
          const f32x4 sa = *(const f32x4*)(stats + ti * 4), sb = *(const f32x4*)(stats + ti * 4 + 2);
          mean_l = (sa[0] + sa[2] + sb[0] + sb[2]) * (1.0f / 512.0f);
          const float var = (sa[1] + sa[3] + sb[1] + sb[3]) * (1.0f / 512.0f) - mean_l * mean_l;
          rs_l = __builtin_amdgcn_rsqf(var + 1e-5f); }
#pragma unroll
        for (int i = 0; i < 8; ++i) {
            const float mean = __builtin_bit_cast(float, __builtin_amdgcn_readlane(__builtin_bit_cast(int, mean_l), i));
            const float rs = __builtin_bit_cast(float, __builtin_amdgcn_readlane(__builtin_bit_cast(int, rs_l), i));
            const f32x2 y = (c[i] - mean) * rs * g2 + b2;
            *(unsigned*)(PC + (size_t)(r0 + tt + i) * DM + 512 + cp * 2) = cvt_pk_bf16(silu_f(y[0]), silu_f(y[1])); }
    }
    __syncthreads();
}

__device__ __forceinline__ void sample_token(const Params& p, unsigned char* shm, const int s) {
    const int tid = threadIdx.x, wid = tid >> 6, lane = tid & 63, b = s >> 4, t = s & 15, r = NPROMPT + s, ch = tid;
    const bf16_t* U = (const bf16_t*)(p.ws + WS_U); const bf16_t* V = (const bf16_t*)(p.ws + WS_V); bf16_t* PC = (bf16_t*)(p.ws + WS_PC);
    {
        const int w = 2 << (ch >> 7); float sum = 0.f, cur = 0.f;
#pragma unroll
        for (int j = 0; j < 16; ++j) if (j < w) { const int e = t + 15 - j;
            const float v = e < 15 ? p.cache_pool[((size_t)b * 15 + e) * 512 + ch] : __uint_as_float((unsigned)U[(size_t)(NPROMPT + b * 16 + e - 15) * DH + ch] << 16);
            sum += v; if (j == 0) cur = v; }
        const float o = sum / (float)w - cur;
        PC[(size_t)r * DM + ch] = (bf16_t)(cvt_pk_bf16(o, 0.f) & 0xffffu);
    }
    float c = p.dw_b[ch];
#pragma unroll
    for (int j = 0; j < 31; ++j) { const int e = t + j;
        const float v = e < 30 ? p.cache_conv[((size_t)b * 30 + e) * 512 + ch] : __uint_as_float((unsigned)V[(size_t)(NPROMPT + b * 16 + e - 30) * DH + ch] << 16);
        c += p.dw_w[j * 512 + ch] * v; }
    float s1 = wave_sum(c), s2 = wave_sum(c * c);
    f32x2* red = (f32x2*)shm;
    if (lane == 0) red[wid] = (f32x2){s1, s2};
    __syncthreads();
    s1 = 0.f; s2 = 0.f;
#pragma unroll
    for (int w8 = 0; w8 < 8; ++w8) { const f32x2 q = red[w8]; s1 += q[0]; s2 += q[1]; }
    const float mean = s1 * (1.0f / 512.0f), var = s2 * (1.0f / 512.0f) - mean * mean, rs = rsqrtf(var + 1e-5f);
    const float y = (c - mean) * rs * p.ln_g[ch] + p.ln_b[ch];
    PC[(size_t)r * DM + 512 + ch] = (bf16_t)(cvt_pk_bf16(silu_f(y), 0.f) & 0xffffu);
    __syncthreads();
}

__device__ __forceinline__ void wait_counters(unsigned* c0, unsigned t0, unsigned* c1, unsigned t1, unsigned* c2, unsigned t2) {
    if (threadIdx.x == 0) { unsigned sp = 0u;
        while (xb_ld(c0) < t0 || xb_ld(c1) < t1 || xb_ld(c2) < t2) { __builtin_amdgcn_s_sleep(1); if (++sp > (1u << 22)) break; }
        __builtin_amdgcn_fence(__ATOMIC_ACQUIRE, "agent"); asm volatile("s_waitcnt vmcnt(0)" ::: "memory"); }
    __syncthreads();
}
__device__ __forceinline__ void phase_mixer_pre(const Params& p, unsigned char* shm, const int gbase, int off, int len) {
    int tid = threadIdx.x; asm volatile("" : "+v"(tid));
    f32x2 w2[31];
    { const float* wp = p.dw_w + (tid & 255) * 2;
#pragma unroll
      for (int j = 0; j < 31; ++j) w2[j] = *(const f32x2*)(wp + j * 512); }
#pragma unroll 1
    while (len > 0) {
        const int take = (len >= 96 || len == 64) ? 64 : (len == 80 ? 48 : (len > 64 ? 32 : len)), r0 = gbase + off, t0 = r0 & (SEQ - 1);
        int tq = tid; asm volatile("" : "+v"(tq));
        if (take == 64) mixer_chunk<64>(p, shm, r0, t0, tq, w2); else if (take == 48) mixer_chunk<48>(p, shm, r0, t0, tq, w2); else mixer_chunk<32>(p, shm, r0, t0, tq, w2);
        off += take; len -= take;
    }
}

__global__ void __launch_bounds__(512, 2) hymba_fwd(Params p) {
    extern __shared__ __attribute__((aligned(16))) unsigned char shm[];
    LAS unsigned char* lds = (LAS unsigned char*)shm;
    const int G = gridDim.x, c = blockIdx.x;
    volatile LAS unsigned* st = (volatile LAS unsigned*)(lds + pg8::STAGE_BYTES);
    if (threadIdx.x == 0) { st[0] = 0u; st[1] = 0u; st[2] = 0u; st[3] = 0u; }
    __syncthreads();
    const XcdBarrier xb = xcd_barrier_post((unsigned*)(p.ws + WS_BAR), st);
    phase_prep(p, shm);
    xcd_barrier(xb);
    const bool uni = st[3] != 0u;
    const int gx = uni ? (int)xb.x : (c & 7), gl = uni ? (int)st[2] : (c >> 3);
    const int sidx = 32 * gx + gl;
    const int pm = 8 * gx + (gl & 7), pn = gl >> 3;
    const int n3 = gx < 2 ? 18 : 17;
    unsigned* cw = (unsigned*)(p.ws + WS_CNT);
    if (gl >= n3) {
        late_weight_prep(p, shm, (gx < 2 ? 14 * gx : 28 + 15 * (gx - 2)) + (gl - n3), 118);
        asm volatile("s_waitcnt vmcnt(0)" ::: "memory");
        __syncthreads();
        if (threadIdx.x == 0) { __builtin_amdgcn_fence(__ATOMIC_RELEASE, "agent"); asm volatile("s_waitcnt vmcnt(0)" ::: "memory"); (void)xb_add(cw + 64 * CW_LW, 1u); }
    }
    { SchedP1 S{(const char*)(p.ws + WS_XB), (const char*)(p.ws + WS_WIN), cw, gx, gl, uni};
      EpiP1 E{(bf16_t*)(p.ws + WS_U), (bf16_t*)(p.ws + WS_SGP), (bf16_t*)(p.ws + WS_V), (bf16_t*)(p.ws + WS_SGC), p.out};
      f32x4 acc[2][2][4][2]; pg8::gemm_phase(lds, DM, DM, S, E, acc); }
    if (uni) {
        const unsigned n_s8 = gx < 2 ? 16u : 8u;
        if (gl == 31) {
            wait_counters(cw + 64 * (CW_RV + gx), 384u, cw + 64 * (CW_SV + gx), n_s8, cw + 64 * (CW_SV + gx), n_s8);
            if (threadIdx.x == 0) { __builtin_amdgcn_fence(__ATOMIC_RELEASE, "agent"); asm volatile("s_waitcnt vmcnt(0)" ::: "memory"); (void)xb_add(cw + 64 * CW_GV, 1u); }
        }
        const bool halo = (gx & 1) && gl == n3;
        wait_counters(cw + 64 * (CW_RV + gx), 384u, cw + 64 * CW_GV, halo ? 8u : 0u, cw + 64 * CW_LW, 118u);
    } else xcd_barrier(xb);
    {
      const int E2 = 32 - n3; int off, len;
      if (!uni) { off = 64 * gl; len = 64; }
      else if (gl >= n3) { off = 96 * (gl - n3); len = 96; }
      else { const int remu = (2048 - 96 * E2) / 16, base = remu / n3, extra = remu % n3; off = 96 * E2 + 16 * (gl * base + (gl < extra ? gl : extra)); len = 16 * (base + (gl < extra ? 1 : 0)); }
      phase_mixer_pre(p, shm, 2048 * gx, off, len); }
    if (uni) wait_counters(cw + 64 * CW_GV, 8u, cw + 64 * CW_GV, 8u, cw + 64 * CW_GV, 8u);
    sample_token(p, shm, sidx);
    if (uni) xcc_barrier(xb, [] {}); else xcd_barrier(xb);
    { SchedP3 S{(const char*)(p.ws + WS_PC), (const char*)(p.ws + WS_MIX), (const char*)(p.ws + WS_PW), pm, pn};
      EpiP3 E{(const bf16_t*)(p.ws + WS_SGP), (const bf16_t*)(p.ws + WS_SGC), p.pw_b, (bf16_t*)(p.ws + WS_Z)};
      f32x4 acc[2][2][4][2]; pg8::gemm_phase(lds, DM, 512, S, E, acc); }
    if (pn < 2) { sample_p3(p, shm, sidx); sample_p3(p, shm, sidx + 16); }
    { SchedP4 S{(const char*)(p.ws + WS_Z), (const char*)(p.ws + WS_WOUT), pm, pn};
      EpiP4 E{p.x_prompt, p.final_g, p.out, (float*)(p.ws + WS_XS), (unsigned*)(p.ws + WS_CNT), (const float*)(p.ws + WS_SS), NPROMPT + sidx, uni};
      f32x4 acc[2][2][4][2]; pg8::Unit u4; const bool has4 = S.next(0, u4);
      int tid4 = threadIdx.x; asm volatile("" : "+v"(tid4));
      const int wid4 = __builtin_amdgcn_readfirstlane(tid4 >> 6), lane4 = tid4 & 63;
      const auto hook = [&] { if (has4) E.init(acc, u4, wid4 >> 2, wid4 & 3, lane4 & 15, lane4 >> 4); };
      if (uni) xcc_barrier(xb, hook); else xcd_barrier(xb, hook);
      sample_p4(p, shm, sidx);
      pg8::gemm_phase(lds, DM, DM, S, E, acc); }
}

extern "C" void kernel_launch(void* const* d_in, const int* in_sizes, int n_in, void* d_out, int out_size, void* d_ws, size_t ws_size, hipStream_t stream) {
    constexpr int LDS_BYTES = pg8::STAGE_BYTES + 16;
    static int grid = 0;
    if (grid == 0) {
        if (n_in != 16 || ws_size < WS_END) { fprintf(stderr, "kernel_launch: unexpected inputs (n_in %d, ws %zu)\n", n_in, ws_size); grid = -1; return; }
        int dev = 0, cus = 0, per_cu = 0;
        (void)hipGetDevice(&dev); (void)hipDeviceGetAttribute(&cus, hipDeviceAttributeMultiprocessorCount, dev);
        if (hipFuncSetAttribute((const void*)hymba_fwd, hipFuncAttributeMaxDynamicSharedMemorySize, LDS_BYTES) != hipSuccess) { fprintf(stderr, "kernel_launch: hipFuncSetAttribute failed\n"); grid = -1; return; }
        if (hipOccupancyMaxActiveBlocksPerMultiprocessor(&per_cu, (const void*)hymba_fwd, 512, LDS_BYTES) != hipSuccess || per_cu < 1) { fprintf(stderr, "kernel_launch: occupancy query says %d\n", per_cu); per_cu = 1; (void)hipGetLastError(); }
        if (cus < 256) { fprintf(stderr, "kernel_launch: built for a 256-CU device (got %d CUs)\n", cus); grid = -1; return; }
        grid = 256;
    }
    if (grid < 0) return;
    if (hipMemsetAsync((char*)d_ws + WS_BAR, 0, WS_CTL_BYTES, stream) != hipSuccess) { fprintf(stderr, "kernel_launch: memset of the barrier words failed\n"); return; }
    Params p{};
    p.x_prompt = (const float*)d_in[0]; p.x_sample = (const float*)d_in[1]; p.cache_pool = (const float*)d_in[2]; p.cache_conv = (const float*)d_in[3];
    p.norm_g = (const float*)d_in[4]; p.w_in = (const float*)d_in[5]; p.pool_mix = (const float*)d_in[6]; p.pool_scale = (const float*)d_in[7];
    p.dw_w = (const float*)d_in[8]; p.dw_b = (const float*)d_in[9]; p.ln_g = (const float*)d_in[10]; p.ln_b = (const float*)d_in[11];
    p.pw_w = (const float*)d_in[12]; p.pw_b = (const float*)d_in[13]; p.w_out = (const float*)d_in[14]; p.final_g = (const float*)d_in[15];
    p.out = (float*)d_out; p.ws = (unsigned char*)d_ws;
    void* args[] = {&p};
    hipError_t e = hipLaunchCooperativeKernel((const void*)hymba_fwd, dim3(grid), dim3(512), args, LDS_BYTES, stream);
    if (e != hipSuccess) fprintf(stderr, "kernel_launch: cooperative launch failed: %s (grid %d)\n", hipGetErrorString(e), grid);
}
```

```cpp
#include <hip/hip_runtime.h>
#include <cstdio>

#define LAS __attribute__((address_space(3)))
typedef unsigned short bf16_t;
typedef short bf16x8 __attribute__((ext_vector_type(8)));
typedef float f32x4 __attribute__((ext_vector_type(4)));
typedef float f32x2 __attribute__((ext_vector_type(2)));
typedef unsigned u32x4 __attribute__((ext_vector_type(4)));
typedef unsigned u32x2 __attribute__((ext_vector_type(2)));

constexpr int DM = 1024, NPROMPT = 16384, NSAMP = 256, MT = NPROMPT + NSAMP, DIN = 2560, DH = 512;
constexpr int SEQ = 4096, DSEQ = 16;
constexpr size_t O_Y = 0;
constexpr size_t O_SPP = (size_t)MT * DM;
constexpr size_t O_SCP = O_SPP + 4 * 15 * 512;
constexpr size_t O_SPS = O_SCP + 4 * 30 * 512;
constexpr size_t O_SCS = O_SPS + 16 * 15 * 512;
constexpr size_t WS_XB = 0;
constexpr size_t WS_WIN = WS_XB + (size_t)MT * DM * 2;
constexpr size_t WS_MIX = WS_WIN + (size_t)DIN * DM * 2;
constexpr size_t WS_PW = WS_MIX + (size_t)512 * 512 * 2;
constexpr size_t WS_WOUT = WS_PW + (size_t)512 * 512 * 2;
constexpr size_t WS_U = WS_WOUT + (size_t)1024 * 1024 * 2;
constexpr size_t WS_SGP = WS_U + (size_t)MT * DH * 2;
constexpr size_t WS_V = WS_SGP + (size_t)MT * DH * 2;
constexpr size_t WS_SGC = WS_V + (size_t)MT * DH * 2;
constexpr size_t WS_PC = WS_SGC + (size_t)MT * DH * 2;
constexpr size_t WS_Z = WS_PC + (size_t)MT * DM * 2;
constexpr size_t WS_SS = WS_Z + (size_t)MT * DM * 2;
constexpr size_t WS_BAR = (WS_SS + (size_t)MT * 4 + 255) / 256 * 256;
constexpr size_t WS_CNT = WS_BAR + 4608 * 4;
constexpr size_t WS_CTL_BYTES = 4608 * 4 + 96 * 256;
constexpr int CW_PIECES = 64, CW_RV = 65  , CW_SV = 73  , CW_GV = 81  , CW_LW = 82  ;
constexpr size_t WS_XS = WS_CNT + 96 * 256;
constexpr size_t WS_END = WS_XS + (size_t)64 * 4 * 256 * 4;

struct Params {
    const float* x_prompt; const float* x_sample; const float* cache_pool; const float* cache_conv; const float* norm_g; const float* w_in;
    const float* pool_mix; const float* pool_scale; const float* dw_w; const float* dw_b; const float* ln_g; const float* ln_b;
    const float* pw_w; const float* pw_b; const float* w_out; const float* final_g;
    float* out; unsigned char* ws;
};

__device__ __forceinline__ unsigned cvt_pk_bf16(float lo, float hi) { unsigned r; asm volatile("v_cvt_pk_bf16_f32 %0, %1, %2" : "=v"(r) : "v"(lo), "v"(hi)); return r; }
__device__ __forceinline__ float bf_lo(unsigned u) { return __uint_as_float(u << 16); }
__device__ __forceinline__ float bf_hi(unsigned u) { return __uint_as_float(u & 0xffff0000u); }
__device__ __forceinline__ f32x2 bf_unpack(unsigned u) { return (f32x2){bf_lo(u), bf_hi(u)}; }
__device__ __forceinline__ float sigmoid_f(float x) { return __builtin_amdgcn_rcpf(1.0f + __expf(-x)); }
__device__ __forceinline__ float silu_f(float x) { return x * sigmoid_f(x); }
__device__ __forceinline__ u32x4 pack8(f32x4 a, f32x4 b) { return (u32x4){cvt_pk_bf16(a[0], a[1]), cvt_pk_bf16(a[2], a[3]), cvt_pk_bf16(b[0], b[1]), cvt_pk_bf16(b[2], b[3])}; }
__device__ __forceinline__ float wave_sum(float v) {
#pragma unroll
    for (int o = 32; o > 0; o >>= 1) v += __shfl_xor(v, o);
    return v;
}


#define XB_TMO      128
#define XB_XCNT(j)  (256  + 64 * (j))
#define XB_XSUB(j)  (1280 + 64 * (j))
#define XB_XGEN(j)  (2304 + 64 * (j))
#define XB_TOP      3328
#define XB_TOPGEN   3392
#define XB_XLOC(j)  (3520 + 64 * (j))
#define XCD_BAR_WORDS 4608
#define XB_SPIN_CAP (1u << 18)
__device__ __forceinline__ unsigned xb_ld(unsigned* p)              { return __hip_atomic_load(p, __ATOMIC_RELAXED, __HIP_MEMORY_SCOPE_AGENT); }
__device__ __forceinline__ unsigned xb_add(unsigned* p, unsigned v) { return __hip_atomic_fetch_add(p, v, __ATOMIC_RELAXED, __HIP_MEMORY_SCOPE_AGENT); }
__device__ __forceinline__ unsigned xb_xcc_id() { return (unsigned)__builtin_amdgcn_s_getreg((3 << 11) | 20) & 0xFu; }
#define XB_SPIN(cond, bar) do { unsigned _sp = 0; while (cond) { __builtin_amdgcn_s_sleep(1); \
    if ((++_sp & 255u) == 0u) { if (xb_ld(&(bar)[XB_TMO])) break; if (_sp > XB_SPIN_CAP) { atomicAdd(&(bar)[XB_TMO], 1u); break; } } } } while (0)
struct XcdBarrier { unsigned* bar; unsigned x; volatile LAS unsigned* st; };
__device__ __forceinline__ XcdBarrier xcd_barrier_post(unsigned* bar, volatile LAS unsigned* st) {
    XcdBarrier b; b.bar = bar; b.x = xb_xcc_id(); b.st = st;
    if (threadIdx.x == 0) st[2] = xb_add(&bar[XB_XCNT(b.x)], 1u);
    return b;
}
__device__ __forceinline__ void xcd_barrier_complete(unsigned* bar, unsigned x, unsigned& nloc, unsigned& nx, unsigned& uni) {
    const unsigned G = gridDim.x * gridDim.y * gridDim.z;
    unsigned sum, cnt, mine, sp = 0u;
    for (;;) {
        sum = 0u; cnt = 0u; mine = 0u; uni = 1u;
#pragma unroll
        for (unsigned j = 0; j < 16; ++j) { const unsigned c = xb_ld(&bar[XB_XCNT(j)]); sum += c; cnt += (c > 0u) ? 1u : 0u; mine = (j == x) ? c : mine; uni = (c == (j < 8 ? 32u : 0u)) ? uni : 0u; }
        if (sum == G) break;
        __builtin_amdgcn_s_sleep(1);
        if ((++sp & 255u) == 0u) { if (xb_ld(&bar[XB_TMO])) break; if (sp > XB_SPIN_CAP) { atomicAdd(&bar[XB_TMO], 1u); break; } }
    }
    nloc = mine > 0u ? mine : 1u; nx = cnt > 0u ? cnt : 1u; uni = (sum == G) ? uni : 0u;
}
template <class Hook>
__device__ __forceinline__ void xcd_barrier(const XcdBarrier& b, const Hook& hook) {
    asm volatile("s_waitcnt vmcnt(0)" ::: "memory");
    __syncthreads();
    if (threadIdx.x >= 64) hook();
    if (threadIdx.x == 0) {
        unsigned* bar = b.bar;
        __builtin_amdgcn_s_waitcnt(0);
        unsigned nloc = b.st[0], nx = b.st[1];
        if (nloc == 0u) { unsigned uni; xcd_barrier_complete(bar, b.x, nloc, nx, uni); b.st[0] = nloc; b.st[1] = nx; b.st[3] = uni; }
        const unsigned old = xb_add(&bar[XB_XSUB(b.x)], 1u);
        const unsigned gen = old / nloc;
        if (old + 1u == (gen + 1u) * nloc) {
            __builtin_amdgcn_fence(__ATOMIC_RELEASE, "agent");
            asm volatile("s_waitcnt vmcnt(0)" ::: "memory");
            const unsigned og = xb_add(&bar[XB_TOP], 1u);
            const unsigned tg = og / nx;
            if (og + 1u == (tg + 1u) * nx) xb_add(&bar[XB_TOPGEN], 1u);
            else XB_SPIN(xb_ld(&bar[XB_TOPGEN]) == tg, bar);
            __builtin_amdgcn_fence(__ATOMIC_ACQUIRE, "agent");
            xb_add(&bar[XB_XGEN(b.x)], 1u);
            asm volatile("s_waitcnt vmcnt(0)" ::: "memory");
        } else {
            XB_SPIN(xb_ld(&bar[XB_XGEN(b.x)]) == gen, bar);
            __builtin_amdgcn_fence(__ATOMIC_ACQUIRE, "agent");
            asm volatile("s_waitcnt vmcnt(0)" ::: "memory");
        }
    }
    if (threadIdx.x < 64) hook();
    __syncthreads();
}
__device__ __forceinline__ void xcd_barrier(const XcdBarrier& b) { xcd_barrier(b, [] {}); }
template <class Hook>
__device__ __forceinline__ void xcc_barrier(const XcdBarrier& b, const Hook& hook) {
    asm volatile("s_waitcnt vmcnt(0)" ::: "memory");
    __syncthreads();
    if (threadIdx.x >= 64) hook();
    if (threadIdx.x == 0) {
        unsigned* w = &b.bar[XB_XLOC(b.x)];
        __builtin_amdgcn_s_waitcnt(0);
        const unsigned old = xb_add(w, 1u), target = (old / 32u + 1u) * 32u;
        XB_SPIN(xb_ld(w) < target, b.bar);
        __builtin_amdgcn_fence(__ATOMIC_ACQUIRE, "agent");
        asm volatile("s_waitcnt vmcnt(0)" ::: "memory");
    }
    if (threadIdx.x < 64) hook();
    __syncthreads();
}

namespace pg8 {
constexpr int BM = 256, BK = 64, HALF = 128, HTB = HALF * BK * 2, STAGE_BYTES = 8 * HTB, NXCD = 8, WGM = 8;
__device__ __forceinline__ int lds_byte(int r, int c) { const int st = (r >> 4) * 2 + (c >> 5), rr = r & 15, cc = c & 31, ob = rr * 64 + cc * 2; return st * 1024 + (ob ^ (((ob >> 9) & 1) << 5)); }
__device__ __forceinline__ void stage_rc(int b, int& R, int& C) { const int st = b / 1024, sb = b % 1024, swz = sb ^ (((sb >> 9) & 1) << 5); R = (st >> 1) * 16 + swz / 64; C = (st & 1) * 32 + (swz % 64) / 2; }
__device__ __forceinline__ int perm32(int rho) { const int n = rho >> 4, i = rho & 15; return 8 * (i >> 2) + 4 * n + (i & 3); }

struct Unit { const char* A; const char* B; int pm, pn, nt, kind; };

__device__ __forceinline__ bool tile_order(int i, int G, int c, int nM, int nN, int& pm, int& pn) {
    const int nwg = nM * nN; const long L = (long)i * G + c; if (L >= nwg) return false;
    int wgid = (int)L; { const int q = nwg / NXCD, r = nwg % NXCD, xcd = wgid % NXCD, off = wgid / NXCD; wgid = (xcd < r ? xcd * (q + 1) : r * (q + 1) + (xcd - r) * q) + off; }
    const int nig = WGM * nN, gid = wgid / nig, fm = gid * WGM, gsz = (nM - fm) < WGM ? (nM - fm) : WGM;
    pm = fm + ((wgid % nig) % gsz); pn = (wgid % nig) / gsz; return true;
}

template <class Epi, class Sched>
__device__ __forceinline__ void gemm_phase(LAS unsigned char* lds, const int lda, const int ldb, const Sched& S, const Epi& E, f32x4 (&acc)[2][2][4][2]) {
    int tid_ = threadIdx.x; asm volatile("" : "+v"(tid_));
    const int tid = tid_, wid = __builtin_amdgcn_readfirstlane(tid >> 6), lane = tid & 63, wr = wid >> 2, wc = wid & 3, fr = lane & 15, fq = lane >> 4;
    unsigned voffA[2], voffB[2];
#pragma unroll
    for (int i = 0; i < 2; ++i) { int R, C; stage_rc(tid * 16 + i * 8192, R, C); const int Rb = Epi::PERM ? ((R & ~31) + perm32(R & 31)) : R;
        voffA[i] = (unsigned)(R * lda + C) * 2u; voffB[i] = (unsigned)(Rb * ldb + C) * 2u; }
    const size_t kstep = (size_t)(BK * 2);
    const size_t hstepA = (size_t)HALF * lda * 2, hstepB = (size_t)HALF * ldb * 2;
    const unsigned ldsw = (unsigned)wid * 1024u;
    const int aoff = lds_byte(wr * 64 + fr, fq * 8), boff = lds_byte(wc * 32 + fr, fq * 8);
#define PG8_SA(b, h) (((b) * 2 + (h)) * HTB)
#define PG8_SB(b, h) ((4 + (b) * 2 + (h)) * HTB)
#define PG8_STAGE(bufoff, gbase, voff) do { _Pragma("unroll") for (int _i = 0; _i < 2; ++_i) \
        __builtin_amdgcn_global_load_lds((const unsigned*)((const char*)(gbase) + (voff)[_i]), (LAS unsigned*)(lds + (bufoff) + ldsw + _i * 8192), 16, 0, 0); } while (0)
#define PG8_LDA(dst, b, h) do { _Pragma("unroll") for (int m = 0; m < 4; ++m) _Pragma("unroll") for (int k = 0; k < 2; ++k) dst[m][k] = *(const LAS bf16x8*)(lds + PG8_SA(b, h) + aoff + m * 2048 + k * 1024); } while (0)
#define PG8_LDB(dst, b, h) do { _Pragma("unroll") for (int n = 0; n < 2; ++n) _Pragma("unroll") for (int k = 0; k < 2; ++k) dst[n][k] = *(const LAS bf16x8*)(lds + PG8_SB(b, h) + boff + n * 2048 + k * 1024); } while (0)
#define PG8_MMA(ai, bj, At, Bt) do { __builtin_amdgcn_s_setprio(1); _Pragma("unroll") for (int m = 0; m < 4; ++m) _Pragma("unroll") for (int n = 0; n < 2; ++n) _Pragma("unroll") for (int k = 0; k < 2; ++k) \
        acc[ai][bj][m][n] = __builtin_amdgcn_mfma_f32_16x16x32_bf16(Bt[n][k], At[m][k], acc[ai][bj][m][n], 0, 0, 0); __builtin_amdgcn_s_setprio(0); } while (0)
#define PG8_WAIT_V(n) asm volatile("s_waitcnt vmcnt(" #n ")" ::: "memory")
#define PG8_WAIT_L(n) asm volatile("s_waitcnt lgkmcnt(" #n ")" ::: "memory")
#define PG8_BAR __builtin_amdgcn_s_barrier()
#define PG8_SCHED __builtin_amdgcn_sched_barrier(0)
    Unit cur, nxt; int ui = 0;
    if (!S.next(0, cur)) return;
    if constexpr (!Epi::EXT_INIT) E.init(acc, cur, wr, wc, fr, fq);
    bf16x8 At[4][2], B0[2][2], B1[2][2];
    const char* cA = cur.A; const char* cB = cur.B;
    PG8_STAGE(PG8_SB(0, 0), cB, voffB); PG8_STAGE(PG8_SA(0, 0), cA, voffA); PG8_STAGE(PG8_SB(0, 1), cB + hstepB, voffB); PG8_STAGE(PG8_SA(0, 1), cA + hstepA, voffA);
    if (wr == 1) PG8_BAR;
    PG8_WAIT_V(4); PG8_BAR;
    PG8_STAGE(PG8_SB(1, 0), cB + kstep, voffB); PG8_STAGE(PG8_SA(1, 0), cA + kstep, voffA); PG8_STAGE(PG8_SB(1, 1), cB + hstepB + kstep, voffB);
    PG8_WAIT_V(6); PG8_BAR;
    for (;;) {
        const bool has_next = S.next(ui + 1, nxt);
        const char* nA = has_next ? nxt.A : cA; const char* nB = has_next ? nxt.B : cB;
        const int nt = cur.nt;
        for (int t = 0; t < nt; t += 2) {
            const bool last = (t == nt - 2);
            const char* a1 = cA + (size_t)(t + 1) * kstep;
            const char* a2 = last ? nA : cA + (size_t)(t + 2) * kstep; const char* b2 = last ? nB : cB + (size_t)(t + 2) * kstep;
            const char* a3 = a2 + kstep; const char* b3 = b2 + kstep;
            bool m0 = true, m1 = true;
            if constexpr (Epi::ZSKIP) { if (cur.kind == 3) { m0 = t < 2; m1 = t >= 2; } }
            PG8_LDB(B0, 0, 0); PG8_SCHED; PG8_LDA(At, 0, 0); PG8_STAGE(PG8_SA(1, 1), a1 + hstepA, voffA);
            PG8_WAIT_L(8); PG8_BAR; PG8_WAIT_L(0); if (m0) PG8_MMA(0, 0, At, B0); PG8_BAR; PG8_SCHED;
            PG8_LDB(B1, 0, 1); PG8_STAGE(PG8_SB(0, 0), b2, voffB);
            PG8_BAR; PG8_WAIT_L(0); if (m1) PG8_MMA(0, 1, At, B1); PG8_BAR;
            PG8_LDA(At, 0, 1); PG8_STAGE(PG8_SA(0, 0), a2, voffA);
            PG8_BAR; PG8_WAIT_L(0); if (m0) PG8_MMA(1, 0, At, B0); PG8_BAR; PG8_SCHED;
            PG8_STAGE(PG8_SB(0, 1), b2 + hstepB, voffB);
            PG8_WAIT_V(6); PG8_BAR; if (m1) PG8_MMA(1, 1, At, B1); PG8_BAR;
            PG8_LDB(B0, 1, 0); PG8_SCHED; PG8_LDA(At, 1, 0); PG8_STAGE(PG8_SA(0, 1), a2 + hstepA, voffA);
            PG8_WAIT_L(8); PG8_BAR; PG8_WAIT_L(0); if (m0) PG8_MMA(0, 0, At, B0); PG8_BAR; PG8_SCHED;
            PG8_LDB(B1, 1, 1); PG8_STAGE(PG8_SB(1, 0), b3, voffB);
            PG8_BAR; PG8_WAIT_L(0); if (m1) PG8_MMA(0, 1, At, B1); PG8_BAR;
            PG8_LDA(At, 1, 1); PG8_STAGE(PG8_SA(1, 0), a3, voffA);
            PG8_BAR; PG8_WAIT_L(0); if (m0) PG8_MMA(1, 0, At, B0); PG8_BAR; PG8_SCHED;
            PG8_STAGE(PG8_SB(1, 1), b3 + hstepB, voffB);
            PG8_WAIT_V(6); PG8_BAR; if (m1) PG8_MMA(1, 1, At, B1); PG8_BAR;
        }
        if constexpr (!Epi::AFTER_DRAIN) { E(acc, cur, wr, wc, fr, fq); S.done(cur, ui, lane); }
        if (!has_next) break;
        cur = nxt; cA = nA; cB = nB; ++ui;
        E.init(acc, cur, wr, wc, fr, fq);
    }
    PG8_WAIT_V(0);
    if (wr == 0) PG8_BAR;
    PG8_BAR;
    if constexpr (Epi::AFTER_DRAIN) E.fused(acc, cur, wr, wc, fr, fq, lds, tid);
#undef PG8_SA
#undef PG8_SB
#undef PG8_STAGE
#undef PG8_LDA
#undef PG8_LDB
#undef PG8_MMA
#undef PG8_WAIT_V
#undef PG8_WAIT_L
#undef PG8_BAR
#undef PG8_SCHED
}
}

struct SchedP1 {
    const char* xb; const char* win; unsigned* cnt; int gx, gl; bool uni;
    __device__ __forceinline__ bool next(int i, pg8::Unit& u) const {
        const int n_s = gx < 2 ? 2 : 1, j = gl + 32 * i; if (j >= 80 + n_s) return false;
        int pm, pn, kind;
        if (j < n_s) { pm = NPROMPT / 256; pn = gx + 8 * j; kind = 2; }
        else if (j < n_s + 48) { const int k = j - n_s, q = k >> 3; pm = 8 * gx + (k & 7); pn = q < 2 ? q : q + 2; kind = 1; }
        else { const int k = j - n_s - 48, q = k >> 3; pm = 8 * gx + (k & 7); pn = q < 2 ? q + 2 : q + 6; kind = 0; }
        u.pm = pm; u.pn = pn; u.kind = kind; u.nt = 16; u.A = xb + (size_t)pm * 256 * DM * 2; u.B = win + (size_t)pn * 256 * DM * 2; return true;
    }
    __device__ __forceinline__ void done(const pg8::Unit&, int ui, int lane) const {
        if (!uni) return;
        const int n_s = gx < 2 ? 2 : 1, nuv = gl < n_s + 16 ? 2 : 1;
        if (ui != nuv - 1) return;
        asm volatile("s_waitcnt vmcnt(0)" ::: "memory");
        if (lane == 0) { const int sm = gl < n_s ? 1 : 0, uv = nuv - sm;
            (void)xb_add(cnt + 64 * (CW_RV + gx), (unsigned)uv);
            if (sm) (void)xb_add(cnt + 64 * (CW_SV + gx), 1u); }
    }
};
struct EpiP1 {
    static constexpr bool PERM = true, AFTER_DRAIN = false, EXT_INIT = false, ZSKIP = false;
    bf16_t* U; bf16_t* SGP; bf16_t* V; bf16_t* SGC; float* out;
    __device__ __forceinline__ void init(f32x4 (&acc)[2][2][4][2], const pg8::Unit&, int, int, int, int) const {
#pragma unroll
        for (int a = 0; a < 2; ++a)
#pragma unroll
            for (int b = 0; b < 2; ++b)
#pragma unroll
                for (int m = 0; m < 4; ++m)
#pragma unroll
                    for (int n = 0; n < 2; ++n) acc[a][b][m][n] = (f32x4){0.f, 0.f, 0.f, 0.f};
    }
    __device__ __forceinline__ void operator()(const f32x4 (&acc)[2][2][4][2], const pg8::Unit& u, int wr, int wc, int fr, int fq) const {
        const int pn = u.pn, row0 = u.pm * 256 + wr * 64 + fr, cl = wc * 32 + 8 * fq;
        if (pn < 2) {
#pragma unroll
            for (int ai = 0; ai < 2; ++ai)
#pragma unroll
                for (int m = 0; m < 4; ++m) {
                    const int r = row0 + ai * 128 + m * 16; bool st; size_t so;
                    if (r < NPROMPT) { const int t = r & (SEQ - 1); st = t >= SEQ - 15; so = O_SPP + ((size_t)(r >> 12) * 15 + (t - (SEQ - 15))) * 512; }
                    else { const int s = r - NPROMPT, t = s & 15; st = t >= 1; so = O_SPS + ((size_t)(s >> 4) * 15 + (t - 1)) * 512; }
#pragma unroll
                    for (int bj = 0; bj < 2; ++bj) { const int c = pn * 256 + bj * 128 + cl; const f32x4 v0 = acc[ai][bj][m][0], v1 = acc[ai][bj][m][1];
                        *(u32x4*)(U + (size_t)r * DH + c) = pack8(v0, v1);
                        if (st) { *(f32x4*)(out + so + c) = v0; *(f32x4*)(out + so + c + 4) = v1; } }
                }
        } else if (pn < 4 || pn >= 8) {
            bf16_t* dst = pn < 4 ? SGP : SGC; const int cb = (pn < 4 ? pn - 2 : pn - 8) * 256 + cl;
#pragma unroll
            for (int ai = 0; ai < 2; ++ai)
#pragma unroll
                for (int m = 0; m < 4; ++m) { const int r = row0 + ai * 128 + m * 16;
#pragma unroll
                    for (int bj = 0; bj < 2; ++bj) { f32x4 v0 = acc[ai][bj][m][0], v1 = acc[ai][bj][m][1];
#pragma unroll
                        for (int j = 0; j < 4; ++j) { v0[j] = silu_f(v0[j]); v1[j] = silu_f(v1[j]); }
                        *(u32x4*)(dst + (size_t)r * DH + cb + bj * 128) = pack8(v0, v1); }
                }
        } else {
            const int c = (pn - 4) * 128 + cl;
#pragma unroll
            for (int ai = 0; ai < 2; ++ai)
#pragma unroll
                for (int m = 0; m < 4; ++m) {
                    const int r = row0 + ai * 128 + m * 16; bool st; size_t so;
                    if (r < NPROMPT) { const int t = r & (SEQ - 1); st = t >= SEQ - 30; so = O_SCP + ((size_t)(r >> 12) * 30 + (t - (SEQ - 30))) * 512; }
                    else { const int s = r - NPROMPT, t = s & 15; st = true; so = O_SCS + ((size_t)(s >> 4) * 30 + 14 + t) * 512; }
                    f32x4 v0 = acc[ai][0][m][0], v1 = acc[ai][0][m][1]; const f32x4 g0 = acc[ai][1][m][0], g1 = acc[ai][1][m][1];
#pragma unroll
                    for (int j = 0; j < 4; ++j) { v0[j] *= sigmoid_f(g0[j]); v1[j] *= sigmoid_f(g1[j]); }
                    *(u32x4*)(V + (size_t)r * DH + c) = pack8(v0, v1);
                    if (st) { *(f32x4*)(out + so + c) = v0; *(f32x4*)(out + so + c + 4) = v1; }
                }
        }
    }
};

struct SchedP3 {
    const char* pc; const char* mix; const char* pw; int pm0, pn0;
    __device__ __forceinline__ void done(const pg8::Unit&, int, int) const {}
    __device__ __forceinline__ bool next(int i, pg8::Unit& u) const {
        if (i != 0) return false; const int pm = pm0, pn = pn0;
        u.pm = pm; u.pn = pn; u.kind = 0;
        if (pn < 2) { u.kind = 3; u.nt = 4; u.A = pc + ((size_t)pm * 256 * DM + 256 * pn) * 2; u.B = mix + ((size_t)pn * 256 * 512 + 256 * pn) * 2; }
        else { u.nt = 8; u.A = pc + ((size_t)pm * 256 * DM + 512) * 2; u.B = pw + (size_t)(pn - 2) * 256 * 512 * 2; }
        return true;
    }
};
struct EpiP3 {
    static constexpr bool PERM = true, AFTER_DRAIN = false, EXT_INIT = false, ZSKIP = true;
    const bf16_t* SGP; const bf16_t* SGC; const float* pw_b; bf16_t* Z;
    __device__ __forceinline__ void init(f32x4 (&acc)[2][2][4][2], const pg8::Unit&, int, int, int, int) const {
#pragma unroll
        for (int a = 0; a < 2; ++a)
#pragma unroll
            for (int b = 0; b < 2; ++b)
#pragma unroll
                for (int m = 0; m < 4; ++m)
#pragma unroll
                    for (int n = 0; n < 2; ++n) acc[a][b][m][n] = (f32x4){0.f, 0.f, 0.f, 0.f};
    }
    __device__ __forceinline__ void operator()(const f32x4 (&acc)[2][2][4][2], const pg8::Unit& u, int wr, int wc, int fr, int fq) const {
        const int pn = u.pn, row0 = u.pm * 256 + wr * 64 + fr, cl = wc * 32 + 8 * fq;
        const bool conv = pn >= 2; const bf16_t* gate = conv ? SGC : SGP; const int cb = (conv ? pn - 2 : pn) * 256 + cl;
        f32x4 bv[2][2];
#pragma unroll
        for (int bj = 0; bj < 2; ++bj)
#pragma unroll
            for (int n = 0; n < 2; ++n) bv[bj][n] = conv ? *(const f32x4*)(pw_b + cb + bj * 128 + 4 * n) : (f32x4){0.f, 0.f, 0.f, 0.f};
#pragma unroll
        for (int ai = 0; ai < 2; ++ai) {
            u32x4 gt[4][2];
#pragma unroll
            for (int m = 0; m < 4; ++m)
#pragma unroll
                for (int bj = 0; bj < 2; ++bj) gt[m][bj] = *(const u32x4*)(gate + (size_t)(row0 + ai * 128 + m * 16) * DH + cb + bj * 128);
#pragma unroll
            for (int m = 0; m < 4; ++m) { const int r = row0 + ai * 128 + m * 16;
#pragma unroll
                for (int bj = 0; bj < 2; ++bj) { const int c = cb + bj * 128; const u32x4 g = gt[m][bj];
                    f32x4 v0 = acc[ai][bj][m][0] + bv[bj][0], v1 = acc[ai][bj][m][1] + bv[bj][1];
                    v0[0] *= bf_lo(g[0]); v0[1] *= bf_hi(g[0]); v0[2] *= bf_lo(g[1]); v0[3] *= bf_hi(g[1]);
                    v1[0] *= bf_lo(g[2]); v1[1] *= bf_hi(g[2]); v1[2] *= bf_lo(g[3]); v1[3] *= bf_hi(g[3]);
                    *(u32x4*)(Z + (size_t)r * DM + (conv ? 512 : 0) + c) = pack8(v0, v1); }
            }
        }
    }
};

struct SchedP4 {
    const char* z; const char* wout; int pm0, pn0;
    __device__ __forceinline__ void done(const pg8::Unit&, int, int) const {}
    __device__ __forceinline__ bool next(int i, pg8::Unit& u) const {
        if (i != 0) return false; const int pm = pm0, pn = pn0;
        u.pm = pm; u.pn = pn; u.kind = 0; u.nt = 16; u.A = z + (size_t)pm * 256 * DM * 2; u.B = wout + (size_t)pn * 256 * DM * 2; return true;
    }
};
struct EpiP4 {
    static constexpr bool PERM = false, AFTER_DRAIN = true, EXT_INIT = true, ZSKIP = false;
    const float* x_prompt; const float* final_g; float* out; float* xs; unsigned* cnt; const float* ss; int srow; bool uni;
    __device__ __forceinline__ void init(f32x4 (&acc)[2][2][4][2], const pg8::Unit& u, int wr, int wc, int fr, int fq) const {
        const int row0 = u.pm * 256 + wr * 64 + fr, col0 = u.pn * 256 + wc * 32 + 4 * fq;
#pragma unroll
        for (int ai = 0; ai < 2; ++ai)
#pragma unroll
            for (int m = 0; m < 4; ++m) { const float* xr = x_prompt + (size_t)(row0 + ai * 128 + m * 16) * DM + col0;
#pragma unroll
                for (int bj = 0; bj < 2; ++bj)
#pragma unroll
                    for (int n = 0; n < 2; ++n) acc[ai][bj][m][n] = *(const f32x4*)(xr + bj * 128 + n * 16); }
    }
    __device__ __forceinline__ void fused(const f32x4 (&acc)[2][2][4][2], const pg8::Unit& u, int wr, int wc, int fr, int fq, LAS unsigned char* lds, int tid) const {
        LAS float* lss = (LAS float*)lds;
#pragma unroll
        for (int ai = 0; ai < 2; ++ai)
#pragma unroll
            for (int m = 0; m < 4; ++m) { float s = 0.f;
#pragma unroll
                for (int bj = 0; bj < 2; ++bj)
#pragma unroll
                    for (int n = 0; n < 2; ++n) { const f32x4 y = acc[ai][bj][m][n]; s += y[0] * y[0] + y[1] * y[1] + y[2] * y[2] + y[3] * y[3]; }
                s += __shfl_xor(s, 16); s += __shfl_xor(s, 32);
                if (fq == 0) lss[(ai * 128 + wr * 64 + m * 16 + fr) * 4 + wc] = s; }
        __syncthreads();
        if (tid < 256) { const f32x4 v = *(const LAS f32x4*)(lss + tid * 4); xs[((size_t)u.pm * 4 + u.pn) * 256 + tid] = v[0] + v[1] + v[2] + v[3]; }
        asm volatile("s_waitcnt vmcnt(0)" ::: "memory");
        __syncthreads();
        if (tid == 0) {
            unsigned* cw = cnt + 64 * u.pm; unsigned* cs = cnt + 64 * CW_PIECES;
            if (!uni) __builtin_amdgcn_fence(__ATOMIC_RELEASE, "agent");
            asm volatile("s_waitcnt vmcnt(0)" ::: "memory");
            (void)xb_add(cw, 1u);
            unsigned sp = 0u;
            while (xb_ld(cw) < 4u || xb_ld(cs) < 256u) { __builtin_amdgcn_s_sleep(1); if (++sp > (1u << 22)) break; }
            __builtin_amdgcn_fence(__ATOMIC_ACQUIRE, "agent");
            asm volatile("s_waitcnt vmcnt(0)" ::: "memory");
        }
        __syncthreads();
        if (tid >= 256) { const int t4 = (tid - 256) * 4; const float rs = rsqrtf(ss[srow] * (1.0f / DM) + 1e-6f); float* yr = out + (size_t)srow * DM + t4;
            *(f32x4*)yr = *(const f32x4*)yr * rs * *(const f32x4*)(final_g + t4); }
        if (tid < 256) { const float* xp = xs + (size_t)u.pm * 4 * 256 + tid; const float tot = xp[0] + xp[256] + xp[512] + xp[768];
            lss[1024 + tid] = rsqrtf(tot * (1.0f / DM) + 1e-6f); }
        __syncthreads();
        const int row0 = u.pm * 256 + wr * 64 + fr, col0 = u.pn * 256 + wc * 32 + 4 * fq;
        f32x4 g4[2][2];
#pragma unroll
        for (int bj = 0; bj < 2; ++bj)
#pragma unroll
            for (int n = 0; n < 2; ++n) g4[bj][n] = *(const f32x4*)(final_g + col0 + bj * 128 + n * 16);
#pragma unroll
        for (int ai = 0; ai < 2; ++ai)
#pragma unroll
            for (int m = 0; m < 4; ++m) { const float rs = lss[1024 + ai * 128 + wr * 64 + m * 16 + fr]; float* yr = out + (size_t)(row0 + ai * 128 + m * 16) * DM + col0;
#pragma unroll
                for (int bj = 0; bj < 2; ++bj)
#pragma unroll
                    for (int n = 0; n < 2; ++n) *(f32x4*)(yr + bj * 128 + n * 16) = acc[ai][bj][m][n] * rs * g4[bj][n]; }
    }
    __device__ __forceinline__ void operator()(const f32x4 (&)[2][2][4][2], const pg8::Unit&, int, int, int, int) const {}
};

template <int NF>
__device__ __forceinline__ f32x4 small_gemm(const bf16_t* __restrict__ A, int lda, const bf16_t* __restrict__ Bt, int ldb, int K, int nw, f32x4* red) {
    const int tid = threadIdx.x, wid = tid >> 6, lane = tid & 63, fr = lane & 15, fq = lane >> 4;
    f32x4 acc[NF];
#pragma unroll
    for (int f = 0; f < NF; ++f) acc[f] = (f32x4){0.f, 0.f, 0.f, 0.f};
    if (wid < nw) { const int ks = K / nw; const bf16_t* ap = A + (size_t)fr * lda + wid * ks + fq * 8; const bf16_t* bp = Bt + (size_t)fr * ldb + wid * ks + fq * 8;
        for (int k = 0; k < ks; k += 32) { const bf16x8 a = *(const bf16x8*)(ap + k);
#pragma unroll
            for (int f = 0; f < NF; ++f) { const bf16x8 b = *(const bf16x8*)(bp + (size_t)f * 16 * ldb + k); acc[f] = __builtin_amdgcn_mfma_f32_16x16x32_bf16(b, a, acc[f], 0, 0, 0); } } }
#pragma unroll
    for (int f = 0; f < NF; ++f) red[(wid * NF + f) * 64 + lane] = acc[f];
    __syncthreads();
    f32x4 r = (f32x4){0.f, 0.f, 0.f, 0.f};
    if (tid < 64 * NF) {
#pragma unroll
        for (int w = 0; w < 8; ++w) r += red[(w * NF + wid) * 64 + lane]; }
    return r;
}
__device__ __forceinline__ void sample_p3(const Params& p, unsigned char* shm, const int i) {
    const int tid = threadIdx.x, wid = tid >> 6, lane = tid & 63, fr = lane & 15, fq = lane >> 4; f32x4* red = (f32x4*)shm;
    const bf16_t* PC = (const bf16_t*)(p.ws + WS_PC); bf16_t* Z = (bf16_t*)(p.ws + WS_Z);
    { const int rb = i >> 4, cb = i & 15, row0 = NPROMPT + rb * 16, row = row0 + fr, c = 32 * cb + 16 * wid + 4 * fq;
        {
            const f32x4 r = small_gemm<2>(PC + (size_t)row0 * DM + 512, DM, (const bf16_t*)(p.ws + WS_PW) + (size_t)32 * cb * 512, 512, 512, 8, red);
            if (tid < 128) { const f32x4 bv = *(const f32x4*)(p.pw_b + c); const u32x2 g = *(const u32x2*)((const bf16_t*)(p.ws + WS_SGC) + (size_t)row * DH + c);
                const f32x4 z = (r + bv) * (f32x4){bf_lo(g[0]), bf_hi(g[0]), bf_lo(g[1]), bf_hi(g[1])};
                *(u32x2*)(Z + (size_t)row * DM + 512 + c) = (u32x2){cvt_pk_bf16(z[0], z[1]), cvt_pk_bf16(z[2], z[3])}; }
            __syncthreads();
        }
        {
            const int g128 = (cb >> 2) * 128;
            const f32x4 r = small_gemm<2>(PC + (size_t)row0 * DM + g128, DM, (const bf16_t*)(p.ws + WS_MIX) + (size_t)32 * cb * 512 + g128, 512, 128, 4, red);
            if (tid < 128) { const u32x2 g = *(const u32x2*)((const bf16_t*)(p.ws + WS_SGP) + (size_t)row * DH + c);
                const f32x4 z = r * (f32x4){bf_lo(g[0]), bf_hi(g[0]), bf_lo(g[1]), bf_hi(g[1])};
                *(u32x2*)(Z + (size_t)row * DM + c) = (u32x2){cvt_pk_bf16(z[0], z[1]), cvt_pk_bf16(z[2], z[3])}; }
            __syncthreads();
        }
    }
}
__device__ __forceinline__ void sample_p4(const Params& p, unsigned char* shm, const int i, const bool uni) {
    const int tid = threadIdx.x, wid = tid >> 6, lane = tid & 63, fr = lane & 15, fq = lane >> 4; f32x4* red = (f32x4*)shm;
    float* ss = (float*)(p.ws + WS_SS);
    { const int rb = i >> 4, cb = i & 15, row0 = NPROMPT + rb * 16, row = row0 + fr, c = 64 * cb + 16 * wid + 4 * fq;
        const f32x4 r = small_gemm<4>((const bf16_t*)(p.ws + WS_Z) + (size_t)row0 * DM, DM, (const bf16_t*)(p.ws + WS_WOUT) + (size_t)64 * cb * DM, DM, DM, 8, red);
        if (tid < 256) { const f32x4 y = r + *(const f32x4*)(p.x_sample + (size_t)(row - NPROMPT) * DM + c);
            *(f32x4*)(p.out + (size_t)row * DM + c) = y;
            float s = y[0] * y[0] + y[1] * y[1] + y[2] * y[2] + y[3] * y[3]; s += __shfl_xor(s, 16); s += __shfl_xor(s, 32);
            if (fq == 0) atomicAdd(ss + row, s); }
        asm volatile("s_waitcnt vmcnt(0)" ::: "memory");
        __syncthreads();
        if (tid == 0) { if (!uni) __builtin_amdgcn_fence(__ATOMIC_RELEASE, "agent"); asm volatile("s_waitcnt vmcnt(0)" ::: "memory"); (void)xb_add((unsigned*)(p.ws + WS_CNT) + 64 * CW_PIECES, 1u); }
    }
}
__device__ __forceinline__ void transpose_load(const float* __restrict__ src, int ldsrc, int k0, int n0s, f32x4 (&v)[2]) {
    const int tid = threadIdx.x, kk = tid >> 4, n4 = (tid & 15) * 4;
#pragma unroll
    for (int i = 0; i < 2; ++i) v[i] = *(const f32x4*)(src + (size_t)(k0 + kk + 32 * i) * ldsrc + n0s + n4);
}
__device__ __forceinline__ void transpose_store(const f32x4 (&v)[2], int k0, bf16_t* __restrict__ dst, int ldd, int n0d, float* tile) {
    const int tid = threadIdx.x;
    {
        const int kk = tid >> 4, n4 = (tid & 15) * 4;
#pragma unroll
        for (int i = 0; i < 2; ++i) { const int k = kk + 32 * i;
            tile[k * 65 + n4 + 0] = v[i][0]; tile[k * 65 + n4 + 1] = v[i][1]; tile[k * 65 + n4 + 2] = v[i][2]; tile[k * 65 + n4 + 3] = v[i][3]; }
    }
    __syncthreads();
    {
        const int n = tid >> 3, k8 = (tid & 7) * 8; float w[8];
#pragma unroll
        for (int j = 0; j < 8; ++j) w[j] = tile[(k8 + j) * 65 + n];
        *(u32x4*)(dst + (size_t)(n0d + n) * ldd + k0 + k8) = (u32x4){cvt_pk_bf16(w[0], w[1]), cvt_pk_bf16(w[2], w[3]), cvt_pk_bf16(w[4], w[5]), cvt_pk_bf16(w[6], w[7])};
    }
    __syncthreads();
}
__device__ __forceinline__ void transpose_tile(const float* __restrict__ src, int ldsrc, int k0, int n0s, bf16_t* __restrict__ dst, int ldd, int n0d, float* tile) {
    f32x4 v[2]; transpose_load(src, ldsrc, k0, n0s, v); transpose_store(v, k0, dst, ldd, n0d, tile);
}
__device__ __forceinline__ int win_src_col(int n0) {
    if (n0 >= 1024 && n0 < 2048) { const int q = n0 - 1024, j = q >> 8, i = q & 255; return i < 128 ? 1024 + 128 * j + i : 1536 + 128 * j + (i - 128); }
    return n0;
}

__device__ __forceinline__ void phase_prep(const Params& p, unsigned char* shm) {
    const int tid = threadIdx.x, wid = tid >> 6, lane = tid & 63, nb = gridDim.x, bid = blockIdx.x;
    bf16_t* xb = (bf16_t*)(p.ws + WS_XB);
    constexpr int T_IN = 16 * 40;
    f32x4 tv[3][2];
#pragma unroll
    for (int q = 0; q < 3; ++q) { const int t = bid + q * nb; if (t < T_IN) transpose_load(p.w_in, DIN, (t / 40) * 64, win_src_col((t % 40) * 64), tv[q]); }
    {
        f32x4 g4[4];
#pragma unroll
        for (int i = 0; i < 4; ++i) g4[i] = *(const f32x4*)(p.norm_g + lane * 4 + 256 * i);
        for (int g = bid * 8 + wid; g < MT / 4; g += nb * 8) {
            f32x4 v[4][4]; float s[4];
#pragma unroll
            for (int q = 0; q < 4; ++q) { const int r = g * 4 + q; const float* xr = r < NPROMPT ? p.x_prompt + (size_t)r * DM : p.x_sample + (size_t)(r - NPROMPT) * DM;
#pragma unroll
                for (int i = 0; i < 4; ++i) v[q][i] = *(const f32x4*)(xr + lane * 4 + 256 * i); }
#pragma unroll
            for (int q = 0; q < 4; ++q) { s[q] = 0.f;
#pragma unroll
                for (int i = 0; i < 4; ++i) s[q] += v[q][i][0] * v[q][i][0] + v[q][i][1] * v[q][i][1] + v[q][i][2] * v[q][i][2] + v[q][i][3] * v[q][i][3];
                s[q] = wave_sum(s[q]); }
#pragma unroll
            for (int q = 0; q < 4; ++q) { const int r = g * 4 + q; const float rs = rsqrtf(s[q] * (1.0f / DM) + 1e-6f);
#pragma unroll
                for (int i = 0; i < 4; ++i) { const f32x4 h = v[q][i] * rs * g4[i];
                    *(u32x2*)(xb + (size_t)r * DM + lane * 4 + 256 * i) = (u32x2){cvt_pk_bf16(h[0], h[1]), cvt_pk_bf16(h[2], h[3])}; } }
        }
    }
    {
        float* tile = (float*)shm; bf16_t* win = (bf16_t*)(p.ws + WS_WIN);
#pragma unroll
        for (int q = 0; q < 3; ++q) { const int t = bid + q * nb; if (t < T_IN) transpose_store(tv[q], (t / 40) * 64, win, DM, (t % 40) * 64, tile); }
        for (int t = bid + 3 * nb; t < T_IN; t += nb) transpose_tile(p.w_in, DIN, (t / 40) * 64, win_src_col((t % 40) * 64), win, DM, (t % 40) * 64, tile);
    }
    float* ss = (float*)(p.ws + WS_SS);
    for (int i = bid * 512 + tid; i < MT; i += nb * 512) ss[i] = 0.f;
    for (int i = bid * 512 + tid; i < 16 * 14 * 128; i += nb * 512) { const int c4 = i & 127, rr = i >> 7, b = rr / 14, j = rr % 14;
        *(f32x4*)(p.out + O_SCS + ((size_t)b * 30 + j) * 512 + c4 * 4) = *(const f32x4*)(p.cache_conv + ((size_t)b * 30 + 16 + j) * 512 + c4 * 4); }
}

__device__ __forceinline__ void late_weight_prep(const Params& p, unsigned char* shm, const int bid, const int nb) {
    const int tid = threadIdx.x; float* tile = (float*)shm;
    bf16_t* pw = (bf16_t*)(p.ws + WS_PW); bf16_t* wout = (bf16_t*)(p.ws + WS_WOUT); bf16_t* mix = (bf16_t*)(p.ws + WS_MIX);
    constexpr int T_OUT = 16 * 16, T_PW = 8 * 8;
    for (int t = bid; t < T_OUT + T_PW; t += nb) {
        if (t < T_OUT) transpose_tile(p.w_out, DM, (t >> 4) * 64, (t & 15) * 64, wout, DM, (t & 15) * 64, tile);
        else { const int tt = t - T_OUT; transpose_tile(p.pw_w, 512, (tt >> 3) * 64, (tt & 7) * 64, pw, 512, (tt & 7) * 64, tile); }
    }
    for (int idx = bid * 512 + tid; idx < 512 * 512; idx += nb * 512) { const int n = idx >> 9, k = idx & 511; float v = 0.f;
        if ((n >> 7) == (k >> 7)) v = p.pool_mix[((size_t)(n >> 7) * 128 + (k & 127)) * 128 + (n & 127)] * p.pool_scale[n];
        mix[idx] = (bf16_t)(cvt_pk_bf16(v, 0.f) & 0xffffu); }
    __syncthreads();
}

#define DPP_STEP(v, ctrl) ((v) + __builtin_bit_cast(float, __builtin_amdgcn_update_dpp(0, __builtin_bit_cast(int, (v)), (ctrl), 0xf, 0xf, true)))
__device__ __forceinline__ float wave_sum_hi(float v) {
    v = DPP_STEP(v, 0xB1);
    v = DPP_STEP(v, 0x4E);
    v = DPP_STEP(v, 0x141);
    v = DPP_STEP(v, 0x140);
    v += __builtin_bit_cast(float, __builtin_amdgcn_update_dpp(0, __builtin_bit_cast(int, v), 0x142, 0xa, 0xf, false));
    v += __builtin_bit_cast(float, __builtin_amdgcn_update_dpp(0, __builtin_bit_cast(int, v), 0x143, 0xc, 0xf, false));
    return v;
}
#define RED16_STEP(CTRL) _Pragma("unroll") for (int k = 0; k < 16; ++k) asm volatile("v_add_f32_dpp %0, %0, %0 " CTRL : "+v"(r[k]))
__device__ __forceinline__ void wave_sum16_hi(float (&r)[16]) {
    asm volatile("s_nop 1" ::: "memory");
    RED16_STEP("quad_perm:[1,0,3,2] row_mask:0xf bank_mask:0xf");
    RED16_STEP("quad_perm:[2,3,0,1] row_mask:0xf bank_mask:0xf");
    RED16_STEP("row_half_mirror row_mask:0xf bank_mask:0xf");
    RED16_STEP("row_mirror row_mask:0xf bank_mask:0xf");
    RED16_STEP("row_bcast:15 row_mask:0xa bank_mask:0xf");
    RED16_STEP("row_bcast:31 row_mask:0xc bank_mask:0xf");
}
template <int W, int TH>
__device__ __forceinline__ void pool_regs(const unsigned (&u)[TH + 15], const int pos0, bf16_t* __restrict__ dst  ) {
    f32x2 s = (f32x2){0.f, 0.f};
#pragma unroll
    for (int j = 0; j < W; ++j) s += bf_unpack(u[15 - j]);
#pragma unroll
    for (int i = 0; i < TH; ++i) { const f32x2 cur = bf_unpack(u[15 + i]); const int pos1 = pos0 + i + 1;
        const float inv = pos1 >= W ? (1.0f / W) : __builtin_amdgcn_rcpf((float)pos1);
        const f32x2 o = s * inv - cur;
        *(unsigned*)(dst + (size_t)i * DM) = cvt_pk_bf16(o[0], o[1]);
        if (i + 1 < TH) s += bf_unpack(u[16 + i]) - bf_unpack(u[16 + i - W]); }
}
template <int T>
__device__ __forceinline__ void mixer_chunk(const Params& p, unsigned char* shm, const int r0, const int t0, const int tid, const f32x2 (&w2)[31]) {
    constexpr int TH = T / 2, ROUNDS = T / 16, NV = ((T + 30) * 64 + 511) / 512;
    const int cp = tid & 255, th = tid >> 8, lane = tid & 63, wv = (tid >> 6) & 3;
    const bf16_t* U = (const bf16_t*)(p.ws + WS_U); const bf16_t* V = (const bf16_t*)(p.ws + WS_V); bf16_t* PC = (bf16_t*)(p.ws + WS_PC);
    const unsigned* l32 = (const unsigned*)shm;
    u32x4 val[NV];
    {
        const bf16_t* vb = V + (size_t)(r0 - 30) * DH;
#pragma unroll
        for (int k = 0; k < NV; ++k) { const int idx = tid + k * 512, lr = idx >> 6; val[k] = (u32x4){0u, 0u, 0u, 0u};
            if (idx < (T + 30) * 64 && t0 - 30 + lr >= 0) val[k] = *(const u32x4*)(vb + (size_t)idx * 8); }
    }
    unsigned u[TH + 15];
    {
        const int f0 = th * TH - 15; const bf16_t* ub = U + (size_t)(r0 + f0) * DH + cp * 2;
#pragma unroll
        for (int k = 0; k < TH + 15; ++k) { u[k] = 0u; if (t0 + f0 + k >= 0) u[k] = *(const unsigned*)(ub + (size_t)k * DH); }
    }
#pragma unroll
    for (int k = 0; k < NV; ++k) { const int idx = tid + k * 512; if (idx < (T + 30) * 64) *(u32x4*)(shm + (size_t)idx * 16) = val[k]; }
    const f32x2 bias = *(const f32x2*)(p.dw_b + cp * 2);
    const f32x2 g2 = *(const f32x2*)(p.ln_g + cp * 2), b2 = *(const f32x2*)(p.ln_b + cp * 2);
    __syncthreads();
    {
        bf16_t* dst = PC + (size_t)(r0 + th * TH) * DM + cp * 2; const int pos0 = t0 + th * TH;
        switch (cp >> 6) { case 0: pool_regs<2, TH>(u, pos0, dst); break; case 1: pool_regs<4, TH>(u, pos0, dst); break; case 2: pool_regs<8, TH>(u, pos0, dst); break; default: pool_regs<16, TH>(u, pos0, dst); break; }
    }
    f32x2* stats = (f32x2*)(shm + (T + 30) * 1024);
#pragma unroll 1
    for (int rd = 0; rd < ROUNDS; ++rd) {
        const int tt = rd * 16 + th * 8;
        f32x2 c[8];
#pragma unroll
        for (int i = 0; i < 8; ++i) c[i] = bias;
        unsigned win[38];
#pragma unroll
        for (int q = 0; q < 38; ++q) win[q] = l32[(tt + q) * 256 + cp];
#pragma unroll
        for (int q = 0; q < 38; ++q) { const f32x2 v = bf_unpack(win[q]);
#pragma unroll
            for (int i = 0; i < 8; ++i) if (q - i >= 0 && q - i < 31) c[i] += w2[q - i] * v;
            asm volatile("" : "+v"(c[0]), "+v"(c[1]), "+v"(c[2]), "+v"(c[3]), "+v"(c[4]), "+v"(c[5]), "+v"(c[6]), "+v"(c[7])); }
        { float r[16];
#pragma unroll
          for (int i = 0; i < 8; ++i) { r[2 * i] = c[i][0] + c[i][1]; r[2 * i + 1] = c[i][0] * c[i][0] + c[i][1] * c[i][1]; }
          wave_sum16_hi(r);
#pragma unroll
          for (int i = 0; i < 8; ++i) if (lane == 63) stats[(tt + i) * 4 + wv] = (f32x2){r[2 * i], r[2 * i + 1]}; }
        __syncthreads();
        float mean_l, rs_l;
        { const int ti = tt + (lane & 7);
          const f32x4 sa = *(const f32x4*)(stats + ti * 4), sb = *(const f32x4*)(stats + ti * 4 + 2);
          mean_l = (sa[0] + sa[2] + sb[0] + sb[2]) * (1.0f / 512.0f);
          const float var = (sa[1] + sa[3] + sb[1] + sb[3]) * (1.0f / 512.0f) - mean_l * mean_l;
          rs_l = __builtin_amdgcn_rsqf(var + 1e-5f); }
#pragma unroll
        for (int i = 0; i < 8; ++i) {
            const float mean = __builtin_bit_cast(float, __builtin_amdgcn_readlane(__builtin_bit_cast(int, mean_l), i));
            const float rs = __builtin_bit_cast(float, __builtin_amdgcn_readlane(__builtin_bit_cast(int, rs_l), i));
            const f32x2 y = (c[i] - mean) * rs * g2 + b2;
            *(unsigned*)(PC + (size_t)(r0 + tt + i) * DM + 512 + cp * 2) = cvt_pk_bf16(silu_f(y[0]), silu_f(y[1])); }
    }
    __syncthreads();
}

__device__ __forceinline__ void sample_token(const Params& p, unsigned char* shm, const int s) {
    const int tid = threadIdx.x, wid = tid >> 6, lane = tid & 63, b = s >> 4, t = s & 15, r = NPROMPT + s, ch = tid;
    const bf16_t* U = (const bf16_t*)(p.ws + WS_U); const bf16_t* V = (const bf16_t*)(p.ws + WS_V); bf16_t* PC = (bf16_t*)(p.ws + WS_PC);
    {
        const int w = 2 << (ch >> 7); float sum = 0.f, cur = 0.f;
#pragma unroll
        for (int j = 0; j < 16; ++j) if (j < w) { const int e = t + 15 - j;
            const float v = e < 15 ? p.cache_pool[((size_t)b * 15 + e) * 512 + ch] : __uint_as_float((unsigned)U[(size_t)(NPROMPT + b * 16 + e - 15) * DH + ch] << 16);
            sum += v; if (j == 0) cur = v; }
        const float o = sum / (float)w - cur;
        PC[(size_t)r * DM + ch] = (bf16_t)(cvt_pk_bf16(o, 0.f) & 0xffffu);
    }
    float c = p.dw_b[ch];
#pragma unroll
    for (int j = 0; j < 31; ++j) { const int e = t + j;
        const float v = e < 30 ? p.cache_conv[((size_t)b * 30 + e) * 512 + ch] : __uint_as_float((unsigned)V[(size_t)(NPROMPT + b * 16 + e - 30) * DH + ch] << 16);
        c += p.dw_w[j * 512 + ch] * v; }
    float s1 = wave_sum(c), s2 = wave_sum(c * c);
    f32x2* red = (f32x2*)shm;
    if (lane == 0) red[wid] = (f32x2){s1, s2};
    __syncthreads();
    s1 = 0.f; s2 = 0.f;
#pragma unroll
    for (int w8 = 0; w8 < 8; ++w8) { const f32x2 q = red[w8]; s1 += q[0]; s2 += q[1]; }
    const float mean = s1 * (1.0f / 512.0f), var = s2 * (1.0f / 512.0f) - mean * mean, rs = rsqrtf(var + 1e-5f);
    const float y = (c - mean) * rs * p.ln_g[ch] + p.ln_b[ch];
    PC[(size_t)r * DM + 512 + ch] = (bf16_t)(cvt_pk_bf16(silu_f(y), 0.f) & 0xffffu);
    __syncthreads();
}

__device__ __forceinline__ void wait_counters(unsigned* c0, unsigned t0, unsigned* c1, unsigned t1, unsigned* c2, unsigned t2) {
    if (threadIdx.x == 0) { unsigned sp = 0u;
        while (xb_ld(c0) < t0 || xb_ld(c1) < t1 || xb_ld(c2) < t2) { __builtin_amdgcn_s_sleep(1); if (++sp > (1u << 22)) break; }
        __builtin_amdgcn_fence(__ATOMIC_ACQUIRE, "agent"); asm volatile("s_waitcnt vmcnt(0)" ::: "memory"); }
    __syncthreads();
}
__device__ __forceinline__ void phase_mixer_pre(const Params& p, unsigned char* shm, const int gbase, int off, int len) {
    int tid = threadIdx.x; asm volatile("" : "+v"(tid));
    f32x2 w2[31];
    { const float* wp = p.dw_w + (tid & 255) * 2;
#pragma unroll
      for (int j = 0; j < 31; ++j) w2[j] = *(const f32x2*)(wp + j * 512); }
#pragma unroll 1
    while (len > 0) {
        const int take = (len >= 96 || len == 64) ? 64 : (len == 80 ? 48 : (len > 64 ? 32 : len)), r0 = gbase + off, t0 = r0 & (SEQ - 1);
        int tq = tid; asm volatile("" : "+v"(tq));
        if (take == 64) mixer_chunk<64>(p, shm, r0, t0, tq, w2); else if (take == 48) mixer_chunk<48>(p, shm, r0, t0, tq, w2); else mixer_chunk<32>(p, shm, r0, t0, tq, w2);
        off += take; len -= take;
    }
}

__global__ void __launch_bounds__(512, 2) hymba_fwd(Params p) {
    extern __shared__ __attribute__((aligned(16))) unsigned char shm[];
    LAS unsigned char* lds = (LAS unsigned char*)shm;
    const int G = gridDim.x, c = blockIdx.x;
    volatile LAS unsigned* st = (volatile LAS unsigned*)(lds + pg8::STAGE_BYTES);
    if (threadIdx.x == 0) { st[0] = 0u; st[1] = 0u; st[2] = 0u; st[3] = 0u; }
    __syncthreads();
    const XcdBarrier xb = xcd_barrier_post((unsigned*)(p.ws + WS_BAR), st);
    phase_prep(p, shm);
    xcd_barrier(xb);
    const bool uni = st[3] != 0u;
    const int gx = uni ? (int)xb.x : (c & 7), gl = uni ? (int)st[2] : (c >> 3);
    const int sidx = 32 * gx + gl;
    const int pm = 8 * gx + (gl & 7), pn = gl >> 3;
    const int n3 = gx < 2 ? 18 : 17;
    unsigned* cw = (unsigned*)(p.ws + WS_CNT);
    if (gl >= n3) {
        late_weight_prep(p, shm, (gx < 2 ? 14 * gx : 28 + 15 * (gx - 2)) + (gl - n3), 118);
        asm volatile("s_waitcnt vmcnt(0)" ::: "memory");
        __syncthreads();
        if (threadIdx.x == 0) { __builtin_amdgcn_fence(__ATOMIC_RELEASE, "agent"); asm volatile("s_waitcnt vmcnt(0)" ::: "memory"); (void)xb_add(cw + 64 * CW_LW, 1u); }
    }
    { SchedP1 S{(const char*)(p.ws + WS_XB), (const char*)(p.ws + WS_WIN), cw, gx, gl, uni};
      EpiP1 E{(bf16_t*)(p.ws + WS_U), (bf16_t*)(p.ws + WS_SGP), (bf16_t*)(p.ws + WS_V), (bf16_t*)(p.ws + WS_SGC), p.out};
      f32x4 acc[2][2][4][2]; pg8::gemm_phase(lds, DM, DM, S, E, acc); }
    if (uni) {
        const unsigned n_s8 = gx < 2 ? 16u : 8u;
        if (gl == 31) {
            wait_counters(cw + 64 * (CW_RV + gx), 384u, cw + 64 * (CW_SV + gx), n_s8, cw + 64 * (CW_SV + gx), n_s8);
            if (threadIdx.x == 0) { __builtin_amdgcn_fence(__ATOMIC_RELEASE, "agent"); asm volatile("s_waitcnt vmcnt(0)" ::: "memory"); (void)xb_add(cw + 64 * CW_GV, 1u); }
        }
        const bool halo = (gx & 1) && gl == n3;
        wait_counters(cw + 64 * (CW_RV + gx), 384u, cw + 64 * CW_GV, halo ? 8u : 0u, cw + 64 * CW_LW, 118u);
    } else xcd_barrier(xb);
    {
      const int E2 = 32 - n3; int off, len;
      if (!uni) { off = 64 * gl; len = 64; }
      else if (gl >= n3) { off = 96 * (gl - n3); len = 96; }
      else { const int remu = (2048 - 96 * E2) / 16, base = remu / n3, extra = remu % n3; off = 96 * E2 + 16 * (gl * base + (gl < extra ? gl : extra)); len = 16 * (base + (gl < extra ? 1 : 0)); }
      phase_mixer_pre(p, shm, 2048 * gx, off, len); }
    if (uni) wait_counters(cw + 64 * CW_GV, 8u, cw + 64 * CW_GV, 8u, cw + 64 * CW_GV, 8u);
    sample_token(p, shm, sidx);
    if (uni) xcc_barrier(xb, [] {}); else xcd_barrier(xb);
    { SchedP3 S{(const char*)(p.ws + WS_PC), (const char*)(p.ws + WS_MIX), (const char*)(p.ws + WS_PW), pm, pn};
      EpiP3 E{(const bf16_t*)(p.ws + WS_SGP), (const bf16_t*)(p.ws + WS_SGC), p.pw_b, (bf16_t*)(p.ws + WS_Z)};
      f32x4 acc[2][2][4][2]; pg8::gemm_phase(lds, DM, 512, S, E, acc); }
    if (pn < 2) { sample_p3(p, shm, sidx); sample_p3(p, shm, sidx + 16); }
    { SchedP4 S{(const char*)(p.ws + WS_Z), (const char*)(p.ws + WS_WOUT), pm, pn};
      EpiP4 E{p.x_prompt, p.final_g, p.out, (float*)(p.ws + WS_XS), (unsigned*)(p.ws + WS_CNT), (const float*)(p.ws + WS_SS), NPROMPT + sidx, uni};
      f32x4 acc[2][2][4][2]; pg8::Unit u4; const bool has4 = S.next(0, u4);
      int tid4 = threadIdx.x; asm volatile("" : "+v"(tid4));
      const int wid4 = __builtin_amdgcn_readfirstlane(tid4 >> 6), lane4 = tid4 & 63;
      const auto hook = [&] { if (has4) E.init(acc, u4, wid4 >> 2, wid4 & 3, lane4 & 15, lane4 >> 4); };
      if (uni) xcc_barrier(xb, hook); else xcd_barrier(xb, hook);
      sample_p4(p, shm, sidx, uni);
      pg8::gemm_phase(lds, DM, DM, S, E, acc); }
}

extern "C" void kernel_launch(void* const* d_in, const int* in_sizes, int n_in, void* d_out, int out_size, void* d_ws, size_t ws_size, hipStream_t stream) {
    constexpr int LDS_BYTES = pg8::STAGE_BYTES + 16;
    static int grid = 0;
    if (grid == 0) {
        if (n_in != 16 || ws_size < WS_END) { fprintf(stderr, "kernel_launch: unexpected inputs (n_in %d, ws %zu)\n", n_in, ws_size); grid = -1; return; }
        int dev = 0, cus = 0, per_cu = 0;
        (void)hipGetDevice(&dev); (void)hipDeviceGetAttribute(&cus, hipDeviceAttributeMultiprocessorCount, dev);
        if (hipFuncSetAttribute((const void*)hymba_fwd, hipFuncAttributeMaxDynamicSharedMemorySize, LDS_BYTES) != hipSuccess) { fprintf(stderr, "kernel_launch: hipFuncSetAttribute failed\n"); grid = -1; return; }
        if (hipOccupancyMaxActiveBlocksPerMultiprocessor(&per_cu, (const void*)hymba_fwd, 512, LDS_BYTES) != hipSuccess || per_cu < 1) { fprintf(stderr, "kernel_launch: occupancy query says %d\n", per_cu); per_cu = 1; (void)hipGetLastError(); }
        if (cus < 256) { fprintf(stderr, "kernel_launch: built for a 256-CU device (got %d CUs)\n", cus); grid = -1; return; }
        grid = 256;
    }
    if (grid < 0) return;
    if (hipMemsetAsync((char*)d_ws + WS_BAR, 0, WS_CTL_BYTES, stream) != hipSuccess) { fprintf(stderr, "kernel_launch: memset of the barrier words failed\n"); return; }
    Params p{};
    p.x_prompt = (const float*)d_in[0]; p.x_sample = (const float*)d_in[1]; p.cache_pool = (const float*)d_in[2]; p.cache_conv = (const float*)d_in[3];
    p.norm_g = (const float*)d_in[4]; p.w_in = (const float*)d_in[5]; p.pool_mix = (const float*)d_in[6]; p.pool_scale = (const float*)d_in[7];
    p.dw_w = (const float*)d_in[8]; p.dw_b = (const float*)d_in[9]; p.ln_g = (const float*)d_in[10]; p.ln_b = (const float*)d_in[11];
    p.pw_w = (const float*)d_in[12]; p.pw_b = (const float*)d_in[13]; p.w_out = (const float*)d_in[14]; p.final_g = (const float*)d_in[15];
    p.out = (float*)d_out; p.ws = (unsigned char*)d_ws;
    void* args[] = {&p};
    hipError_t e = hipLaunchCooperativeKernel((const void*)hymba_fwd, dim3(grid), dim3(512), args, LDS_BYTES, stream);
    if (e != hipSuccess) fprintf(stderr, "kernel_launch: cooperative launch failed: %s (grid %d)\n", hipGetErrorString(e), grid);
}
```

```cpp
#include <hip/hip_runtime.h>
#include <cstdio>

#define LAS __attribute__((address_space(3)))
typedef unsigned short bf16_t;
typedef short bf16x8 __attribute__((ext_vector_type(8)));
typedef float f32x4 __attribute__((ext_vector_type(4)));
typedef float f32x2 __attribute__((ext_vector_type(2)));
typedef unsigned u32x4 __attribute__((ext_vector_type(4)));
typedef unsigned u32x2 __attribute__((ext_vector_type(2)));

constexpr int DM = 1024, NPROMPT = 16384, NSAMP = 256, MT = NPROMPT + NSAMP, DIN = 2560, DH = 512;
constexpr int SEQ = 4096, DSEQ = 16;
constexpr size_t O_Y = 0;
constexpr size_t O_SPP = (size_t)MT * DM;
constexpr size_t O_SCP = O_SPP + 4 * 15 * 512;
constexpr size_t O_SPS = O_SCP + 4 * 30 * 512;
constexpr size_t O_SCS = O_SPS + 16 * 15 * 512;
constexpr size_t WS_XB = 0;
constexpr size_t WS_WIN = WS_XB + (size_t)MT * DM * 2;
constexpr size_t WS_MIX = WS_WIN + (size_t)DIN * DM * 2;
constexpr size_t WS_PW = WS_MIX + (size_t)512 * 512 * 2;
constexpr size_t WS_WOUT = WS_PW + (size_t)512 * 512 * 2;
constexpr size_t WS_U = WS_WOUT + (size_t)1024 * 1024 * 2;
constexpr size_t WS_SGP = WS_U + (size_t)MT * DH * 2;
constexpr size_t WS_V = WS_SGP + (size_t)MT * DH * 2;
constexpr size_t WS_SGC = WS_V + (size_t)MT * DH * 2;
constexpr size_t WS_PC = WS_SGC + (size_t)MT * DH * 2;
constexpr size_t WS_Z = WS_PC + (size_t)MT * DM * 2;
constexpr size_t WS_SS = WS_Z + (size_t)MT * DM * 2;
constexpr size_t WS_BAR = (WS_SS + (size_t)MT * 4 + 255) / 256 * 256;
constexpr size_t WS_CNT = WS_BAR + 4608 * 4;
constexpr size_t WS_CTL_BYTES = 4608 * 4 + 96 * 256;
constexpr int CW_PIECES = 64, CW_RV = 65  , CW_SV = 73  , CW_GV = 81  , CW_LW = 82  ;
constexpr size_t WS_XS = WS_CNT + 96 * 256;
constexpr size_t WS_END = WS_XS + (size_t)64 * 4 * 256 * 4;

struct Params {
    const float* x_prompt; const float* x_sample; const float* cache_pool; const float* cache_conv; const float* norm_g; const float* w_in;
    const float* pool_mix; const float* pool_scale; const float* dw_w; const float* dw_b; const float* ln_g; const float* ln_b;
    const float* pw_w; const float* pw_b; const float* w_out; const float* final_g;
    float* out; unsigned char* ws;
};

__device__ __forceinline__ unsigned cvt_pk_bf16(float lo, float hi) { unsigned r; asm volatile("v_cvt_pk_bf16_f32 %0, %1, %2" : "=v"(r) : "v"(lo), "v"(hi)); return r; }
__device__ __forceinline__ float bf_lo(unsigned u) { return __uint_as_float(u << 16); }
__device__ __forceinline__ float bf_hi(unsigned u) { return __uint_as_float(u & 0xffff0000u); }
__device__ __forceinline__ f32x2 bf_unpack(unsigned u) { return (f32x2){bf_lo(u), bf_hi(u)}; }
__device__ __forceinline__ float sigmoid_f(float x) { return __builtin_amdgcn_rcpf(1.0f + __expf(-x)); }
__device__ __forceinline__ float silu_f(float x) { return x * sigmoid_f(x); }
__device__ __forceinline__ u32x4 pack8(f32x4 a, f32x4 b) { return (u32x4){cvt_pk_bf16(a[0], a[1]), cvt_pk_bf16(a[2], a[3]), cvt_pk_bf16(b[0], b[1]), cvt_pk_bf16(b[2], b[3])}; }
__device__ __forceinline__ float wave_sum(float v) {
#pragma unroll
    for (int o = 32; o > 0; o >>= 1) v += __shfl_xor(v, o);
    return v;
}


#define XB_TMO      128
#define XB_XCNT(j)  (256  + 64 * (j))
#define XB_XSUB(j)  (1280 + 64 * (j))
#define XB_XGEN(j)  (2304 + 64 * (j))
#define XB_TOP      3328
#define XB_TOPGEN   3392
#define XB_XLOC(j)  (3520 + 64 * (j))
#define XCD_BAR_WORDS 4608
#define XB_SPIN_CAP (1u << 18)
__device__ __forceinline__ unsigned xb_ld(unsigned* p)              { return __hip_atomic_load(p, __ATOMIC_RELAXED, __HIP_MEMORY_SCOPE_AGENT); }
__device__ __forceinline__ unsigned xb_add(unsigned* p, unsigned v) { return __hip_atomic_fetch_add(p, v, __ATOMIC_RELAXED, __HIP_MEMORY_SCOPE_AGENT); }
__device__ __forceinline__ unsigned xb_xcc_id() { return (unsigned)__builtin_amdgcn_s_getreg((3 << 11) | 20) & 0xFu; }
#define XB_SPIN(cond, bar) do { unsigned _sp = 0; while (cond) { __builtin_amdgcn_s_sleep(1); \
    if ((++_sp & 255u) == 0u) { if (xb_ld(&(bar)[XB_TMO])) break; if (_sp > XB_SPIN_CAP) { atomicAdd(&(bar)[XB_TMO], 1u); break; } } } } while (0)
struct XcdBarrier { unsigned* bar; unsigned x; volatile LAS unsigned* st; };
__device__ __forceinline__ XcdBarrier xcd_barrier_post(unsigned* bar, volatile LAS unsigned* st) {
    XcdBarrier b; b.bar = bar; b.x = xb_xcc_id(); b.st = st;
    if (threadIdx.x == 0) st[2] = xb_add(&bar[XB_XCNT(b.x)], 1u);
    return b;
}
__device__ __forceinline__ void xcd_barrier_complete(unsigned* bar, unsigned x, unsigned& nloc, unsigned& nx, unsigned& uni) {
    const unsigned G = gridDim.x * gridDim.y * gridDim.z;
    unsigned sum, cnt, mine, sp = 0u;
    for (;;) {
        sum = 0u; cnt = 0u; mine = 0u; uni = 1u;
#pragma unroll
        for (unsigned j = 0; j < 16; ++j) { const unsigned c = xb_ld(&bar[XB_XCNT(j)]); sum += c; cnt += (c > 0u) ? 1u : 0u; mine = (j == x) ? c : mine; uni = (c == (j < 8 ? 32u : 0u)) ? uni : 0u; }
        if (sum == G) break;
        __builtin_amdgcn_s_sleep(1);
        if ((++sp & 255u) == 0u) { if (xb_ld(&bar[XB_TMO])) break; if (sp > XB_SPIN_CAP) { atomicAdd(&bar[XB_TMO], 1u); break; } }
    }
    nloc = mine > 0u ? mine : 1u; nx = cnt > 0u ? cnt : 1u; uni = (sum == G) ? uni : 0u;
}
template <class Hook>
__device__ __forceinline__ void xcd_barrier(const XcdBarrier& b, const Hook& hook) {
    asm volatile("s_waitcnt vmcnt(0)" ::: "memory");
    __syncthreads();
    if (threadIdx.x >= 64) hook();
    if (threadIdx.x == 0) {
        unsigned* bar = b.bar;
        __builtin_amdgcn_s_waitcnt(0);
        unsigned nloc = b.st[0], nx = b.st[1];
        if (nloc == 0u) { unsigned uni; xcd_barrier_complete(bar, b.x, nloc, nx, uni); b.st[0] = nloc; b.st[1] = nx; b.st[3] = uni; }
        const unsigned old = xb_add(&bar[XB_XSUB(b.x)], 1u);
        const unsigned gen = old / nloc;
        if (old + 1u == (gen + 1u) * nloc) {
            __builtin_amdgcn_fence(__ATOMIC_RELEASE, "agent");
            asm volatile("s_waitcnt vmcnt(0)" ::: "memory");
            const unsigned og = xb_add(&bar[XB_TOP], 1u);
            const unsigned tg = og / nx;
            if (og + 1u == (tg + 1u) * nx) xb_add(&bar[XB_TOPGEN], 1u);
            else XB_SPIN(xb_ld(&bar[XB_TOPGEN]) == tg, bar);
            __builtin_amdgcn_fence(__ATOMIC_ACQUIRE, "agent");
            xb_add(&bar[XB_XGEN(b.x)], 1u);
            asm volatile("s_waitcnt vmcnt(0)" ::: "memory");
        } else {
            XB_SPIN(xb_ld(&bar[XB_XGEN(b.x)]) == gen, bar);
            __builtin_amdgcn_fence(__ATOMIC_ACQUIRE, "agent");
            asm volatile("s_waitcnt vmcnt(0)" ::: "memory");
        }
    }
    if (threadIdx.x < 64) hook();
    __syncthreads();
}
__device__ __forceinline__ void xcd_barrier(const XcdBarrier& b) { xcd_barrier(b, [] {}); }
template <class Hook>
__device__ __forceinline__ void xcc_barrier(const XcdBarrier& b, const Hook& hook) {
    asm volatile("s_waitcnt vmcnt(0)" ::: "memory");
    __syncthreads();
    if (threadIdx.x >= 64) hook();
    if (threadIdx.x == 0) {
        unsigned* w = &b.bar[XB_XLOC(b.x)];
        __builtin_amdgcn_s_waitcnt(0);
        const unsigned old = xb_add(w, 1u), target = (old / 32u + 1u) * 32u;
        XB_SPIN(xb_ld(w) < target, b.bar);
        __builtin_amdgcn_fence(__ATOMIC_ACQUIRE, "agent");
        asm volatile("s_waitcnt vmcnt(0)" ::: "memory");
    }
    if (threadIdx.x < 64) hook();
    __syncthreads();
}

namespace pg8 {
constexpr int BM = 256, BK = 64, HALF = 128, HTB = HALF * BK * 2, STAGE_BYTES = 8 * HTB, NXCD = 8, WGM = 8;
__device__ __forceinline__ int lds_byte(int r, int c) { const int st = (r >> 4) * 2 + (c >> 5), rr = r & 15, cc = c & 31, ob = rr * 64 + cc * 2; return st * 1024 + (ob ^ (((ob >> 9) & 1) << 5)); }
__device__ __forceinline__ void stage_rc(int b, int& R, int& C) { const int st = b / 1024, sb = b % 1024, swz = sb ^ (((sb >> 9) & 1) << 5); R = (st >> 1) * 16 + swz / 64; C = (st & 1) * 32 + (swz % 64) / 2; }
__device__ __forceinline__ int perm32(int rho) { const int n = rho >> 4, i = rho & 15; return 8 * (i >> 2) + 4 * n + (i & 3); }

struct Unit { const char* A; const char* B; int pm, pn, nt, kind; };

__device__ __forceinline__ bool tile_order(int i, int G, int c, int nM, int nN, int& pm, int& pn) {
    const int nwg = nM * nN; const long L = (long)i * G + c; if (L >= nwg) return false;
    int wgid = (int)L; { const int q = nwg / NXCD, r = nwg % NXCD, xcd = wgid % NXCD, off = wgid / NXCD; wgid = (xcd < r ? xcd * (q + 1) : r * (q + 1) + (xcd - r) * q) + off; }
    const int nig = WGM * nN, gid = wgid / nig, fm = gid * WGM, gsz = (nM - fm) < WGM ? (nM - fm) : WGM;
    pm = fm + ((wgid % nig) % gsz); pn = (wgid % nig) / gsz; return true;
}

template <class Epi, class Sched>
__device__ __forceinline__ void gemm_phase(LAS unsigned char* lds, const int lda, const int ldb, const Sched& S, const Epi& E, f32x4 (&acc)[2][2][4][2]) {
    int tid_ = threadIdx.x; asm volatile("" : "+v"(tid_));
    const int tid = tid_, wid = __builtin_amdgcn_readfirstlane(tid >> 6), lane = tid & 63, wr = wid >> 2, wc = wid & 3, fr = lane & 15, fq = lane >> 4;
    unsigned voffA[2], voffB[2];
#pragma unroll
    for (int i = 0; i < 2; ++i) { int R, C; stage_rc(tid * 16 + i * 8192, R, C); const int Rb = Epi::PERM ? ((R & ~31) + perm32(R & 31)) : R;
        voffA[i] = (unsigned)(R * lda + C) * 2u; voffB[i] = (unsigned)(Rb * ldb + C) * 2u; }
    const size_t kstep = (size_t)(BK * 2);
    const size_t hstepA = (size_t)HALF * lda * 2, hstepB = (size_t)HALF * ldb * 2;
    const unsigned ldsw = (unsigned)wid * 1024u;
    const int aoff = lds_byte(wr * 64 + fr, fq * 8), boff = lds_byte(wc * 32 + fr, fq * 8);
#define PG8_SA(b, h) (((b) * 2 + (h)) * HTB)
#define PG8_SB(b, h) ((4 + (b) * 2 + (h)) * HTB)
#define PG8_STAGE(bufoff, gbase, voff) do { _Pragma("unroll") for (int _i = 0; _i < 2; ++_i) \
        __builtin_amdgcn_global_load_lds((const unsigned*)((const char*)(gbase) + (voff)[_i]), (LAS unsigned*)(lds + (bufoff) + ldsw + _i * 8192), 16, 0, 0); } while (0)
#define PG8_LDA(dst, b, h) do { _Pragma("unroll") for (int m = 0; m < 4; ++m) _Pragma("unroll") for (int k = 0; k < 2; ++k) dst[m][k] = *(const LAS bf16x8*)(lds + PG8_SA(b, h) + aoff + m * 2048 + k * 1024); } while (0)
#define PG8_LDB(dst, b, h) do { _Pragma("unroll") for (int n = 0; n < 2; ++n) _Pragma("unroll") for (int k = 0; k < 2; ++k) dst[n][k] = *(const LAS bf16x8*)(lds + PG8_SB(b, h) + boff + n * 2048 + k * 1024); } while (0)
#define PG8_MMA(ai, bj, At, Bt) do { __builtin_amdgcn_s_setprio(1); _Pragma("unroll") for (int m = 0; m < 4; ++m) _Pragma("unroll") for (int n = 0; n < 2; ++n) _Pragma("unroll") for (int k = 0; k < 2; ++k) \
        acc[ai][bj][m][n] = __builtin_amdgcn_mfma_f32_16x16x32_bf16(Bt[n][k], At[m][k], acc[ai][bj][m][n], 0, 0, 0); __builtin_amdgcn_s_setprio(0); } while (0)
#define PG8_WAIT_V(n) asm volatile("s_waitcnt vmcnt(" #n ")" ::: "memory")
#define PG8_WAIT_L(n) asm volatile("s_waitcnt lgkmcnt(" #n ")" ::: "memory")
#define PG8_BAR __builtin_amdgcn_s_barrier()
#define PG8_SCHED __builtin_amdgcn_sched_barrier(0)
    Unit cur, nxt; int ui = 0;
    if (!S.next(0, cur)) return;
    if constexpr (!Epi::EXT_INIT) E.init(acc, cur, wr, wc, fr, fq);
    bf16x8 At[4][2], B0[2][2], B1[2][2];
    const char* cA = cur.A; const char* cB = cur.B;
    PG8_STAGE(PG8_SB(0, 0), cB, voffB); PG8_STAGE(PG8_SA(0, 0), cA, voffA); PG8_STAGE(PG8_SB(0, 1), cB + hstepB, voffB); PG8_STAGE(PG8_SA(0, 1), cA + hstepA, voffA);
    if (wr == 1) PG8_BAR;
    PG8_WAIT_V(4); PG8_BAR;
    PG8_STAGE(PG8_SB(1, 0), cB + kstep, voffB); PG8_STAGE(PG8_SA(1, 0), cA + kstep, voffA); PG8_STAGE(PG8_SB(1, 1), cB + hstepB + kstep, voffB);
    PG8_WAIT_V(6); PG8_BAR;
    for (;;) {
        const bool has_next = S.next(ui + 1, nxt);
        const char* nA = has_next ? nxt.A : cA; const char* nB = has_next ? nxt.B : cB;
        const int nt = cur.nt;
        for (int t = 0; t < nt; t += 2) {
            const bool last = (t == nt - 2);
            const char* a1 = cA + (size_t)(t + 1) * kstep;
            const char* a2 = last ? nA : cA + (size_t)(t + 2) * kstep; const char* b2 = last ? nB : cB + (size_t)(t + 2) * kstep;
            const char* a3 = a2 + kstep; const char* b3 = b2 + kstep;
            bool m0 = true, m1 = true;
            if constexpr (Epi::ZSKIP) { if (cur.kind == 3) { m0 = t < 2; m1 = t >= 2; } }
            PG8_LDB(B0, 0, 0); PG8_SCHED; PG8_LDA(At, 0, 0); PG8_STAGE(PG8_SA(1, 1), a1 + hstepA, voffA);
            PG8_WAIT_L(8); PG8_BAR; PG8_WAIT_L(0); if (m0) PG8_MMA(0, 0, At, B0); PG8_BAR; PG8_SCHED;
            PG8_LDB(B1, 0, 1); PG8_STAGE(PG8_SB(0, 0), b2, voffB);
            PG8_BAR; PG8_WAIT_L(0); if (m1) PG8_MMA(0, 1, At, B1); PG8_BAR;
            PG8_LDA(At, 0, 1); PG8_STAGE(PG8_SA(0, 0), a2, voffA);
            PG8_BAR; PG8_WAIT_L(0); if (m0) PG8_MMA(1, 0, At, B0); PG8_BAR; PG8_SCHED;
            PG8_STAGE(PG8_SB(0, 1), b2 + hstepB, voffB);
            PG8_WAIT_V(6); PG8_BAR; if (m1) PG8_MMA(1, 1, At, B1); PG8_BAR;
            PG8_LDB(B0, 1, 0); PG8_SCHED; PG8_LDA(At, 1, 0); PG8_STAGE(PG8_SA(0, 1), a2 + hstepA, voffA);
            PG8_WAIT_L(8); PG8_BAR; PG8_WAIT_L(0); if (m0) PG8_MMA(0, 0, At, B0); PG8_BAR; PG8_SCHED;
            PG8_LDB(B1, 1, 1); PG8_STAGE(PG8_SB(1, 0), b3, voffB);
            PG8_BAR; PG8_WAIT_L(0); if (m1) PG8_MMA(0, 1, At, B1); PG8_BAR;
            PG8_LDA(At, 1, 1); PG8_STAGE(PG8_SA(1, 0), a3, voffA);
            PG8_BAR; PG8_WAIT_L(0); if (m0) PG8_MMA(1, 0, At, B0); PG8_BAR; PG8_SCHED;
            PG8_STAGE(PG8_SB(1, 1), b3 + hstepB, voffB);
            PG8_WAIT_V(6); PG8_BAR; if (m1) PG8_MMA(1, 1, At, B1); PG8_BAR;
        }
        if constexpr (!Epi::AFTER_DRAIN) { E(acc, cur, wr, wc, fr, fq); S.done(cur, ui, lane); }
        if (!has_next) break;
        cur = nxt; cA = nA; cB = nB; ++ui;
        E.init(acc, cur, wr, wc, fr, fq);
    }
    PG8_WAIT_V(0);
    if (wr == 0) PG8_BAR;
    PG8_BAR;
    if constexpr (Epi::AFTER_DRAIN) E.fused(acc, cur, wr, wc, fr, fq, lds, tid);
#undef PG8_SA
#undef PG8_SB
#undef PG8_STAGE
#undef PG8_LDA
#undef PG8_LDB
#undef PG8_MMA
#undef PG8_WAIT_V
#undef PG8_WAIT_L
#undef PG8_BAR
#undef PG8_SCHED
}
}

struct SchedP1 {
    const char* xb; const char* win; unsigned* cnt; int gx, gl; bool uni;
    __device__ __forceinline__ bool next(int i, pg8::Unit& u) const {
        const int n_s = gx < 2 ? 2 : 1, j = gl + 32 * i; if (j >= 80 + n_s) return false;
        int pm, pn, kind;
        if (j < n_s) { pm = NPROMPT / 256; pn = gx + 8 * j; kind = 2; }
        else if (j < n_s + 48) { const int k = j - n_s, q = k >> 3; pm = 8 * gx + (k & 7); pn = q < 2 ? q : q + 2; kind = 1; }
        else { const int k = j - n_s - 48, q = k >> 3; pm = 8 * gx + (k & 7); pn = q < 2 ? q + 2 : q + 6; kind = 0; }
        u.pm = pm; u.pn = pn; u.kind = kind; u.nt = 16; u.A = xb + (size_t)pm * 256 * DM * 2; u.B = win + (size_t)pn * 256 * DM * 2; return true;
    }
    __device__ __forceinline__ void done(const pg8::Unit&, int ui, int lane) const {
        if (!uni) return;
        const int n_s = gx < 2 ? 2 : 1, nuv = gl < n_s + 16 ? 2 : 1;
        if (ui != nuv - 1) return;
        asm volatile("s_waitcnt vmcnt(0)" ::: "memory");
        if (lane == 0) { const int sm = gl < n_s ? 1 : 0, uv = nuv - sm;
            (void)xb_add(cnt + 64 * (CW_RV + gx), (unsigned)uv);
            if (sm) (void)xb_add(cnt + 64 * (CW_SV + gx), 1u); }
    }
};
struct EpiP1 {
    static constexpr bool PERM = true, AFTER_DRAIN = false, EXT_INIT = false, ZSKIP = false;
    bf16_t* U; bf16_t* SGP; bf16_t* V; bf16_t* SGC; float* out;
    __device__ __forceinline__ void init(f32x4 (&acc)[2][2][4][2], const pg8::Unit&, int, int, int, int) const {
#pragma unroll
        for (int a = 0; a < 2; ++a)
#pragma unroll
            for (int b = 0; b < 2; ++b)
#pragma unroll
                for (int m = 0; m < 4; ++m)
#pragma unroll
                    for (int n = 0; n < 2; ++n) acc[a][b][m][n] = (f32x4){0.f, 0.f, 0.f, 0.f};
    }
    __device__ __forceinline__ void operator()(const f32x4 (&acc)[2][2][4][2], const pg8::Unit& u, int wr, int wc, int fr, int fq) const {
        const int pn = u.pn, row0 = u.pm * 256 + wr * 64 + fr, cl = wc * 32 + 8 * fq;
        if (pn < 2) {
#pragma unroll
            for (int ai = 0; ai < 2; ++ai)
#pragma unroll
                for (int m = 0; m < 4; ++m) {
                    const int r = row0 + ai * 128 + m * 16; bool st; size_t so;
                    if (r < NPROMPT) { const int t = r & (SEQ - 1); st = t >= SEQ - 15; so = O_SPP + ((size_t)(r >> 12) * 15 + (t - (SEQ - 15))) * 512; }
                    else { const int s = r - NPROMPT, t = s & 15; st = t >= 1; so = O_SPS + ((size_t)(s >> 4) * 15 + (t - 1)) * 512; }
#pragma unroll
                    for (int bj = 0; bj < 2; ++bj) { const int c = pn * 256 + bj * 128 + cl; const f32x4 v0 = acc[ai][bj][m][0], v1 = acc[ai][bj][m][1];
                        *(u32x4*)(U + (size_t)r * DH + c) = pack8(v0, v1);
                        if (st) { *(f32x4*)(out + so + c) = v0; *(f32x4*)(out + so + c + 4) = v1; } }
                }
        } else if (pn < 4 || pn >= 8) {
            bf16_t* dst = pn < 4 ? SGP : SGC; const int cb = (pn < 4 ? pn - 2 : pn - 8) * 256 + cl;
#pragma unroll
            for (int ai = 0; ai < 2; ++ai)
#pragma unroll
                for (int m = 0; m < 4; ++m) { const int r = row0 + ai * 128 + m * 16;
#pragma unroll
                    for (int bj = 0; bj < 2; ++bj) { f32x4 v0 = acc[ai][bj][m][0], v1 = acc[ai][bj][m][1];
#pragma unroll
                        for (int j = 0; j < 4; ++j) { v0[j] = silu_f(v0[j]); v1[j] = silu_f(v1[j]); }
                        *(u32x4*)(dst + (size_t)r * DH + cb + bj * 128) = pack8(v0, v1); }
                }
        } else {
            const int c = (pn - 4) * 128 + cl;
#pragma unroll
            for (int ai = 0; ai < 2; ++ai)
#pragma unroll
                for (int m = 0; m < 4; ++m) {
                    const int r = row0 + ai * 128 + m * 16; bool st; size_t so;
                    if (r < NPROMPT) { const int t = r & (SEQ - 1); st = t >= SEQ - 30; so = O_SCP + ((size_t)(r >> 12) * 30 + (t - (SEQ - 30))) * 512; }
                    else { const int s = r - NPROMPT, t = s & 15; st = true; so = O_SCS + ((size_t)(s >> 4) * 30 + 14 + t) * 512; }
                    f32x4 v0 = acc[ai][0][m][0], v1 = acc[ai][0][m][1]; const f32x4 g0 = acc[ai][1][m][0], g1 = acc[ai][1][m][1];
#pragma unroll
                    for (int j = 0; j < 4; ++j) { v0[j] *= sigmoid_f(g0[j]); v1[j] *= sigmoid_f(g1[j]); }
                    *(u32x4*)(V + (size_t)r * DH + c) = pack8(v0, v1);
                    if (st) { *(f32x4*)(out + so + c) = v0; *(f32x4*)(out + so + c + 4) = v1; }
                }
        }
    }
};

struct SchedP3 {
    const char* pc; const char* mix; const char* pw; int pm0, pn0;
    __device__ __forceinline__ void done(const pg8::Unit&, int, int) const {}
    __device__ __forceinline__ bool next(int i, pg8::Unit& u) const {
        if (i != 0) return false; const int pm = pm0, pn = pn0;
        u.pm = pm; u.pn = pn; u.kind = 0;
        if (pn < 2) { u.kind = 3; u.nt = 4; u.A = pc + ((size_t)pm * 256 * DM + 256 * pn) * 2; u.B = mix + ((size_t)pn * 256 * 512 + 256 * pn) * 2; }
        else { u.nt = 8; u.A = pc + ((size_t)pm * 256 * DM + 512) * 2; u.B = pw + (size_t)(pn - 2) * 256 * 512 * 2; }
        return true;
    }
};
struct EpiP3 {
    static constexpr bool PERM = true, AFTER_DRAIN = false, EXT_INIT = false, ZSKIP = true;
    const bf16_t* SGP; const bf16_t* SGC; const float* pw_b; bf16_t* Z;
    __device__ __forceinline__ void init(f32x4 (&acc)[2][2][4][2], const pg8::Unit&, int, int, int, int) const {
#pragma unroll
        for (int a = 0; a < 2; ++a)
#pragma unroll
            for (int b = 0; b < 2; ++b)
#pragma unroll
                for (int m = 0; m < 4; ++m)
#pragma unroll
                    for (int n = 0; n < 2; ++n) acc[a][b][m][n] = (f32x4){0.f, 0.f, 0.f, 0.f};
    }
    __device__ __forceinline__ void operator()(const f32x4 (&acc)[2][2][4][2], const pg8::Unit& u, int wr, int wc, int fr, int fq) const {
        const int pn = u.pn, row0 = u.pm * 256 + wr * 64 + fr, cl = wc * 32 + 8 * fq;
        const bool conv = pn >= 2; const bf16_t* gate = conv ? SGC : SGP; const int cb = (conv ? pn - 2 : pn) * 256 + cl;
        f32x4 bv[2][2];
#pragma unroll
        for (int bj = 0; bj < 2; ++bj)
#pragma unroll
            for (int n = 0; n < 2; ++n) bv[bj][n] = conv ? *(const f32x4*)(pw_b + cb + bj * 128 + 4 * n) : (f32x4){0.f, 0.f, 0.f, 0.f};
#pragma unroll
        for (int ai = 0; ai < 2; ++ai) {
            u32x4 gt[4][2];
#pragma unroll
            for (int m = 0; m < 4; ++m)
#pragma unroll
                for (int bj = 0; bj < 2; ++bj) gt[m][bj] = *(const u32x4*)(gate + (size_t)(row0 + ai * 128 + m * 16) * DH + cb + bj * 128);
#pragma unroll
            for (int m = 0; m < 4; ++m) { const int r = row0 + ai * 128 + m * 16;
#pragma unroll
                for (int bj = 0; bj < 2; ++bj) { const int c = cb + bj * 128; const u32x4 g = gt[m][bj];
                    f32x4 v0 = acc[ai][bj][m][0] + bv[bj][0], v1 = acc[ai][bj][m][1] + bv[bj][1];
                    v0[0] *= bf_lo(g[0]); v0[1] *= bf_hi(g[0]); v0[2] *= bf_lo(g[1]); v0[3] *= bf_hi(g[1]);
                    v1[0] *= bf_lo(g[2]); v1[1] *= bf_hi(g[2]); v1[2] *= bf_lo(g[3]); v1[3] *= bf_hi(g[3]);
                    *(u32x4*)(Z + (size_t)r * DM + (conv ? 512 : 0) + c) = pack8(v0, v1); }
            }
        }
    }
};

struct SchedP4 {
    const char* z; const char* wout; int pm0, pn0;
    __device__ __forceinline__ void done(const pg8::Unit&, int, int) const {}
    __device__ __forceinline__ bool next(int i, pg8::Unit& u) const {
        if (i != 0) return false; const int pm = pm0, pn = pn0;
        u.pm = pm; u.pn = pn; u.kind = 0; u.nt = 16; u.A = z + (size_t)pm * 256 * DM * 2; u.B = wout + (size_t)pn * 256 * DM * 2; return true;
    }
};
struct EpiP4 {
    static constexpr bool PERM = false, AFTER_DRAIN = true, EXT_INIT = true, ZSKIP = false;
    const float* x_prompt; const float* final_g; float* out; float* xs; unsigned* cnt; const float* ss; int srow; bool uni;
    __device__ __forceinline__ void init(f32x4 (&acc)[2][2][4][2], const pg8::Unit& u, int wr, int wc, int fr, int fq) const {
        const int row0 = u.pm * 256 + wr * 64 + fr, col0 = u.pn * 256 + wc * 32 + 4 * fq;
#pragma unroll
        for (int ai = 0; ai < 2; ++ai)
#pragma unroll
            for (int m = 0; m < 4; ++m) { const float* xr = x_prompt + (size_t)(row0 + ai * 128 + m * 16) * DM + col0;
#pragma unroll
                for (int bj = 0; bj < 2; ++bj)
#pragma unroll
                    for (int n = 0; n < 2; ++n) acc[ai][bj][m][n] = *(const f32x4*)(xr + bj * 128 + n * 16); }
    }
    __device__ __forceinline__ void fused(const f32x4 (&acc)[2][2][4][2], const pg8::Unit& u, int wr, int wc, int fr, int fq, LAS unsigned char* lds, int tid) const {
        LAS float* lss = (LAS float*)lds;
#pragma unroll
        for (int ai = 0; ai < 2; ++ai)
#pragma unroll
            for (int m = 0; m < 4; ++m) { float s = 0.f;
#pragma unroll
                for (int bj = 0; bj < 2; ++bj)
#pragma unroll
                    for (int n = 0; n < 2; ++n) { const f32x4 y = acc[ai][bj][m][n]; s += y[0] * y[0] + y[1] * y[1] + y[2] * y[2] + y[3] * y[3]; }
                s += __shfl_xor(s, 16); s += __shfl_xor(s, 32);
                if (fq == 0) lss[(ai * 128 + wr * 64 + m * 16 + fr) * 4 + wc] = s; }
        __syncthreads();
        if (tid < 256) { const f32x4 v = *(const LAS f32x4*)(lss + tid * 4); xs[((size_t)u.pm * 4 + u.pn) * 256 + tid] = v[0] + v[1] + v[2] + v[3]; }
        asm volatile("s_waitcnt vmcnt(0)" ::: "memory");
        __syncthreads();
        if (tid == 0) {
            unsigned* cw = cnt + 64 * u.pm; unsigned* cs = cnt + 64 * CW_PIECES;
            if (!uni) __builtin_amdgcn_fence(__ATOMIC_RELEASE, "agent");
            asm volatile("s_waitcnt vmcnt(0)" ::: "memory");
            (void)xb_add(cw, 1u);
            unsigned sp = 0u;
            while (xb_ld(cw) < 4u || xb_ld(cs) < 256u) { __builtin_amdgcn_s_sleep(1); if (++sp > (1u << 22)) break; }
            __builtin_amdgcn_fence(__ATOMIC_ACQUIRE, "agent");
            asm volatile("s_waitcnt vmcnt(0)" ::: "memory");
        }
        __syncthreads();
        if (tid >= 256) { const int t4 = (tid - 256) * 4; const float rs = rsqrtf(ss[srow] * (1.0f / DM) + 1e-6f); float* yr = out + (size_t)srow * DM + t4;
            *(f32x4*)yr = *(const f32x4*)yr * rs * *(const f32x4*)(final_g + t4); }
        if (tid < 256) { const float* xp = xs + (size_t)u.pm * 4 * 256 + tid; const float tot = xp[0] + xp[256] + xp[512] + xp[768];
            lss[1024 + tid] = rsqrtf(tot * (1.0f / DM) + 1e-6f); }
        __syncthreads();
        const int row0 = u.pm * 256 + wr * 64 + fr, col0 = u.pn * 256 + wc * 32 + 4 * fq;
        f32x4 g4[2][2];
#pragma unroll
        for (int bj = 0; bj < 2; ++bj)
#pragma unroll
            for (int n = 0; n < 2; ++n) g4[bj][n] = *(const f32x4*)(final_g + col0 + bj * 128 + n * 16);
#pragma unroll
        for (int ai = 0; ai < 2; ++ai)
#pragma unroll
            for (int m = 0; m < 4; ++m) { const float rs = lss[1024 + ai * 128 + wr * 64 + m * 16 + fr]; float* yr = out + (size_t)(row0 + ai * 128 + m * 16) * DM + col0;
#pragma unroll
                for (int bj = 0; bj < 2; ++bj)
#pragma unroll
                    for (int n = 0; n < 2; ++n) *(f32x4*)(yr + bj * 128 + n * 16) = acc[ai][bj][m][n] * rs * g4[bj][n]; }
    }
    __device__ __forceinline__ void operator()(const f32x4 (&)[2][2][4][2], const pg8::Unit&, int, int, int, int) const {}
};

template <int NF>
__device__ __forceinline__ f32x4 small_gemm(const bf16_t* __restrict__ A, int lda, const bf16_t* __restrict__ Bt, int ldb, int K, int nw, f32x4* red) {
    const int tid = threadIdx.x, wid = tid >> 6, lane = tid & 63, fr = lane & 15, fq = lane >> 4;
    f32x4 acc[NF];
#pragma unroll
    for (int f = 0; f < NF; ++f) acc[f] = (f32x4){0.f, 0.f, 0.f, 0.f};
    if (wid < nw) { const int ks = K / nw; const bf16_t* ap = A + (size_t)fr * lda + wid * ks + fq * 8; const bf16_t* bp = Bt + (size_t)fr * ldb + wid * ks + fq * 8;
        for (int k = 0; k < ks; k += 32) { const bf16x8 a = *(const bf16x8*)(ap + k);
#pragma unroll
            for (int f = 0; f < NF; ++f) { const bf16x8 b = *(const bf16x8*)(bp + (size_t)f * 16 * ldb + k); acc[f] = __builtin_amdgcn_mfma_f32_16x16x32_bf16(b, a, acc[f], 0, 0, 0); } } }
#pragma unroll
    for (int f = 0; f < NF; ++f) red[(wid * NF + f) * 64 + lane] = acc[f];
    __syncthreads();
    f32x4 r = (f32x4){0.f, 0.f, 0.f, 0.f};
    if (tid < 64 * NF) {
#pragma unroll
        for (int w = 0; w < 8; ++w) r += red[(w * NF + wid) * 64 + lane]; }
    return r;
}
__device__ __forceinline__ void sample_p3(const Params& p, unsigned char* shm, const int i) {
    const int tid = threadIdx.x, wid = tid >> 6, lane = tid & 63, fr = lane & 15, fq = lane >> 4; f32x4* red = (f32x4*)shm;
    const bf16_t* PC = (const bf16_t*)(p.ws + WS_PC); bf16_t* Z = (bf16_t*)(p.ws + WS_Z);
    { const int rb = i >> 4, cb = i & 15, row0 = NPROMPT + rb * 16, row = row0 + fr, c = 32 * cb + 16 * wid + 4 * fq;
        {
            const f32x4 r = small_gemm<2>(PC + (size_t)row0 * DM + 512, DM, (const bf16_t*)(p.ws + WS_PW) + (size_t)32 * cb * 512, 512, 512, 8, red);
            if (tid < 128) { const f32x4 bv = *(const f32x4*)(p.pw_b + c); const u32x2 g = *(const u32x2*)((const bf16_t*)(p.ws + WS_SGC) + (size_t)row * DH + c);
                const f32x4 z = (r + bv) * (f32x4){bf_lo(g[0]), bf_hi(g[0]), bf_lo(g[1]), bf_hi(g[1])};
                *(u32x2*)(Z + (size_t)row * DM + 512 + c) = (u32x2){cvt_pk_bf16(z[0], z[1]), cvt_pk_bf16(z[2], z[3])}; }
            __syncthreads();
        }
        {
            const int g128 = (cb >> 2) * 128;
            const f32x4 r = small_gemm<2>(PC + (size_t)row0 * DM + g128, DM, (const bf16_t*)(p.ws + WS_MIX) + (size_t)32 * cb * 512 + g128, 512, 128, 4, red);
            if (tid < 128) { const u32x2 g = *(const u32x2*)((const bf16_t*)(p.ws + WS_SGP) + (size_t)row * DH + c);
                const f32x4 z = r * (f32x4){bf_lo(g[0]), bf_hi(g[0]), bf_lo(g[1]), bf_hi(g[1])};
                *(u32x2*)(Z + (size_t)row * DM + c) = (u32x2){cvt_pk_bf16(z[0], z[1]), cvt_pk_bf16(z[2], z[3])}; }
            __syncthreads();
        }
    }
}
__device__ __forceinline__ void sample_p4(const Params& p, unsigned char* shm, const int i, const bool uni) {
    const int tid = threadIdx.x, wid = tid >> 6, lane = tid & 63, fr = lane & 15, fq = lane >> 4; f32x4* red = (f32x4*)shm;
    float* ss = (float*)(p.ws + WS_SS);
    { const int rb = i >> 4, cb = i & 15, row0 = NPROMPT + rb * 16, row = row0 + fr, c = 64 * cb + 16 * wid + 4 * fq;
        const f32x4 r = small_gemm<4>((const bf16_t*)(p.ws + WS_Z) + (size_t)row0 * DM, DM, (const bf16_t*)(p.ws + WS_WOUT) + (size_t)64 * cb * DM, DM, DM, 8, red);
        if (tid < 256) { const f32x4 y = r + *(const f32x4*)(p.x_sample + (size_t)(row - NPROMPT) * DM + c);
            *(f32x4*)(p.out + (size_t)row * DM + c) = y;
            float s = y[0] * y[0] + y[1] * y[1] + y[2] * y[2] + y[3] * y[3]; s += __shfl_xor(s, 16); s += __shfl_xor(s, 32);
            if (fq == 0) atomicAdd(ss + row, s); }
        asm volatile("s_waitcnt vmcnt(0)" ::: "memory");
        __syncthreads();
        if (tid == 0) { if (!uni) __builtin_amdgcn_fence(__ATOMIC_RELEASE, "agent"); asm volatile("s_waitcnt vmcnt(0)" ::: "memory"); (void)xb_add((unsigned*)(p.ws + WS_CNT) + 64 * CW_PIECES, 1u); }
    }
}
__device__ __forceinline__ void transpose_load(const float* __restrict__ src, int ldsrc, int k0, int n0s, f32x4 (&v)[2]) {
    const int tid = threadIdx.x, kk = tid >> 4, n4 = (tid & 15) * 4;
#pragma unroll
    for (int i = 0; i < 2; ++i) v[i] = *(const f32x4*)(src + (size_t)(k0 + kk + 32 * i) * ldsrc + n0s + n4);
}
__device__ __forceinline__ void transpose_store(const f32x4 (&v)[2], int k0, bf16_t* __restrict__ dst, int ldd, int n0d, float* tile) {
    const int tid = threadIdx.x;
    {
        const int kk = tid >> 4, n4 = (tid & 15) * 4;
#pragma unroll
        for (int i = 0; i < 2; ++i) { const int k = kk + 32 * i;
            tile[k * 65 + n4 + 0] = v[i][0]; tile[k * 65 + n4 + 1] = v[i][1]; tile[k * 65 + n4 + 2] = v[i][2]; tile[k * 65 + n4 + 3] = v[i][3]; }
    }
    __syncthreads();
    {
        const int n = tid >> 3, k8 = (tid & 7) * 8; float w[8];
#pragma unroll
        for (int j = 0; j < 8; ++j) w[j] = tile[(k8 + j) * 65 + n];
        *(u32x4*)(dst + (size_t)(n0d + n) * ldd + k0 + k8) = (u32x4){cvt_pk_bf16(w[0], w[1]), cvt_pk_bf16(w[2], w[3]), cvt_pk_bf16(w[4], w[5]), cvt_pk_bf16(w[6], w[7])};
    }
    __syncthreads();
}
__device__ __forceinline__ void transpose_tile(const float* __restrict__ src, int ldsrc, int k0, int n0s, bf16_t* __restrict__ dst, int ldd, int n0d, float* tile) {
    f32x4 v[2]; transpose_load(src, ldsrc, k0, n0s, v); transpose_store(v, k0, dst, ldd, n0d, tile);
}
__device__ __forceinline__ int win_src_col(int n0) {
    if (n0 >= 1024 && n0 < 2048) { const int q = n0 - 1024, j = q >> 8, i = q & 255; return i < 128 ? 1024 + 128 * j + i : 1536 + 128 * j + (i - 128); }
    return n0;
}

__device__ __forceinline__ void phase_prep(const Params& p, unsigned char* shm) {
    const int tid = threadIdx.x, wid = tid >> 6, lane = tid & 63, nb = gridDim.x, bid = blockIdx.x;
    bf16_t* xb = (bf16_t*)(p.ws + WS_XB);
    constexpr int T_IN = 16 * 40;
    f32x4 tv[3][2];
#pragma unroll
    for (int q = 0; q < 3; ++q) { const int t = bid + q * nb; if (t < T_IN) transpose_load(p.w_in, DIN, (t / 40) * 64, win_src_col((t % 40) * 64), tv[q]); }
    {
        f32x4 g4[4];
#pragma unroll
        for (int i = 0; i < 4; ++i) g4[i] = *(const f32x4*)(p.norm_g + lane * 4 + 256 * i);
        for (int g = bid * 8 + wid; g < MT / 4; g += nb * 8) {
            f32x4 v[4][4]; float s[4];
#pragma unroll
            for (int q = 0; q < 4; ++q) { const int r = g * 4 + q; const float* xr = r < NPROMPT ? p.x_prompt + (size_t)r * DM : p.x_sample + (size_t)(r - NPROMPT) * DM;
#pragma unroll
                for (int i = 0; i < 4; ++i) v[q][i] = *(const f32x4*)(xr + lane * 4 + 256 * i); }
#pragma unroll
            for (int q = 0; q < 4; ++q) { s[q] = 0.f;
#pragma unroll
                for (int i = 0; i < 4; ++i) s[q] += v[q][i][0] * v[q][i][0] + v[q][i][1] * v[q][i][1] + v[q][i][2] * v[q][i][2] + v[q][i][3] * v[q][i][3];
                s[q] = wave_sum(s[q]); }
#pragma unroll
            for (int q = 0; q < 4; ++q) { const int r = g * 4 + q; const float rs = rsqrtf(s[q] * (1.0f / DM) + 1e-6f);
#pragma unroll
                for (int i = 0; i < 4; ++i) { const f32x4 h = v[q][i] * rs * g4[i];
                    *(u32x2*)(xb + (size_t)r * DM + lane * 4 + 256 * i) = (u32x2){cvt_pk_bf16(h[0], h[1]), cvt_pk_bf16(h[2], h[3])}; } }
        }
    }
    {
        float* tile = (float*)shm; bf16_t* win = (bf16_t*)(p.ws + WS_WIN);
#pragma unroll
        for (int q = 0; q < 3; ++q) { const int t = bid + q * nb; if (t < T_IN) transpose_store(tv[q], (t / 40) * 64, win, DM, (t % 40) * 64, tile); }
        for (int t = bid + 3 * nb; t < T_IN; t += nb) transpose_tile(p.w_in, DIN, (t / 40) * 64, win_src_col((t % 40) * 64), win, DM, (t % 40) * 64, tile);
    }
    float* ss = (float*)(p.ws + WS_SS);
    for (int i = bid * 512 + tid; i < MT; i += nb * 512) ss[i] = 0.f;
    for (int i = bid * 512 + tid; i < 16 * 14 * 128; i += nb * 512) { const int c4 = i & 127, rr = i >> 7, b = rr / 14, j = rr % 14;
        *(f32x4*)(p.out + O_SCS + ((size_t)b * 30 + j) * 512 + c4 * 4) = *(const f32x4*)(p.cache_conv + ((size_t)b * 30 + 16 + j) * 512 + c4 * 4); }
}

__device__ __forceinline__ void late_weight_prep(const Params& p, unsigned char* shm, const int bid, const int nb) {
    const int tid = threadIdx.x; float* tile = (float*)shm;
    bf16_t* pw = (bf16_t*)(p.ws + WS_PW); bf16_t* wout = (bf16_t*)(p.ws + WS_WOUT); bf16_t* mix = (bf16_t*)(p.ws + WS_MIX);
    constexpr int T_OUT = 16 * 16, T_PW = 8 * 8;
    for (int t = bid; t < T_OUT + T_PW; t += nb) {
        if (t < T_OUT) transpose_tile(p.w_out, DM, (t >> 4) * 64, (t & 15) * 64, wout, DM, (t & 15) * 64, tile);
        else { const int tt = t - T_OUT; transpose_tile(p.pw_w, 512, (tt >> 3) * 64, (tt & 7) * 64, pw, 512, (tt & 7) * 64, tile); }
    }
    for (int idx = bid * 512 + tid; idx < 512 * 512; idx += nb * 512) { const int n = idx >> 9, k = idx & 511; float v = 0.f;
        if ((n >> 7) == (k >> 7)) v = p.pool_mix[((size_t)(n >> 7) * 128 + (k & 127)) * 128 + (n & 127)] * p.pool_scale[n];
        mix[idx] = (bf16_t)(cvt_pk_bf16(v, 0.f) & 0xffffu); }
    __syncthreads();
}

#define DPP_STEP(v, ctrl) ((v) + __builtin_bit_cast(float, __builtin_amdgcn_update_dpp(0, __builtin_bit_cast(int, (v)), (ctrl), 0xf, 0xf, true)))
__device__ __forceinline__ float wave_sum_hi(float v) {
    v = DPP_STEP(v, 0xB1);
    v = DPP_STEP(v, 0x4E);
    v = DPP_STEP(v, 0x141);
    v = DPP_STEP(v, 0x140);
    v += __builtin_bit_cast(float, __builtin_amdgcn_update_dpp(0, __builtin_bit_cast(int, v), 0x142, 0xa, 0xf, false));
    v += __builtin_bit_cast(float, __builtin_amdgcn_update_dpp(0, __builtin_bit_cast(int, v), 0x143, 0xc, 0xf, false));
    return v;
}
#define RED16_STEP(CTRL) _Pragma("unroll") for (int k = 0; k < 16; ++k) asm volatile("v_add_f32_dpp %0, %0, %0 " CTRL : "+v"(r[k]))
__device__ __forceinline__ void wave_sum16_hi(float (&r)[16]) {
    asm volatile("s_nop 1" ::: "memory");
    RED16_STEP("quad_perm:[1,0,3,2] row_mask:0xf bank_mask:0xf");
    RED16_STEP("quad_perm:[2,3,0,1] row_mask:0xf bank_mask:0xf");
    RED16_STEP("row_half_mirror row_mask:0xf bank_mask:0xf");
    RED16_STEP("row_mirror row_mask:0xf bank_mask:0xf");
    RED16_STEP("row_bcast:15 row_mask:0xa bank_mask:0xf");
    RED16_STEP("row_bcast:31 row_mask:0xc bank_mask:0xf");
}
template <int W, int TH>
__device__ __forceinline__ void pool_regs(const unsigned (&u)[TH + 15], const int pos0, bf16_t* __restrict__ dst  ) {
    f32x2 s = (f32x2){0.f, 0.f};
#pragma unroll
    for (int j = 0; j < W; ++j) s += bf_unpack(u[15 - j]);
#pragma unroll
    for (int i = 0; i < TH; ++i) { const f32x2 cur = bf_unpack(u[15 + i]); const int pos1 = pos0 + i + 1;
        const float inv = pos1 >= W ? (1.0f / W) : __builtin_amdgcn_rcpf((float)pos1);
        const f32x2 o = s * inv - cur;
        *(unsigned*)(dst + (size_t)i * DM) = cvt_pk_bf16(o[0], o[1]);
        if (i + 1 < TH) s += bf_unpack(u[16 + i]) - bf_unpack(u[16 + i - W]); }
}
template <int T>
__device__ __forceinline__ void mixer_chunk(const Params& p, unsigned char* shm, const int r0, const int t0, const int tid, const f32x2 (&w2)[31]) {
    constexpr int TH = T / 2, ROUNDS = T / 16, NV = ((T + 30) * 64 + 511) / 512;
    const int cp = tid & 255, th = tid >> 8, lane = tid & 63, wv = (tid >> 6) & 3;
    const bf16_t* U = (const bf16_t*)(p.ws + WS_U); const bf16_t* V = (const bf16_t*)(p.ws + WS_V); bf16_t* PC = (bf16_t*)(p.ws + WS_PC);
    const unsigned* l32 = (const unsigned*)shm;
    u32x4 val[NV];
    {
        const bf16_t* vb = V + (size_t)(r0 - 30) * DH;
#pragma unroll
        for (int k = 0; k < NV; ++k) { const int idx = tid + k * 512, lr = idx >> 6; val[k] = (u32x4){0u, 0u, 0u, 0u};
            if (idx < (T + 30) * 64 && t0 - 30 + lr >= 0) val[k] = *(const u32x4*)(vb + (size_t)idx * 8); }
    }
    unsigned u[TH + 15];
    {
        const int f0 = th * TH - 15; const bf16_t* ub = U + (size_t)(r0 + f0) * DH + cp * 2;
#pragma unroll
        for (int k = 0; k < TH + 15; ++k) { u[k] = 0u; if (t0 + f0 + k >= 0) u[k] = *(const unsigned*)(ub + (size_t)k * DH); }
    }
#pragma unroll
    for (int k = 0; k < NV; ++k) { const int idx = tid + k * 512; if (idx < (T + 30) * 64) *(u32x4*)(shm + (size_t)idx * 16) = val[k]; }
    const f32x2 bias = *(const f32x2*)(p.dw_b + cp * 2);
    const f32x2 g2 = *(const f32x2*)(p.ln_g + cp * 2), b2 = *(const f32x2*)(p.ln_b + cp * 2);
    __syncthreads();
    {
        bf16_t* dst = PC + (size_t)(r0 + th * TH) * DM + cp * 2; const int pos0 = t0 + th * TH;
        switch (cp >> 6) { case 0: pool_regs<2, TH>(u, pos0, dst); break; case 1: pool_regs<4, TH>(u, pos0, dst); break; case 2: pool_regs<8, TH>(u, pos0, dst); break; default: pool_regs<16, TH>(u, pos0, dst); break; }
    }
    f32x2* stats = (f32x2*)(shm + (T + 30) * 1024);
#pragma unroll 1
    for (int rd = 0; rd < ROUNDS; ++rd) {
        const int tt = rd * 16 + th * 8;
        f32x2 c[8];
#pragma unroll
        for (int i = 0; i < 8; ++i) c[i] = bias;
        unsigned win[38];
#pragma unroll
        for (int q = 0; q < 38; ++q) win[q] = l32[(tt + q) * 256 + cp];
#pragma unroll
        for (int q = 0; q < 38; ++q) { const f32x2 v = bf_unpack(win[q]);
#pragma unroll
            for (int i = 0; i < 8; ++i) if (q - i >= 0 && q - i < 31) c[i] += w2[q - i] * v;
            asm volatile("" : "+v"(c[0]), "+v"(c[1]), "+v"(c[2]), "+v"(c[3]), "+v"(c[4]), "+v"(c[5]), "+v"(c[6]), "+v"(c[7])); }
        { float r[16];
#pragma unroll
          for (int i = 0; i < 8; ++i) { r[2 * i] = c[i][0] + c[i][1]; r[2 * i + 1] = c[i][0] * c[i][0] + c[i][1] * c[i][1]; }
          wave_sum16_hi(r);
#pragma unroll
          for (int i = 0; i < 8; ++i) if (lane == 63) stats[(tt + i) * 4 + wv] = (f32x2){r[2 * i], r[2 * i + 1]}; }
        __syncthreads();
        float mean_l, rs_l;
        { const int ti = tt + (lane & 7);
          const f32x4 sa = *(const f32x4*)(stats + ti * 4), sb = *(const f32x4*)(stats + ti * 4 + 2);
          mean_l = (sa[0] + sa[2] + sb[0] + sb[2]) * (1.0f / 512.0f);
          const float var = (sa[1] + sa[3] + sb[1] + sb[3]) * (1.0f / 512.0f) - mean_l * mean_l;
          rs_l = __builtin_amdgcn_rsqf(var + 1e-5f); }
#pragma unroll
        for (int i = 0; i < 8; ++i) {
            const float mean = __builtin_bit_cast(float, __builtin_amdgcn_readlane(__builtin_bit_cast(int, mean_l), i));
            const float rs = __builtin_bit_cast(float, __builtin_amdgcn_readlane(__builtin_bit_cast(int, rs_l), i));
            const f32x2 y = (c[i] - mean) * rs * g2 + b2;
            *(unsigned*)(PC + (size_t)(r0 + tt + i) * DM + 512 + cp * 2) = cvt_pk_bf16(silu_f(y[0]), silu_f(y[1])); }
    }
    __syncthreads();
}

__device__ __forceinline__ void sample_token(const Params& p, unsigned char* shm, const int s) {
    const int tid = threadIdx.x, wid = tid >> 6, lane = tid & 63, b = s >> 4, t = s & 15, r = NPROMPT + s, ch = tid;
    const bf16_t* U = (const bf16_t*)(p.ws + WS_U); const bf16_t* V = (const bf16_t*)(p.ws + WS_V); bf16_t* PC = (bf16_t*)(p.ws + WS_PC);
    {
        const int w = 2 << (ch >> 7); float sum = 0.f, cur = 0.f;
#pragma unroll
        for (int j = 0; j < 16; ++j) if (j < w) { const int e = t + 15 - j;
            const float v = e < 15 ? p.cache_pool[((size_t)b * 15 + e) * 512 + ch] : __uint_as_float((unsigned)U[(size_t)(NPROMPT + b * 16 + e - 15) * DH + ch] << 16);
            sum += v; if (j == 0) cur = v; }
        const float o = sum / (float)w - cur;
        PC[(size_t)r * DM + ch] = (bf16_t)(cvt_pk_bf16(o, 0.f) & 0xffffu);
    }
    float c = p.dw_b[ch];
#pragma unroll
    for (int j = 0; j < 31; ++j) { const int e = t + j;
        const float v = e < 30 ? p.cache_conv[((size_t)b * 30 + e) * 512 + ch] : __uint_as_float((unsigned)V[(size_t)(NPROMPT + b * 16 + e - 30) * DH + ch] << 16);
        c += p.dw_w[j * 512 + ch] * v; }
    float s1 = wave_sum(c), s2 = wave_sum(c * c);
    f32x2* red = (f32x2*)shm;
    if (lane == 0) red[wid] = (f32x2){s1, s2};
    __syncthreads();
    s1 = 0.f; s2 = 0.f;
#pragma unroll
    for (int w8 = 0; w8 < 8; ++w8) { const f32x2 q = red[w8]; s1 += q[0]; s2 += q[1]; }
    const float mean = s1 * (1.0f / 512.0f), var = s2 * (1.0f / 512.0f) - mean * mean, rs = rsqrtf(var + 1e-5f);
    const float y = (c - mean) * rs * p.ln_g[ch] + p.ln_b[ch];
    PC[(size_t)r * DM + 512 + ch] = (bf16_t)(cvt_pk_bf16(silu_f(y), 0.f) & 0xffffu);
    __syncthreads();
}

__device__ __forceinline__ void wait_counters(unsigned* c0, unsigned t0, unsigned* c1, unsigned t1, unsigned* c2, unsigned t2) {
    if (threadIdx.x == 0) { unsigned sp = 0u;
        while (xb_ld(c0) < t0 || xb_ld(c1) < t1 || xb_ld(c2) < t2) { __builtin_amdgcn_s_sleep(1); if (++sp > (1u << 22)) break; }
        __builtin_amdgcn_fence(__ATOMIC_ACQUIRE, "agent"); asm volatile("s_waitcnt vmcnt(0)" ::: "memory"); }
    __syncthreads();
}
__device__ __forceinline__ void phase_mixer_pre(const Params& p, unsigned char* shm, const int gbase, int off, int len) {
    int tid = threadIdx.x; asm volatile("" : "+v"(tid));
    f32x2 w2[31];
    { const float* wp = p.dw_w + (tid & 255) * 2;
#pragma unroll
      for (int j = 0; j < 31; ++j) w2[j] = *(const f32x2*)(wp + j * 512); }
#pragma unroll 1
    while (len > 0) {
        const int take = (len >= 96 || len == 64) ? 64 : (len == 80 ? 48 : (len > 64 ? 32 : len)), r0 = gbase + off, t0 = r0 & (SEQ - 1);
        int tq = tid; asm volatile("" : "+v"(tq));
        if (take == 64) mixer_chunk<64>(p, shm, r0, t0, tq, w2); else if (take == 48) mixer_chunk<48>(p, shm, r0, t0, tq, w2); else mixer_chunk<32>(p, shm, r0, t0, tq, w2);
        off += take; len -= take;
    }
}

__global__ void __launch_bounds__(512, 2) hymba_fwd(Params p) {
    extern __shared__ __attribute__((aligned(16))) unsigned char shm[];
    LAS unsigned char* lds = (LAS unsigned char*)shm;
    const int G = gridDim.x, c = blockIdx.x;
    volatile LAS unsigned* st = (volatile LAS unsigned*)(lds + pg8::STAGE_BYTES);
    if (threadIdx.x == 0) { st[0] = 0u; st[1] = 0u; st[2] = 0u; st[3] = 0u; }
    __syncthreads();
    const XcdBarrier xb = xcd_barrier_post((unsigned*)(p.ws + WS_BAR), st);
    phase_prep(p, shm);
    xcd_barrier(xb);
    const bool uni = st[3] != 0u;
    const int gx = uni ? (int)xb.x : (c & 7), gl = uni ? (int)st[2] : (c >> 3);
    const int sidx = 32 * gx + gl;
    const int pm = 8 * gx + (gl & 7), pn = gl >> 3;
    const int n3 = gx < 2 ? 18 : 17;
    unsigned* cw = (unsigned*)(p.ws + WS_CNT);
    if (gl >= n3) {
        late_weight_prep(p, shm, (gx < 2 ? 14 * gx : 28 + 15 * (gx - 2)) + (gl - n3), 118);
        asm volatile("s_waitcnt vmcnt(0)" ::: "memory");
        __syncthreads();
        if (threadIdx.x == 0 && !uni) { __builtin_amdgcn_fence(__ATOMIC_RELEASE, "agent"); asm volatile("s_waitcnt vmcnt(0)" ::: "memory"); (void)xb_add(cw + 64 * CW_LW, 1u); }
    }
    { SchedP1 S{(const char*)(p.ws + WS_XB), (const char*)(p.ws + WS_WIN), cw, gx, gl, uni};
      EpiP1 E{(bf16_t*)(p.ws + WS_U), (bf16_t*)(p.ws + WS_SGP), (bf16_t*)(p.ws + WS_V), (bf16_t*)(p.ws + WS_SGC), p.out};
      f32x4 acc[2][2][4][2]; pg8::gemm_phase(lds, DM, DM, S, E, acc); }
    if (uni) {
        const unsigned n_s8 = gx < 2 ? 16u : 8u;
        if (gl == 31) {
            wait_counters(cw + 64 * (CW_RV + gx), 384u, cw + 64 * (CW_SV + gx), n_s8, cw + 64 * (CW_SV + gx), n_s8);
            if (threadIdx.x == 0) { __builtin_amdgcn_fence(__ATOMIC_RELEASE, "agent"); asm volatile("s_waitcnt vmcnt(0)" ::: "memory"); (void)xb_add(cw + 64 * CW_GV, 1u); }
        }
        const bool halo = (gx & 1) && gl == n3;
        wait_counters(cw + 64 * (CW_RV + gx), 384u, cw + 64 * CW_GV, halo ? 8u : 0u, cw + 64 * CW_GV, 0u);
    } else xcd_barrier(xb);
    {
      const int E2 = 32 - n3; int off, len;
      if (!uni) { off = 64 * gl; len = 64; }
      else if (gl >= n3) { off = 96 * (gl - n3); len = 96; }
      else { const int remu = (2048 - 96 * E2) / 16, base = remu / n3, extra = remu % n3; off = 96 * E2 + 16 * (gl * base + (gl < extra ? gl : extra)); len = 16 * (base + (gl < extra ? 1 : 0)); }
      phase_mixer_pre(p, shm, 2048 * gx, off, len); }
    if (uni) wait_counters(cw + 64 * CW_GV, 8u, cw + 64 * CW_GV, 8u, cw + 64 * CW_GV, 8u);
    sample_token(p, shm, sidx);
    if (uni) xcc_barrier(xb, [] {}); else xcd_barrier(xb);
    { SchedP3 S{(const char*)(p.ws + WS_PC), (const char*)(p.ws + WS_MIX), (const char*)(p.ws + WS_PW), pm, pn};
      EpiP3 E{(const bf16_t*)(p.ws + WS_SGP), (const bf16_t*)(p.ws + WS_SGC), p.pw_b, (bf16_t*)(p.ws + WS_Z)};
      f32x4 acc[2][2][4][2]; pg8::gemm_phase(lds, DM, 512, S, E, acc); }
    if (pn < 2) { sample_p3(p, shm, sidx); sample_p3(p, shm, sidx + 16); }
    { SchedP4 S{(const char*)(p.ws + WS_Z), (const char*)(p.ws + WS_WOUT), pm, pn};
      EpiP4 E{p.x_prompt, p.final_g, p.out, (float*)(p.ws + WS_XS), (unsigned*)(p.ws + WS_CNT), (const float*)(p.ws + WS_SS), NPROMPT + sidx, uni};
      f32x4 acc[2][2][4][2]; pg8::Unit u4; const bool has4 = S.next(0, u4);
      int tid4 = threadIdx.x; asm volatile("" : "+v"(tid4));
      const int wid4 = __builtin_amdgcn_readfirstlane(tid4 >> 6), lane4 = tid4 & 63;
      const auto hook = [&] { if (has4) E.init(acc, u4, wid4 >> 2, wid4 & 3, lane4 & 15, lane4 >> 4); };
      if (uni) xcc_barrier(xb, hook); else xcd_barrier(xb, hook);
      sample_p4(p, shm, sidx, uni);
      pg8::gemm_phase(lds, DM, DM, S, E, acc); }
}

extern "C" void kernel_launch(void* const* d_in, const int* in_sizes, int n_in, void* d_out, int out_size, void* d_ws, size_t ws_size, hipStream_t stream) {
    constexpr int LDS_BYTES = pg8::STAGE_BYTES + 16;
    static int grid = 0;
    if (grid == 0) {
        if (n_in != 16 || ws_size < WS_END) { fprintf(stderr, "kernel_launch: unexpected inputs (n_in %d, ws %zu)\n", n_in, ws_size); grid = -1; return; }
        int dev = 0, cus = 0, per_cu = 0;
        (void)hipGetDevice(&dev); (void)hipDeviceGetAttribute(&cus, hipDeviceAttributeMultiprocessorCount, dev);
        if (hipFuncSetAttribute((const void*)hymba_fwd, hipFuncAttributeMaxDynamicSharedMemorySize, LDS_BYTES) != hipSuccess) { fprintf(stderr, "kernel_launch: hipFuncSetAttribute failed\n"); grid = -1; return; }
        if (hipOccupancyMaxActiveBlocksPerMultiprocessor(&per_cu, (const void*)hymba_fwd, 512, LDS_BYTES) != hipSuccess || per_cu < 1) { fprintf(stderr, "kernel_launch: occupancy query says %d\n", per_cu); per_cu = 1; (void)hipGetLastError(); }
        if (cus < 256) { fprintf(stderr, "kernel_launch: built for a 256-CU device (got %d CUs)\n", cus); grid = -1; return; }
        grid = 256;
    }
    if (grid < 0) return;
    if (hipMemsetAsync((char*)d_ws + WS_BAR, 0, WS_CTL_BYTES, stream) != hipSuccess) { fprintf(stderr, "kernel_launch: memset of the barrier words failed\n"); return; }
    Params p{};
    p.x_prompt = (const float*)d_in[0]; p.x_sample = (const float*)d_in[1]; p.cache_pool = (const float*)d_in[2]; p.cache_conv = (const float*)d_in[3];
    p.norm_g = (const float*)d_in[4]; p.w_in = (const float*)d_in[5]; p.pool_mix = (const float*)d_in[6]; p.pool_scale = (const float*)d_in[7];
    p.dw_w = (const float*)d_in[8]; p.dw_b = (const float*)d_in[9]; p.ln_g = (const float*)d_in[10]; p.ln_b = (const float*)d_in[11];
    p.pw_w = (const float*)d_in[12]; p.pw_b = (const float*)d_in[13]; p.w_out = (const float*)d_in[14]; p.final_g = (const float*)d_in[15];
    p.out = (float*)d_out; p.ws = (unsigned char*)d_ws;
    void* args[] = {&p};
    hipError_t e = hipLaunchCooperativeKernel((const void*)hymba_fwd, dim3(grid), dim3(512), args, LDS_BYTES, stream);
    if (e != hipSuccess) fprintf(stderr, "kernel_launch: cooperative launch failed: %s (grid %d)\n", hipGetErrorString(e), grid);
}
```
